# Optimizing an MI355X kernel written in HIP

```python
import jax, jax.numpy as jnp
from jax import lax
import numpy as np

D_MODEL = 1024
BATCH = 16
SEQ = 2048
DEPTH = 2

GRID_W = 64
CTX_LEN = 256
EPS = 1e-6
N_MOD = 6
D_LRU = D_MODEL
LRU_BLOCKS = 16
LRU_BW = D_LRU // LRU_BLOCKS
CONV_W = 4
CONV_PAD_L = 2
LRU_C = 8.0
GLA_HEADS = 4
GLA_DK = D_MODEL // 2
GLA_DV = D_MODEL
GLA_DK_H = GLA_DK // GLA_HEADS
GLA_DV_H = GLA_DV // GLA_HEADS
GLA_GATE_RANK = 16
GLA_GATE_NORM = 16.0
GLA_CHUNK = 64
PEER_HEADS = 8
PEER_DQ = 256
PEER_DHALF = PEER_DQ // 2
N_KEYS = 128
N_EXPERTS = N_KEYS * N_KEYS
PEER_TOPK = 16
PEER_BLOCK = 128
IN_SIZES = (D_LRU, D_LRU, GLA_DK, GLA_DK, GLA_DV, GLA_DV, 2 * GLA_GATE_RANK, D_MODEL, D_MODEL)
D_IN = sum(IN_SIZES)

kernel_name = "hybrid_rglru_gla_peer_diffusion_block"


def _rmsnorm(x, g):
    x32 = x.astype(jnp.float32)
    y = x32 * lax.rsqrt(jnp.mean(x32 * x32, axis=-1, keepdims=True) + EPS)
    return (y * g.astype(jnp.float32)).astype(x.dtype)


def _modulate(h, shift, scale):
    return h * (1.0 + scale) + shift


def _split_in(proj):
    offs = [int(o) for o in np.cumsum(IN_SIZES)[:-1]]
    return jnp.split(proj, offs, axis=-1)


def _heads(t, n):
    b, l, ch = t.shape
    return t.reshape(b, l, n, ch // n).transpose(0, 2, 1, 3)


def _to_colmajor(t):
    b, l, ch = t.shape
    rows = l // GRID_W
    return t.reshape(b, rows, GRID_W, ch).swapaxes(1, 2).reshape(b, l, ch)


def _from_colmajor(t):
    b, l, ch = t.shape
    rows = l // GRID_W
    return t.reshape(b, GRID_W, rows, ch).swapaxes(1, 2).reshape(b, l, ch)


def _conv_centred(x, w, bias):
    l = x.shape[1]
    xp = jnp.pad(x, ((0, 0), (CONV_PAD_L, CONV_W - 1 - CONV_PAD_L), (0, 0)))
    out = bias
    for k in range(CONV_W):
        out = out + xp[:, k:k + l] * w[k]
    return out


def _lin_combine(e1, e2):
    a1, b1 = e1
    a2, b2 = e2
    return a1 * a2, a2 * b1 + b2


def _rglru(xr, w_a, b_a, w_x, b_x, lam, h0, reverse):
    b, l, _ = xr.shape
    xb = xr.reshape(b, l, LRU_BLOCKS, LRU_BW)
    r = jax.nn.sigmoid(jnp.einsum('blhi,hij->blhj', xb, w_a).reshape(b, l, D_LRU) + b_a)
    i = jax.nn.sigmoid(jnp.einsum('blhi,hij->blhj', xb, w_x).reshape(b, l, D_LRU) + b_x)
    log_a = -LRU_C * jax.nn.softplus(-lam.astype(jnp.float32)) * r.astype(jnp.float32)
    a = jnp.exp(log_a)
    u = jnp.sqrt(-jnp.expm1(2.0 * log_a)) * (i * xr).astype(jnp.float32)
    a_cum, h_zero = lax.associative_scan(_lin_combine, (a, u), axis=1, reverse=reverse)
    h = h_zero + a_cum * h0[:, None, :]
    h_last = h[:, 0] if reverse else h[:, -1]
    return h, h_last


def _gla_chunked(q, k, v, log_a, s0):
    b, h, l, dk = q.shape
    dv = v.shape[-1]
    n = l // GLA_CHUNK
    q = q.reshape(b, h, n, GLA_CHUNK, dk)
    k = k.reshape(b, h, n, GLA_CHUNK, dk)
    v = v.reshape(b, h, n, GLA_CHUNK, dv)
    cum = jnp.cumsum(log_a.reshape(b, h, n, GLA_CHUNK, dk), axis=3)
    q_in = q * jnp.exp(cum)
    k_in = k * jnp.exp(-cum)
    k_st = k * jnp.exp(cum[:, :, :, -1:, :] - cum)
    g_last = jnp.exp(cum[:, :, :, -1, :])
    mask = jnp.tril(jnp.ones((GLA_CHUNK, GLA_CHUNK), jnp.float32))
    att = jnp.einsum('bhncd,bhnsd->bhncs', q_in, k_in) * mask
    o_intra = jnp.einsum('bhncs,bhnse->bhnce', att, v)

    def step(state, xs):
        q_c, k_c, v_c, g_c = xs
        o_c = jnp.einsum('bhcd,bhde->bhce', q_c, state)
        state = state * g_c[..., None] + jnp.einsum('bhcd,bhce->bhde', k_c, v_c)
        return state, o_c

    xs = (jnp.moveaxis(q_in, 2, 0), jnp.moveaxis(k_st, 2, 0), jnp.moveaxis(v, 2, 0), jnp.moveaxis(g_last, 2, 0))
    s_fin, o_inter = lax.scan(step, s0, xs)
    o = o_intra + jnp.moveaxis(o_inter, 0, 2)
    return o.reshape(b, h, l, dv), s_fin


def _gla_branch(q, k, v, f, gla_wf, gla_bf, s0_f, s0_b):
    lg_f = jax.nn.log_sigmoid((f[..., :GLA_GATE_RANK] @ gla_wf[0] + gla_bf[0]).astype(jnp.float32)) / GLA_GATE_NORM
    lg_b = jax.nn.log_sigmoid((f[..., GLA_GATE_RANK:] @ gla_wf[1] + gla_bf[1]).astype(jnp.float32)) / GLA_GATE_NORM
    qh = _heads(q, GLA_HEADS) * (GLA_DK_H ** -0.5)
    kh = _heads(k, GLA_HEADS)
    vh = _heads(v, GLA_HEADS)
    o_f, s_f = _gla_chunked(qh, kh, vh, _heads(lg_f, GLA_HEADS), s0_f)
    flip = lambda t: jnp.flip(t, axis=2)
    o_b, s_b = _gla_chunked(flip(qh), flip(kh), flip(vh), flip(_heads(lg_b, GLA_HEADS)), s0_b)
    o = (o_f + flip(o_b)).astype(jnp.float32)
    o = o * lax.rsqrt(jnp.mean(o * o, axis=-1, keepdims=True) + EPS)
    bsz, _, l, _ = o.shape
    return o.transpose(0, 2, 1, 3).reshape(bsz, l, GLA_DV), s_f, s_b


def _merge(y_lru, y_gla, g_lru, g_gla, w_br_lru, w_br_gla, w_out):
    m = jax.nn.sigmoid(g_lru) * (y_lru @ w_br_lru) + jax.nn.sigmoid(g_gla) * (y_gla @ w_br_gla)
    return m @ w_out


def _token_mixer(hn_c, hn_l, w_in, conv_w, conv_b, lru_wa, lru_ba, lru_wx, lru_bx, lru_lam,
                 gla_wf, gla_bf, gla_norm_g, w_br_lru, w_br_gla, w_out, with_ctx_out):
    bsz = hn_l.shape[0]
    dt = hn_l.dtype
    xc, gc, qc, kc, vc, oc, fc, glc, ggc = _split_in(hn_c @ w_in)
    xl, gl, ql, kl, vl, ol, fl, gll, ggl = _split_in(hn_l @ w_in)
    xr_c = _conv_centred(xc, conv_w, conv_b)
    xr_l = _conv_centred(xl, conv_w, conv_b)
    h0 = jnp.zeros((bsz, D_LRU), jnp.float32)
    hc_f, sc_f = _rglru(xr_c, lru_wa[0], lru_ba[0], lru_wx[0], lru_bx[0], lru_lam[0], h0, False)
    hc_b, sc_b = _rglru(xr_c, lru_wa[1], lru_ba[1], lru_wx[1], lru_bx[1], lru_lam[1], h0, True)
    hl_f, _ = _rglru(xr_l, lru_wa[0], lru_ba[0], lru_wx[0], lru_bx[0], lru_lam[0], sc_f, False)
    hl_b, _ = _rglru(xr_l, lru_wa[1], lru_ba[1], lru_wx[1], lru_bx[1], lru_lam[1], sc_b, True)
    y_lru_l = ((hl_f + hl_b) * jax.nn.gelu(gl.astype(jnp.float32))).astype(dt)
    s0 = jnp.zeros((bsz, GLA_HEADS, GLA_DK_H, GLA_DV_H), jnp.float32)
    oc_n, sg_f, sg_b = _gla_branch(qc, kc, vc, fc, gla_wf, gla_bf, s0, s0)
    ol_n, _, _ = _gla_branch(_to_colmajor(ql), _to_colmajor(kl), _to_colmajor(vl), _to_colmajor(fl),
                             gla_wf, gla_bf, sg_f, sg_b)
    y_gla_l = (_from_colmajor(ol_n) * gla_norm_g * jax.nn.silu(ol.astype(jnp.float32))).astype(dt)
    out_l = _merge(y_lru_l, y_gla_l, gll, ggl, w_br_lru, w_br_gla, w_out)
    if not with_ctx_out:
        return out_l, None
    y_lru_c = ((hc_f + hc_b) * jax.nn.gelu(gc.astype(jnp.float32))).astype(dt)
    y_gla_c = (oc_n * gla_norm_g * jax.nn.silu(oc.astype(jnp.float32))).astype(dt)
    out_c = _merge(y_lru_c, y_gla_c, glc, ggc, w_br_lru, w_br_gla, w_out)
    return out_l, out_c


def _peer(h, w_q, sub_keys, expert_u, expert_v):
    shape = h.shape
    blocks = h.reshape(-1, PEER_BLOCK, D_MODEL)

    def block_fn(hb):
        p = hb.shape[0]
        q = (hb @ w_q).reshape(p, PEER_HEADS, 2, PEER_DHALF)
        s = jnp.einsum('phzd,zkd->phzk', q, sub_keys).astype(jnp.float32)
        s_top, i_top = lax.top_k(s, PEER_TOPK)
        cand_s = (s_top[:, :, 0, :, None] + s_top[:, :, 1, None, :]).reshape(p, PEER_HEADS, PEER_TOPK * PEER_TOPK)
        cand_i = (i_top[:, :, 0, :, None] * N_KEYS + i_top[:, :, 1, None, :]).reshape(p, PEER_HEADS, PEER_TOPK * PEER_TOPK)
        best_s, best_j = lax.top_k(cand_s, PEER_TOPK)
        idx = jnp.take_along_axis(cand_i, best_j, axis=-1)
        g = jax.nn.softmax(best_s, axis=-1)
        act = jax.nn.gelu(jnp.einsum('phkd,pd->phk', expert_u[idx], hb).astype(jnp.float32))
        wgt = (g * act).astype(hb.dtype)
        return jnp.einsum('phk,phkd->pd', wgt, expert_v[idx])

    return lax.map(block_fn, blocks).reshape(shape)


def setup_inputs(seed: int = 0) -> dict:
    key = jax.random.key(seed)
    ks = jax.random.split(key, 32)
    f32 = jnp.float32
    d = D_MODEL

    def nrm(k, shape, s):
        return jax.random.normal(k, shape, f32) * s

    a0 = jax.random.uniform(ks[15], (DEPTH, 2, D_LRU), f32, 0.9, 0.999)
    return {
        "x": nrm(ks[0], (BATCH, SEQ, d), 1.0),
        "c": nrm(ks[1], (BATCH, d), 1.0),
        "ctx": nrm(ks[2], (BATCH, CTX_LEN, d), 1.0),
        "c_ctx": nrm(ks[3], (d,), 1.0),
        "w_mod": nrm(ks[4], (DEPTH, d, N_MOD * d), 0.5 * d ** -0.5),
        "b_mod": nrm(ks[5], (DEPTH, N_MOD * d), 0.02),
        "norm1_g": 1.0 + nrm(ks[6], (DEPTH, d), 0.02),
        "norm2_g": 1.0 + nrm(ks[7], (DEPTH, d), 0.02),
        "w_in": nrm(ks[8], (DEPTH, d, D_IN), d ** -0.5),
        "conv_w": nrm(ks[9], (DEPTH, CONV_W, D_LRU), CONV_W ** -0.5),
        "conv_b": nrm(ks[10], (DEPTH, D_LRU), 0.02),
        "lru_wa": nrm(ks[11], (DEPTH, 2, LRU_BLOCKS, LRU_BW, LRU_BW), LRU_BW ** -0.5),
        "lru_ba": nrm(ks[12], (DEPTH, 2, D_LRU), 0.02),
        "lru_wx": nrm(ks[13], (DEPTH, 2, LRU_BLOCKS, LRU_BW, LRU_BW), LRU_BW ** -0.5),
        "lru_bx": nrm(ks[14], (DEPTH, 2, D_LRU), 0.02),
        "lru_lam": jnp.log(a0) - jnp.log1p(-a0),
        "gla_wf": nrm(ks[16], (DEPTH, 2, GLA_GATE_RANK, GLA_DK), GLA_GATE_RANK ** -0.5),
        "gla_bf": nrm(ks[17], (DEPTH, 2, GLA_DK), 0.02),
        "gla_norm_g": 1.0 + nrm(ks[18], (DEPTH, GLA_DV), 0.02),
        "w_br_lru": nrm(ks[19], (DEPTH, D_LRU, d), D_LRU ** -0.5),
        "w_br_gla": nrm(ks[20], (DEPTH, GLA_DV, d), GLA_DV ** -0.5),
        "w_out": nrm(ks[21], (DEPTH, d, d), d ** -0.5),
        "peer_wq": nrm(ks[22], (DEPTH, d, PEER_HEADS * PEER_DQ), d ** -0.5),
        "peer_keys": nrm(ks[23], (DEPTH, 2, N_KEYS, PEER_DHALF), PEER_DHALF ** -0.5),
        "expert_u": nrm(ks[24], (DEPTH, N_EXPERTS, d), d ** -0.5),
        "expert_v": nrm(ks[25], (DEPTH, N_EXPERTS, d), 1.0),
        "final_norm_g": 1.0 + nrm(ks[26], (d,), 0.02),
    }


def reference(x, c, ctx, c_ctx, w_mod, b_mod, norm1_g, norm2_g, w_in, conv_w, conv_b,
              lru_wa, lru_ba, lru_wx, lru_bx, lru_lam, gla_wf, gla_bf, gla_norm_g,
              w_br_lru, w_br_gla, w_out, peer_wq, peer_keys, expert_u, expert_v, final_norm_g):
    h_l = x
    h_c = ctx
    for layer in range(DEPTH):
        last = layer == DEPTH - 1
        mod_l = jax.nn.silu(c) @ w_mod[layer] + b_mod[layer]
        mod_c = jax.nn.silu(c_ctx) @ w_mod[layer] + b_mod[layer]
        sh1, sc1, g1, sh2, sc2, g2 = jnp.split(mod_l[:, None, :], N_MOD, axis=-1)
        csh1, csc1, cg1, csh2, csc2, cg2 = jnp.split(mod_c, N_MOD, axis=-1)
        hn_l = _modulate(_rmsnorm(h_l, norm1_g[layer]), sh1, sc1)
        hn_c = _modulate(_rmsnorm(h_c, norm1_g[layer]), csh1, csc1)
        mix_l, mix_c = _token_mixer(hn_c, hn_l, w_in[layer], conv_w[layer], conv_b[layer],
                                    lru_wa[layer], lru_ba[layer], lru_wx[layer], lru_bx[layer], lru_lam[layer],
                                    gla_wf[layer], gla_bf[layer], gla_norm_g[layer],
                                    w_br_lru[layer], w_br_gla[layer], w_out[layer], not last)
        h_l = h_l + g1 * mix_l
        h_l = h_l + g2 * _peer(_modulate(_rmsnorm(h_l, norm2_g[layer]), sh2, sc2),
                               peer_wq[layer], peer_keys[layer], expert_u[layer], expert_v[layer])
        if not last:
            h_c = h_c + cg1 * mix_c
            h_c = h_c + cg2 * _peer(_modulate(_rmsnorm(h_c, norm2_g[layer]), csh2, csc2),
                                    peer_wq[layer], peer_keys[layer], expert_u[layer], expert_v[layer])
    return _rmsnorm(h_l, final_norm_g)
```

```cpp
#include <hip/hip_runtime.h>
#include <hip/hip_cooperative_groups.h>
#include <cstdio>
namespace cg = cooperative_groups;
namespace pg8 {
#define PG8_LAS __attribute__((address_space(3)))
typedef unsigned short bf16_t;
typedef short bf16x8 __attribute__((ext_vector_type(8)));
typedef float f32x4 __attribute__((ext_vector_type(4)));
typedef unsigned u32x4 __attribute__((ext_vector_type(4)));
constexpr int BM = 256, BK = 64, HALF = 128, HTB = HALF * BK * 2  , STAGE_BYTES = 8 * HTB, NXCD = 8, WGM = 8;

__host__ __device__ __forceinline__ int lds_byte(int r, int c) { const int st = (r >> 4) * 2 + (c >> 5), rr = r & 15, cc = c & 31, ob = rr * 64 + cc * 2; return st * 1024 + (ob ^ (((ob >> 9) & 1) << 5)); }
__host__ __device__ __forceinline__ void stage_rc(int b, int& R, int& C) { const int st = b / 1024, sb = b % 1024, swz = sb ^ (((sb >> 9) & 1) << 5); R = (st >> 1) * 16 + swz / 64; C = (st & 1) * 32 + (swz % 64) / 2; }
__host__ __device__ __forceinline__ int perm32(int rho) { const int n = rho >> 4, i = rho & 15; return 8 * (i >> 2) + 4 * n + (i & 3); }

struct Unit { int pm, pn; };
struct Gemm { const bf16_t* A; const bf16_t* Bt; int M, N, K; };

struct StaticOrder {
    int nM, nN, nwg, G, c;
    __host__ __device__ void init(int M, int N, int G_, int c_) { nM = M / BM; nN = N / BM; nwg = nM * nN; G = G_; c = c_; }
    __host__ __device__ bool next(int i, Unit& u) const {
        const long L = (long)i * G + c; if (L >= nwg) return false;
        int wgid = (int)L; { const int q = nwg / NXCD, r = nwg % NXCD, xcd = wgid % NXCD, off = wgid / NXCD; wgid = (xcd < r ? xcd * (q + 1) : r * (q + 1) + (xcd - r) * q) + off; }
        const int nig = WGM * nN, gid = wgid / nig, fm = gid * WGM, gsz = (nM - fm) < WGM ? (nM - fm) : WGM;
        u.pm = fm + ((wgid % nig) % gsz); u.pn = (wgid % nig) / gsz; return true;
    }
    __device__ __forceinline__ void a_ready(const Unit&) const {}
    __device__ __forceinline__ void done(const Unit&) const {}
};
__device__ __forceinline__ unsigned cvt_pk_bf16(float lo, float hi) { unsigned r; asm volatile("v_cvt_pk_bf16_f32 %0, %1, %2" : "=v"(r) : "v"(lo), "v"(hi)); return r; }
typedef float f32x2 __attribute__((ext_vector_type(2)));
template <class Epi, class Sched, bool STAMP = false>
__device__ __forceinline__ void gemm_phase(PG8_LAS unsigned char* lds, const Gemm g, const Sched& S, const Epi& E, unsigned long long* stamps) {
    int tid_l = threadIdx.x; asm volatile("" : "+v"(tid_l)); const int tid = tid_l, wid = __builtin_amdgcn_readfirstlane(tid >> 6), lane = tid & 63, wr = wid >> 2, wc = wid & 3, fr = lane & 15, fq = lane >> 4;
    const int K = g.K, nt = K / BK;
    int ts_lo = 0, ts_hi = 0, nts = 0; const unsigned long long rt_entry = STAMP ? (unsigned long long)wall_clock64() : 0ull;
#define PG8_STAMP() do { if (STAMP && wid == 0 && nts < 64) { const unsigned long long _c = (unsigned long long)clock64(); \
        ts_lo = (lane == nts) ? (int)(unsigned)_c : ts_lo; ts_hi = (lane == nts) ? (int)(unsigned)(_c >> 32) : ts_hi; ++nts; } } while (0)
    PG8_STAMP();
    unsigned voffA[2], voffB[2];
#pragma unroll
    for (int i = 0; i < 2; ++i) { int R, C; stage_rc(tid * 16 + i * 8192, R, C); const int Rb = Epi::PERM ? ((R & ~31) + perm32(R & 31)) : R;
        voffA[i] = (unsigned)(R * K + C) * 2u; voffB[i] = (unsigned)(Rb * K + C) * 2u; }
    const size_t kstep = (size_t)(BK * 2);
    const size_t hstep = (size_t)HALF * K * 2;
    const size_t tstep = 2 * hstep;
    const unsigned ldsw = (unsigned)wid * 1024u;
    const int aoff = lds_byte(wr * 64 + fr, fq * 8), boff = lds_byte(wc * 32 + fr, fq * 8);
#define PG8_SA(b, h) (((b) * 2 + (h)) * HTB)
#define PG8_SB(b, h) ((4 + (b) * 2 + (h)) * HTB)
#define PG8_STAGE(bufoff, gbase, voff) do { _Pragma("unroll") for (int _i = 0; _i < 2; ++_i) \
        __builtin_amdgcn_global_load_lds((const unsigned*)((const char*)(gbase) + (voff)[_i]), (PG8_LAS unsigned*)(lds + (bufoff) + ldsw + _i * 8192), 16, 0, 0); } while (0)
#define PG8_LDA(dst, b, h) do { _Pragma("unroll") for (int m = 0; m < 4; ++m) _Pragma("unroll") for (int k = 0; k < 2; ++k) dst[m][k] = *(const PG8_LAS bf16x8*)(lds + PG8_SA(b, h) + aoff + m * 2048 + k * 1024); } while (0)
#define PG8_LDB(dst, b, h) do { _Pragma("unroll") for (int n = 0; n < 2; ++n) _Pragma("unroll") for (int k = 0; k < 2; ++k) dst[n][k] = *(const PG8_LAS bf16x8*)(lds + PG8_SB(b, h) + boff + n * 2048 + k * 1024); } while (0)
#define PG8_MMA(ai, bj, At, Bt) do { __builtin_amdgcn_s_setprio(1); _Pragma("unroll") for (int m = 0; m < 4; ++m) _Pragma("unroll") for (int n = 0; n < 2; ++n) _Pragma("unroll") for (int k = 0; k < 2; ++k) \
        acc[ai][bj][m][n] = __builtin_amdgcn_mfma_f32_16x16x32_bf16(Bt[n][k], At[m][k], acc[ai][bj][m][n], 0, 0, 0); __builtin_amdgcn_s_setprio(0); } while (0)
#define PG8_WAIT_V(n) asm volatile("s_waitcnt vmcnt(" #n ")" ::: "memory")
#define PG8_WAIT_L(n) asm volatile("s_waitcnt lgkmcnt(" #n ")" ::: "memory")
#define PG8_BAR __builtin_amdgcn_s_barrier()
#define PG8_SCHED __builtin_amdgcn_sched_barrier(0)
    Unit cur, nxt; int ui = 0;
    if (!S.next(0, cur)) return;
    f32x4 acc[2][2][4][2];
#pragma unroll
    for (int a = 0; a < 2; ++a)
#pragma unroll
        for (int b = 0; b < 2; ++b)
#pragma unroll
            for (int m = 0; m < 4; ++m)
#pragma unroll
                for (int n = 0; n < 2; ++n) acc[a][b][m][n] = (f32x4){0.f, 0.f, 0.f, 0.f};
    bf16x8 At[4][2], B0[2][2], B1[2][2];
    const char* cA = (const char*)g.A + (size_t)cur.pm * tstep; const char* cB = (const char*)g.Bt + (size_t)cur.pn * tstep;
    S.a_ready(cur);
    PG8_STAGE(PG8_SB(0, 0), cB, voffB); PG8_STAGE(PG8_SA(0, 0), cA, voffA); PG8_STAGE(PG8_SB(0, 1), cB + hstep, voffB); PG8_STAGE(PG8_SA(0, 1), cA + hstep, voffA);
    if (wr == 1) PG8_BAR;
    PG8_WAIT_V(4); PG8_BAR;
    PG8_STAGE(PG8_SB(1, 0), cB + kstep, voffB); PG8_STAGE(PG8_SA(1, 0), cA + kstep, voffA); PG8_STAGE(PG8_SB(1, 1), cB + hstep + kstep, voffB);
    PG8_WAIT_V(6); PG8_BAR;
    PG8_STAMP();
    for (;;) {
        const bool has_next = S.next(ui + 1, nxt);
        const char* nA = has_next ? (const char*)g.A + (size_t)nxt.pm * tstep : cA; const char* nB = has_next ? (const char*)g.Bt + (size_t)nxt.pn * tstep : cB;
        for (int t = 0; t < nt; t += 2) {
            const bool last = (t == nt - 2);
            const char* a1 = cA + (size_t)(t + 1) * kstep;
            const char* a2 = last ? nA : cA + (size_t)(t + 2) * kstep; const char* b2 = last ? nB : cB + (size_t)(t + 2) * kstep;
            const char* a3 = a2 + kstep; const char* b3 = b2 + kstep;
            if (last && has_next) S.a_ready(nxt);
            PG8_LDB(B0, 0, 0); PG8_SCHED; PG8_LDA(At, 0, 0); PG8_STAGE(PG8_SA(1, 1), a1 + hstep, voffA);
            PG8_WAIT_L(8); PG8_BAR; PG8_WAIT_L(0); PG8_MMA(0, 0, At, B0); PG8_BAR; PG8_SCHED;
            PG8_LDB(B1, 0, 1); PG8_STAGE(PG8_SB(0, 0), b2, voffB);
            PG8_BAR; PG8_WAIT_L(0); PG8_MMA(0, 1, At, B1); PG8_BAR;
            PG8_LDA(At, 0, 1); PG8_STAGE(PG8_SA(0, 0), a2, voffA);
            PG8_BAR; PG8_WAIT_L(0); PG8_MMA(1, 0, At, B0); PG8_BAR; PG8_SCHED;
            PG8_STAGE(PG8_SB(0, 1), b2 + hstep, voffB);
            PG8_WAIT_V(6); PG8_BAR; PG8_MMA(1, 1, At, B1); PG8_BAR;
            PG8_LDB(B0, 1, 0); PG8_SCHED; PG8_LDA(At, 1, 0); PG8_STAGE(PG8_SA(0, 1), a2 + hstep, voffA);
            PG8_WAIT_L(8); PG8_BAR; PG8_WAIT_L(0); PG8_MMA(0, 0, At, B0); PG8_BAR; PG8_SCHED;
            PG8_LDB(B1, 1, 1); PG8_STAGE(PG8_SB(1, 0), b3, voffB);
            PG8_BAR; PG8_WAIT_L(0); PG8_MMA(0, 1, At, B1); PG8_BAR;
            PG8_LDA(At, 1, 1); PG8_STAGE(PG8_SA(1, 0), a3, voffA);
            PG8_BAR; PG8_WAIT_L(0); PG8_MMA(1, 0, At, B0); PG8_BAR; PG8_SCHED;
            PG8_STAGE(PG8_SB(1, 1), b3 + hstep, voffB);
            PG8_WAIT_V(6); PG8_BAR; PG8_MMA(1, 1, At, B1); PG8_BAR;
        }
        PG8_STAMP();
        if constexpr (!Epi::AFTER_DRAIN) { E(acc, cur, wr, wc, fr, fq); S.done(cur); }
        PG8_STAMP();
        if (!has_next) break;
#pragma unroll
        for (int a = 0; a < 2; ++a)
#pragma unroll
            for (int b = 0; b < 2; ++b)
#pragma unroll
                for (int m = 0; m < 4; ++m)
#pragma unroll
                    for (int n = 0; n < 2; ++n) acc[a][b][m][n] = (f32x4){0.f, 0.f, 0.f, 0.f};
        cur = nxt; cA = nA; cB = nB; ++ui;
    }
    PG8_WAIT_V(0);
    if (wr == 0) PG8_BAR;
    PG8_BAR;
    if constexpr (Epi::AFTER_DRAIN) { E.fused(acc, cur, wr, wc, fr, fq, lds, wid, lane); S.done(cur); }
    PG8_STAMP();
    if (STAMP && wid == 0) { stamps[lane] = lane < nts ? (((unsigned long long)(unsigned)ts_hi << 32) | (unsigned)ts_lo) : 0ull;
        if (lane == 62) stamps[62] = rt_entry; if (lane == 63) stamps[63] = (unsigned long long)wall_clock64(); }
#undef PG8_STAMP
#undef PG8_SA
#undef PG8_SB
#undef PG8_STAGE
#undef PG8_LDA
#undef PG8_LDB
#undef PG8_MMA
#undef PG8_WAIT_V
#undef PG8_WAIT_L
#undef PG8_BAR
#undef PG8_SCHED
}
}

using pg8::bf16_t; using pg8::f32x4; using pg8::u32x4; using pg8::Unit;
#define LAS __attribute__((address_space(3)))
typedef unsigned u32x2 __attribute__((ext_vector_type(2)));

constexpr int NT = 36864, NL = 32768, NCX = 4096;
constexpr size_t MiB = 1u << 20;
constexpr size_t SLOT = 72 * MiB;
constexpr size_t FIX = 7 * SLOT;
constexpr size_t OFF_HC = FIX;
constexpr size_t OFF_WA = FIX + 16 * MiB;
constexpr size_t OFF_WB = OFF_WA + (size_t)3328 * 2048;
constexpr size_t OFF_WBL = OFF_WB + (size_t)4096 * 2048;
constexpr size_t OFF_WSC = OFF_WBL + 6 * MiB;
constexpr size_t OFF_MOD = OFF_WSC + 4 * MiB;
constexpr size_t WS_END = OFF_MOD + 1 * MiB;
constexpr size_t OFF_F = 6 * SLOT;
constexpr size_t OFF_EU = 6 * SLOT + 8 * MiB;
constexpr size_t OFF_EV = 6 * SLOT + 40 * MiB;
constexpr int LDS_BYTES = 144 * 1024;

struct Params { const float* in[27]; float* out; unsigned char* ws; int ph_lo, ph_hi, coop, pad; };

__device__ __forceinline__ float bf_lo(unsigned w) { return __uint_as_float(w << 16); }
__device__ __forceinline__ float bf_hi(unsigned w) { return __uint_as_float(w & 0xffff0000u); }
__device__ __forceinline__ float bf2f(bf16_t b) { return __uint_as_float(((unsigned)b) << 16); }
__device__ __forceinline__ unsigned pk2(float lo, float hi) { return pg8::cvt_pk_bf16(lo, hi); }
__device__ __forceinline__ bf16_t f2bf(float f) { return (bf16_t)(pk2(f, 0.f) & 0xffffu); }
__device__ __forceinline__ float sigmoidf_(float x) { return __builtin_amdgcn_rcpf(1.f + __expf(-x)); }
__device__ __forceinline__ float siluf_(float x) { return x * sigmoidf_(x); }
__device__ __forceinline__ float gelu_tanh(float x) { return x * sigmoidf_(1.5957691216f * (x + 0.044715f * x * x * x)); }
__device__ __forceinline__ float wave_sum(float v) {
#pragma unroll
    for (int o = 32; o >= 1; o >>= 1) v += __shfl_xor(v, o);
    return v;
}
__device__ __forceinline__ float wave_max(float v) {
#pragma unroll
    for (int o = 32; o >= 1; o >>= 1) v = fmaxf(v, __shfl_xor(v, o));
    return v;
}
#define LDS_FENCE() asm volatile("s_waitcnt lgkmcnt(0)" ::: "memory")

struct EpiA {
    static constexpr bool PERM = true, AFTER_DRAIN = false;
    bf16_t *X, *Q, *K, *V, *F; float qscale;
    __device__ __forceinline__ void operator()(const f32x4 (&acc)[2][2][4][2], const Unit& u, int wr, int wc, int fr, int fq) const {
        const int pn = u.pn, row0 = u.pm * 256 + wr * 64 + fr;
        if (pn == 12) {
            if (wc == 0) {
#pragma unroll
                for (int ai = 0; ai < 2; ++ai)
#pragma unroll
                    for (int m = 0; m < 4; ++m) { const f32x4 v0 = acc[ai][0][m][0], v1 = acc[ai][0][m][1]; u32x4 w; w.x = pk2(v0[0], v0[1]); w.y = pk2(v0[2], v0[3]); w.z = pk2(v1[0], v1[1]); w.w = pk2(v1[2], v1[3]);
                        *(u32x4*)(F + (size_t)(row0 + ai * 128 + m * 16) * 32 + 8 * fq) = w; }
            }
            return;
        }
        bf16_t* base; int ld, colt; float s = 1.f;
        if (pn < 4) { base = X; ld = 1024; colt = pn * 256; }
        else if (pn < 6) { base = Q; ld = 512; colt = (pn - 4) * 256; s = qscale; }
        else if (pn < 8) { base = K; ld = 512; colt = (pn - 6) * 256; }
        else { base = V; ld = 1024; colt = (pn - 8) * 256; }
        const int col0 = colt + wc * 32 + 8 * fq;
#pragma unroll
        for (int ai = 0; ai < 2; ++ai)
#pragma unroll
            for (int m = 0; m < 4; ++m) { bf16_t* rowp = base + (size_t)(row0 + ai * 128 + m * 16) * ld + col0;
#pragma unroll
                for (int bj = 0; bj < 2; ++bj) { const f32x4 v0 = acc[ai][bj][m][0] * s, v1 = acc[ai][bj][m][1] * s; u32x4 w; w.x = pk2(v0[0], v0[1]); w.y = pk2(v0[2], v0[3]); w.z = pk2(v1[0], v1[1]); w.w = pk2(v1[2], v1[3]);
                    *(u32x4*)(rowp + bj * 128) = w; } }
    }
};
struct EpiB {
    static constexpr bool PERM = true, AFTER_DRAIN = false;
    bf16_t* HF; const bf16_t* HB; bf16_t* ON; bf16_t *SGL, *SGG;
    __device__ __forceinline__ void operator()(const f32x4 (&acc)[2][2][4][2], const Unit& u, int wr, int wc, int fr, int fq) const {
        const int pn = u.pn, row0 = u.pm * 256 + wr * 64 + fr, col0 = (pn & 3) * 256 + wc * 32 + 8 * fq;
#pragma unroll
        for (int ai = 0; ai < 2; ++ai)
#pragma unroll
            for (int m = 0; m < 4; ++m) { const size_t off = (size_t)(row0 + ai * 128 + m * 16) * 1024 + col0;
#pragma unroll
                for (int bj = 0; bj < 2; ++bj) { const f32x4 v0 = acc[ai][bj][m][0], v1 = acc[ai][bj][m][1]; float a[8] = {v0[0], v0[1], v0[2], v0[3], v1[0], v1[1], v1[2], v1[3]}; float y[8];
                    const size_t o = off + bj * 128;
                    if (pn < 4) { const u32x4 hf = *(const u32x4*)(HF + o), hb = *(const u32x4*)(HB + o); const unsigned hw[4] = {hf.x, hf.y, hf.z, hf.w}, gw[4] = {hb.x, hb.y, hb.z, hb.w};
#pragma unroll
                        for (int j = 0; j < 4; ++j) { y[2 * j] = (bf_lo(hw[j]) + bf_lo(gw[j])) * gelu_tanh(a[2 * j]); y[2 * j + 1] = (bf_hi(hw[j]) + bf_hi(gw[j])) * gelu_tanh(a[2 * j + 1]); }
                        u32x4 w; w.x = pk2(y[0], y[1]); w.y = pk2(y[2], y[3]); w.z = pk2(y[4], y[5]); w.w = pk2(y[6], y[7]); *(u32x4*)(HF + o) = w; }
                    else if (pn < 8) { const u32x4 on = *(const u32x4*)(ON + o); const unsigned hw[4] = {on.x, on.y, on.z, on.w};
#pragma unroll
                        for (int j = 0; j < 4; ++j) { y[2 * j] = bf_lo(hw[j]) * siluf_(a[2 * j]); y[2 * j + 1] = bf_hi(hw[j]) * siluf_(a[2 * j + 1]); }
                        u32x4 w; w.x = pk2(y[0], y[1]); w.y = pk2(y[2], y[3]); w.z = pk2(y[4], y[5]); w.w = pk2(y[6], y[7]); *(u32x4*)(ON + o) = w; }
                    else {
#pragma unroll
                        for (int j = 0; j < 8; ++j) y[j] = sigmoidf_(a[j]);
                        u32x4 w; w.x = pk2(y[0], y[1]); w.y = pk2(y[2], y[3]); w.z = pk2(y[4], y[5]); w.w = pk2(y[6], y[7]); *(u32x4*)((pn < 12 ? SGL : SGG) + o) = w; }
                }
                asm volatile("" ::: "memory"); }
    }
};
template <int SECOND> struct EpiM {
    static constexpr bool PERM = true, AFTER_DRAIN = false;
    bf16_t* G; const bf16_t* M1;
    __device__ __forceinline__ void operator()(const f32x4 (&acc)[2][2][4][2], const Unit& u, int wr, int wc, int fr, int fq) const {
        const int row0 = u.pm * 256 + wr * 64 + fr, col0 = u.pn * 256 + wc * 32 + 8 * fq;
#pragma unroll
        for (int ai = 0; ai < 2; ++ai)
#pragma unroll
            for (int m = 0; m < 4; ++m) { const size_t off = (size_t)(row0 + ai * 128 + m * 16) * 1024 + col0;
#pragma unroll
                for (int bj = 0; bj < 2; ++bj) { const f32x4 v0 = acc[ai][bj][m][0], v1 = acc[ai][bj][m][1]; const float a[8] = {v0[0], v0[1], v0[2], v0[3], v1[0], v1[1], v1[2], v1[3]}; float y[8];
                    const size_t o = off + bj * 128; const u32x4 g = *(const u32x4*)(G + o); const unsigned gw[4] = {g.x, g.y, g.z, g.w};
                    if (SECOND) { const u32x4 p1 = *(const u32x4*)(M1 + o); const unsigned pw[4] = {p1.x, p1.y, p1.z, p1.w};
#pragma unroll
                        for (int j = 0; j < 4; ++j) { y[2 * j] = bf_lo(pw[j]) + bf_lo(gw[j]) * a[2 * j]; y[2 * j + 1] = bf_hi(pw[j]) + bf_hi(gw[j]) * a[2 * j + 1]; } }
                    else {
#pragma unroll
                        for (int j = 0; j < 4; ++j) { y[2 * j] = bf_lo(gw[j]) * a[2 * j]; y[2 * j + 1] = bf_hi(gw[j]) * a[2 * j + 1]; } }
                    u32x4 w; w.x = pk2(y[0], y[1]); w.y = pk2(y[2], y[3]); w.z = pk2(y[4], y[5]); w.w = pk2(y[6], y[7]); *(u32x4*)(G + o) = w; }
                asm volatile("" ::: "memory"); }
    }
};
struct EpiOut {
    static constexpr bool PERM = false, AFTER_DRAIN = false;
    const float *inL, *inC; float *outL, *outC; const float* mod;
    __device__ __forceinline__ void operator()(const f32x4 (&acc)[2][2][4][2], const Unit& u, int wr, int wc, int fr, int fq) const {
        const bool lat = u.pm < 128; const int prow = (lat ? u.pm : u.pm - 128) * 256 + wr * 64 + fr, col0 = u.pn * 256 + wc * 32 + 4 * fq;
        const float* src = lat ? inL : inC; float* dst = lat ? outL : outC; const float* g1 = mod + (size_t)(lat ? (u.pm >> 3) : 16) * 6144 + 2048 + col0;
        f32x4 gv[2][2];
#pragma unroll
        for (int bj = 0; bj < 2; ++bj)
#pragma unroll
            for (int n = 0; n < 2; ++n) gv[bj][n] = *(const f32x4*)(g1 + bj * 128 + n * 16);
#pragma unroll
        for (int ai = 0; ai < 2; ++ai)
#pragma unroll
            for (int m = 0; m < 4; ++m) { const size_t off = (size_t)(prow + ai * 128 + m * 16) * 1024 + col0;
#pragma unroll
                for (int bj = 0; bj < 2; ++bj)
#pragma unroll
                    for (int n = 0; n < 2; ++n) { const f32x4 h = *(const f32x4*)(src + off + bj * 128 + n * 16); *(f32x4*)(dst + off + bj * 128 + n * 16) = h + gv[bj][n] * acc[ai][bj][m][n]; }
                asm volatile("" ::: "memory"); }
    }
};
struct EpiSc {
    static constexpr bool PERM = false, AFTER_DRAIN = false;
    float* SC;
    __device__ __forceinline__ void operator()(const f32x4 (&acc)[2][2][4][2], const Unit& u, int wr, int wc, int fr, int fq) const {
        const int row0 = u.pm * 256 + wr * 64 + fr, col0 = u.pn * 256 + wc * 32 + 4 * fq;
#pragma unroll
        for (int ai = 0; ai < 2; ++ai)
#pragma unroll
            for (int m = 0; m < 4; ++m) { float* rowp = SC + (size_t)(row0 + ai * 128 + m * 16) * 2048 + col0;
#pragma unroll
                for (int bj = 0; bj < 2; ++bj)
#pragma unroll
                    for (int n = 0; n < 2; ++n) *(f32x4*)(rowp + bj * 128 + n * 16) = acc[ai][bj][m][n]; }
    }
};

__device__ __forceinline__ void transpose_item(const float* W, int N, bf16_t* WT, int drow, int k0, int n0, LAS float* scr, int lane) {
#pragma unroll 8
    for (int i = 0; i < 32; ++i) { const int kk = 2 * i + (lane >> 5); scr[kk * 33 + (lane & 31)] = W[(size_t)(k0 + kk) * N + n0 + (lane & 31)]; }
    LDS_FENCE();
    const int c = lane & 7;
#pragma unroll
    for (int j = 0; j < 4; ++j) { const int n = (lane >> 3) + 8 * j; const LAS float* s = scr + (8 * c) * 33 + n;
        u32x4 o; o.x = pk2(s[0 * 33], s[1 * 33]); o.y = pk2(s[2 * 33], s[3 * 33]); o.z = pk2(s[4 * 33], s[5 * 33]); o.w = pk2(s[6 * 33], s[7 * 33]);
        *(u32x4*)(WT + (size_t)(drow + n) * 1024 + k0 + 8 * c) = o; }
    LDS_FENCE();
}
__device__ __forceinline__ void prep_phase(const Params& p, int layer, LAS unsigned char* lds, int tid, int lane, int wave) {
    unsigned char* ws = p.ws;
    const int gw = blockIdx.x * 8 + wave, NGW = gridDim.x * 8;
    if (layer == 0) {
        LAS float* sc = (LAS float*)(lds + 69632);
        LAS float* red = (LAS float*)lds;
        for (int e = tid; e < 17 * 1024; e += 512) { const int r = e >> 10, k = e & 1023; const float c = r < 16 ? p.in[1][r * 1024 + k] : p.in[3][k]; sc[e] = siluf_(c); }
        __syncthreads();
        float* MOD = (float*)(ws + OFF_MOD);
        for (int it = blockIdx.x; it < 192; it += gridDim.x) {
            const int l = it / 96, n0 = (it % 96) * 64;
            float acc[17];
#pragma unroll
            for (int r = 0; r < 17; ++r) acc[r] = 0.f;
            const float* wm = p.in[4] + ((size_t)l * 1024 + wave * 128) * 6144 + n0 + lane;
#pragma unroll 4
            for (int k = 0; k < 128; ++k) { const float w = wm[(size_t)k * 6144];
#pragma unroll
                for (int r = 0; r < 17; ++r) acc[r] += sc[r * 1024 + wave * 128 + k] * w; }
#pragma unroll
            for (int r = 0; r < 17; ++r) red[(wave * 17 + r) * 64 + lane] = acc[r];
            __syncthreads();
            for (int e = tid; e < 17 * 64; e += 512) { const int r = e >> 6, nn = e & 63; float s = p.in[5][l * 6144 + n0 + nn];
#pragma unroll
                for (int w = 0; w < 8; ++w) s += red[(w * 17 + r) * 64 + nn];
                MOD[((size_t)l * 17 + r) * 6144 + n0 + nn] = s; }
            __syncthreads();
        }
    }
    LAS float* scr = (LAS float*)(lds + wave * 8448);
    bf16_t* WA = (bf16_t*)(ws + OFF_WA); bf16_t* WB = (bf16_t*)(ws + OFF_WB);
    const float* w_in = p.in[8] + (size_t)layer * 1024 * 7200;
    for (int it = gw; it < 5136; it += NGW) {
        const float* W; int N, kb, nb, drow; bf16_t* WT;
        if (it < 3600) { kb = it / 225; nb = it % 225; W = w_in; N = 7200; const int n0 = nb * 32;
            if (n0 < 1024) { WT = WA; drow = n0; }
            else if (n0 < 2048) { WT = WB; drow = n0 - 1024; }
            else if (n0 < 2560) { WT = WA; drow = 1024 + (n0 - 2048); }
            else if (n0 < 3072) { WT = WA; drow = 1536 + (n0 - 2560); }
            else if (n0 < 4096) { WT = WA; drow = 2048 + (n0 - 3072); }
            else if (n0 < 5120) { WT = WB; drow = 1024 + (n0 - 4096); }
            else if (n0 < 5152) { WT = WA; drow = 3072; }
            else if (n0 < 6176) { WT = WB; drow = 2048 + (n0 - 5152); }
            else { WT = WB; drow = 3072 + (n0 - 6176); }
        } else { int r = it - 3600; const int mi = r / 512; r %= 512; kb = r / 32; nb = r % 32; N = 1024; W = p.in[19 + mi] + (size_t)layer * 1024 * 1024; WT = (bf16_t*)(ws + OFF_WBL + (size_t)mi * 2 * MiB); drow = nb * 32; }
        transpose_item(W, N, WT, drow, kb * 64, nb * 32, scr, lane);
    }
    for (int i = blockIdx.x * 512 + tid; i < 224 * 1024 / 8; i += gridDim.x * 512) ((u32x4*)(WA + (size_t)3104 * 1024))[i] = (u32x4){0u, 0u, 0u, 0u};
    const float* wq = p.in[22] + (size_t)layer * 1024 * 2048; const float* keys = p.in[23] + (size_t)layer * 2 * 128 * 128; bf16_t* WSC = (bf16_t*)(ws + OFF_WSC);
    for (int it = gw; it < 2048; it += NGW) {
        const int hz = it >> 7, i0 = (it & 127) * 8, z = hz & 1;
        float a0[8], a1[8];
#pragma unroll
        for (int ii = 0; ii < 8; ++ii) { a0[ii] = 0.f; a1[ii] = 0.f; }
        const float* kr0 = keys + (size_t)(z * 128 + lane) * 128; const float* kr1 = kr0 + 64 * 128; const float* wr_ = wq + (size_t)i0 * 2048 + hz * 128;
        for (int d4 = 0; d4 < 32; ++d4) { const f32x4 k0 = *(const f32x4*)(kr0 + 4 * d4), k1 = *(const f32x4*)(kr1 + 4 * d4);
#pragma unroll
            for (int ii = 0; ii < 8; ++ii) { const f32x4 q = *(const f32x4*)(wr_ + (size_t)ii * 2048 + 4 * d4);
                a0[ii] += q[0] * k0[0] + q[1] * k0[1] + q[2] * k0[2] + q[3] * k0[3]; a1[ii] += q[0] * k1[0] + q[1] * k1[1] + q[2] * k1[2] + q[3] * k1[3]; } }
        u32x4 o; o.x = pk2(a0[0], a0[1]); o.y = pk2(a0[2], a0[3]); o.z = pk2(a0[4], a0[5]); o.w = pk2(a0[6], a0[7]); *(u32x4*)(WSC + (size_t)(hz * 128 + lane) * 1024 + i0) = o;
        o.x = pk2(a1[0], a1[1]); o.y = pk2(a1[2], a1[3]); o.z = pk2(a1[4], a1[5]); o.w = pk2(a1[6], a1[7]); *(u32x4*)(WSC + (size_t)(hz * 128 + 64 + lane) * 1024 + i0) = o;
    }
}
__device__ __forceinline__ void norm_phase(const Params& p, int layer, int which, int nrows, const float* HL, const float* HCp, int lane, int wave) {
    const int gw = blockIdx.x * 8 + wave, NGW = gridDim.x * 8;
    bf16_t* HN = (bf16_t*)p.ws; const float* MOD = (const float*)(p.ws + OFF_MOD) + (size_t)layer * 17 * 6144 + which * 3072; const float* gn = p.in[6 + which] + layer * 1024;
    for (int r = gw; r < nrows; r += NGW) {
        const float* src = r < NL ? HL + (size_t)r * 1024 : HCp + (size_t)(r - NL) * 1024; const float* md = MOD + (size_t)(r < NL ? (r >> 11) : 16) * 6144;
        f32x4 v[4]; float ss = 0.f;
#pragma unroll
        for (int j = 0; j < 4; ++j) { v[j] = ((const f32x4*)src)[lane + 64 * j]; ss += v[j][0] * v[j][0] + v[j][1] * v[j][1] + v[j][2] * v[j][2] + v[j][3] * v[j][3]; }
        const float rstd = rsqrtf(wave_sum(ss) * (1.f / 1024.f) + 1e-6f);
#pragma unroll
        for (int j = 0; j < 4; ++j) { const f32x4 g = ((const f32x4*)gn)[lane + 64 * j], sh = ((const f32x4*)md)[lane + 64 * j], sc = ((const f32x4*)(md + 1024))[lane + 64 * j];
            const f32x4 y = v[j] * rstd * g * (sc + 1.f) + sh; u32x2 o; o.x = pk2(y[0], y[1]); o.y = pk2(y[2], y[3]); ((u32x2*)(HN + (size_t)r * 1024))[lane + 64 * j] = o; }
    }
}
__device__ __forceinline__ int gla_row(int b, int dir, int s) {
    if (s < 256) return NL + b * 256 + (dir ? 255 - s : s);
    const int j = dir ? 2047 - (s - 256) : (s - 256);
    return b * 2048 + (j & 31) * 64 + (j >> 5);
}
__device__ __forceinline__ void gla_naive_phase(const Params& p, int layer, LAS unsigned char* lds, int tid) {
    const bf16_t* Q = (const bf16_t*)(p.ws + 3 * SLOT); const bf16_t* K = Q + (size_t)NT * 512; const bf16_t* V = (const bf16_t*)(p.ws + 2 * SLOT); const bf16_t* F = (const bf16_t*)(p.ws + OFF_F);
    LAS float* sA = (LAS float*)lds; LAS float* sK = sA + 512; LAS float* sQ = sK + 512; LAS float* sO = sQ + 512;
    const int tt = tid >> 7, dkk = tid & 127, dv = tid & 255, half = tid >> 8;
    for (int item = blockIdx.x; item < 128; item += gridDim.x) {
        const int b = item >> 3, h = (item >> 1) & 3, dir = item & 1;
        bf16_t* O = (bf16_t*)(p.ws + (size_t)(4 + dir) * SLOT);
        const float* wf = p.in[16] + ((size_t)(layer * 2 + dir) * 16) * 512 + h * 128 + dkk; const float bfv = p.in[17][(layer * 2 + dir) * 512 + h * 128 + dkk];
        float wfr[16];
#pragma unroll
        for (int j = 0; j < 16; ++j) wfr[j] = wf[j * 512];
        float S[64];
#pragma unroll
        for (int i = 0; i < 64; ++i) S[i] = 0.f;
        for (int s4 = 0; s4 < 576; ++s4) {
            { const int r = gla_row(b, dir, s4 * 4 + tt);
              const u32x4* fp = (const u32x4*)(F + (size_t)r * 32 + dir * 16); const u32x4 f0 = fp[0], f1 = fp[1]; const unsigned fw[8] = {f0.x, f0.y, f0.z, f0.w, f1.x, f1.y, f1.z, f1.w};
              float z = bfv;
#pragma unroll
              for (int j = 0; j < 8; ++j) z += bf_lo(fw[j]) * wfr[2 * j] + bf_hi(fw[j]) * wfr[2 * j + 1];
              const float lg = (fminf(z, 0.f) - log1pf(__expf(-fabsf(z)))) * (1.f / 16.f);
              sA[tid] = __expf(lg); sK[tid] = bf2f(K[(size_t)r * 512 + h * 128 + dkk]); sQ[tid] = bf2f(Q[(size_t)r * 512 + h * 128 + dkk]); }
            __syncthreads();
#pragma unroll
            for (int t4 = 0; t4 < 4; ++t4) { const int r = gla_row(b, dir, s4 * 4 + t4); const float v = bf2f(V[(size_t)r * 1024 + h * 256 + dv]); float op = 0.f;
#pragma unroll
                for (int i = 0; i < 64; ++i) { const int dk = t4 * 128 + half * 64 + i; S[i] = sA[dk] * S[i] + sK[dk] * v; op += sQ[dk] * S[i]; }
                sO[(t4 * 2 + half) * 256 + dv] = op; }
            __syncthreads();
            for (int e = tid; e < 1024; e += 512) { const int t4 = e >> 8, d = e & 255; const int r = gla_row(b, dir, s4 * 4 + t4); O[(size_t)r * 1024 + h * 256 + d] = f2bf(sO[(t4 * 2) * 256 + d] + sO[(t4 * 2 + 1) * 256 + d]); }
        }
        __syncthreads();
    }
}
template <int DIR> __device__ __forceinline__ void lru_naive_item(const Params& p, int layer, int b, int hb, int lane) {
    const int c = hb * 64 + lane;
    const bf16_t* X = (const bf16_t*)(p.ws + 1 * SLOT); bf16_t* Hd = (bf16_t*)(p.ws + (size_t)(DIR ? 2 : 3) * SLOT);
    const float* wa = p.in[11] + ((size_t)((layer * 2 + DIR) * 16 + hb) * 64) * 64 + lane; const float* wx = p.in[13] + ((size_t)((layer * 2 + DIR) * 16 + hb) * 64) * 64 + lane;
    float war[64], wxr[64];
#pragma unroll
    for (int i = 0; i < 64; ++i) { war[i] = wa[i * 64]; wxr[i] = wx[i * 64]; }
    const float ba = p.in[12][(layer * 2 + DIR) * 1024 + c], bx = p.in[14][(layer * 2 + DIR) * 1024 + c], lam = p.in[15][(layer * 2 + DIR) * 1024 + c];
    const float cl = -8.f * (fmaxf(-lam, 0.f) + log1pf(__expf(-fabsf(lam))));
    const float cw0 = p.in[9][(layer * 4 + 0) * 1024 + c], cw1 = p.in[9][(layer * 4 + 1) * 1024 + c], cw2 = p.in[9][(layer * 4 + 2) * 1024 + c], cw3 = p.in[9][(layer * 4 + 3) * 1024 + c], cb = p.in[10][layer * 1024 + c];
    float h = 0.f;
    for (int seg = 0; seg < 2; ++seg) {
        const int L = seg ? 2048 : 256; const size_t base = seg ? (size_t)b * 2048 : (size_t)NL + (size_t)b * 256;
        for (int ch = 0; ch < L / 16; ++ch) {
            const int tb = DIR ? L - 16 - ch * 16 : ch * 16;
            float xv[19];
#pragma unroll
            for (int j = 0; j < 19; ++j) { const int t = tb - 2 + j; xv[j] = (t >= 0 && t < L) ? bf2f(X[(base + t) * 1024 + c]) : 0.f; }
#pragma unroll
            for (int i = 0; i < 16; ++i) { const int q = DIR ? 15 - i : i;
                const float xr = cb + cw0 * xv[q] + cw1 * xv[q + 1] + cw2 * xv[q + 2] + cw3 * xv[q + 3];
                float ra = ba, ri = bx;
#pragma unroll
                for (int k = 0; k < 64; ++k) { const float xk = __int_as_float(__builtin_amdgcn_readlane(__float_as_int(xr), k)); ra += xk * war[k]; ri += xk * wxr[k]; }
                const float rg = sigmoidf_(ra), ig = sigmoidf_(ri), la = cl * rg, a = __expf(la), uu = sqrtf(fmaxf(-expm1f(2.f * la), 0.f)) * ig * xr;
                h = a * h + uu;
                Hd[(base + tb + q) * 1024 + c] = f2bf(h); }
        }
    }
}
__device__ __forceinline__ void lru_naive_phase(const Params& p, int layer, int lane, int wave) {
    const int gw = wave * gridDim.x + blockIdx.x, NGW = gridDim.x * 8;
    for (int item = gw; item < 512; item += NGW) { const int b = item >> 5, hb = (item >> 1) & 15;
        if (item & 1) lru_naive_item<1>(p, layer, b, hb, lane); else lru_naive_item<0>(p, layer, b, hb, lane); }
}
__device__ __forceinline__ void onorm_phase(const Params& p, int layer, int tid, int lane, int wave) {
    const int gw = blockIdx.x * 8 + wave, NGW = gridDim.x * 8;
    bf16_t* OF = (bf16_t*)(p.ws + 4 * SLOT); const bf16_t* OB = (const bf16_t*)(p.ws + 5 * SLOT); const float* ng = p.in[18] + layer * 1024 + 16 * lane;
    const int nrows = layer == 1 ? NL : NT;
    for (int r = gw; r < nrows; r += NGW) {
        const u32x4* a = (const u32x4*)(OF + (size_t)r * 1024 + 16 * lane); const u32x4* bq = (const u32x4*)(OB + (size_t)r * 1024 + 16 * lane);
        const u32x4 a0 = a[0], a1 = a[1], b0 = bq[0], b1 = bq[1]; const unsigned aw[8] = {a0.x, a0.y, a0.z, a0.w, a1.x, a1.y, a1.z, a1.w}, bw[8] = {b0.x, b0.y, b0.z, b0.w, b1.x, b1.y, b1.z, b1.w};
        float o[16], ss = 0.f;
#pragma unroll
        for (int j = 0; j < 8; ++j) { o[2 * j] = bf_lo(aw[j]) + bf_lo(bw[j]); o[2 * j + 1] = bf_hi(aw[j]) + bf_hi(bw[j]); ss += o[2 * j] * o[2 * j] + o[2 * j + 1] * o[2 * j + 1]; }
#pragma unroll
        for (int of = 1; of < 16; of <<= 1) ss += __shfl_xor(ss, of);
        const float rs = rsqrtf(ss * (1.f / 256.f) + 1e-6f);
        u32x4 w0, w1; const f32x4 g0 = ((const f32x4*)ng)[0], g1 = ((const f32x4*)ng)[1], g2 = ((const f32x4*)ng)[2], g3 = ((const f32x4*)ng)[3];
        w0.x = pk2(o[0] * rs * g0[0], o[1] * rs * g0[1]); w0.y = pk2(o[2] * rs * g0[2], o[3] * rs * g0[3]); w0.z = pk2(o[4] * rs * g1[0], o[5] * rs * g1[1]); w0.w = pk2(o[6] * rs * g1[2], o[7] * rs * g1[3]);
        w1.x = pk2(o[8] * rs * g2[0], o[9] * rs * g2[1]); w1.y = pk2(o[10] * rs * g2[2], o[11] * rs * g2[3]); w1.z = pk2(o[12] * rs * g3[0], o[13] * rs * g3[1]); w1.w = pk2(o[14] * rs * g3[2], o[15] * rs * g3[3]);
        u32x4* d = (u32x4*)(OF + (size_t)r * 1024 + 16 * lane); d[0] = w0; d[1] = w1;
    }
    const f32x4* eu = (const f32x4*)(p.in[24] + (size_t)layer * 16384 * 1024); const f32x4* ev = (const f32x4*)(p.in[25] + (size_t)layer * 16384 * 1024);
    u32x4* EU = (u32x4*)(p.ws + OFF_EU); u32x4* EV = (u32x4*)(p.ws + OFF_EV);
    for (int i = blockIdx.x * 512 + tid; i < 16384 * 1024 / 8; i += gridDim.x * 512) {
        const f32x4 a = eu[2 * i], b = eu[2 * i + 1], c = ev[2 * i], d = ev[2 * i + 1];
        u32x4 w; w.x = pk2(a[0], a[1]); w.y = pk2(a[2], a[3]); w.z = pk2(b[0], b[1]); w.w = pk2(b[2], b[3]); EU[i] = w;
        w.x = pk2(c[0], c[1]); w.y = pk2(c[2], c[3]); w.z = pk2(d[0], d[1]); w.w = pk2(d[2], d[3]); EV[i] = w;
    }
}
__device__ __forceinline__ void peer_phase(const Params& p, int layer, LAS unsigned char* lds, int lane, int wave) {
    const int gw = blockIdx.x * 8 + wave, NGW = gridDim.x * 8;
    const int nrows = layer == 1 ? NL : NT;
    const float* SC = (const float*)(p.ws + 1 * SLOT); bf16_t* HN = (bf16_t*)p.ws;
    const bf16_t* EU = (const bf16_t*)(p.ws + OFF_EU); const bf16_t* EV = (const bf16_t*)(p.ws + OFF_EV);
    const float* MODL = (const float*)(p.ws + OFF_MOD) + (size_t)layer * 17 * 6144;
    LAS float* topv = (LAS float*)(lds + wave * 4096); LAS int* topi = (LAS int*)(topv + 256); LAS float* selw = (LAS float*)(topi + 256); LAS int* sele = (LAS int*)(selw + 128);
    const float NINF = -__builtin_huge_valf();
    for (int r = gw; r < nrows; r += NGW) {
        const float* sc = SC + (size_t)r * 2048;
        for (int g = 0; g < 16; ++g) {
            float a0 = sc[g * 128 + lane], a1 = sc[g * 128 + 64 + lane]; float tv = 0.f; int ti = 0;
            for (int it = 0; it < 16; ++it) {
                const float m = wave_max(fmaxf(a0, a1));
                const unsigned long long b0 = __ballot(a0 == m); int idx;
                if (b0) { const int l0 = __ffsll((long long)b0) - 1; idx = l0; if (lane == l0) a0 = NINF; }
                else { const unsigned long long b1 = __ballot(a1 == m); const int l1 = __ffsll((long long)b1) - 1; idx = 64 + l1; if (lane == l1) a1 = NINF; }
                if (lane == it) { tv = m; ti = idx; }
            }
            if (lane < 16) { topv[g * 16 + lane] = tv; topi[g * 16 + lane] = ti; }
        }
        LDS_FENCE();
        for (int h = 0; h < 8; ++h) {
            float cs[4]; int ci[4]; const int jj = lane & 15; const float bvj = topv[(2 * h + 1) * 16 + jj]; const int bij = topi[(2 * h + 1) * 16 + jj];
#pragma unroll
            for (int m = 0; m < 4; ++m) { const int ii = (lane >> 4) + 4 * m; cs[m] = topv[(2 * h) * 16 + ii] + bvj; ci[m] = topi[(2 * h) * 16 + ii] * 128 + bij; }
            float bs = NINF; int be = 0;
            for (int it = 0; it < 16; ++it) {
                const float lm = fmaxf(fmaxf(cs[0], cs[1]), fmaxf(cs[2], cs[3])); const float m = wave_max(lm);
                const unsigned long long bb = __ballot(lm == m); const int l0 = __ffsll((long long)bb) - 1; int e = 0;
                if (lane == l0) { if (cs[0] == m) { e = ci[0]; cs[0] = NINF; } else if (cs[1] == m) { e = ci[1]; cs[1] = NINF; } else if (cs[2] == m) { e = ci[2]; cs[2] = NINF; } else { e = ci[3]; cs[3] = NINF; } }
                e = __shfl(e, l0);
                if (lane == it) { bs = m; be = e; }
            }
            const float mx = __shfl(bs, 0); const float ex = lane < 16 ? __expf(bs - mx) : 0.f; const float sum = wave_sum(ex);
            if (lane < 16) { selw[h * 16 + lane] = ex / sum; sele[h * 16 + lane] = be; }
        }
        LDS_FENCE();
        float hn[16], acc[16];
        { const u32x4* hp = (const u32x4*)(HN + (size_t)r * 1024 + 16 * lane); const u32x4 w0 = hp[0], w1 = hp[1]; const unsigned hw[8] = {w0.x, w0.y, w0.z, w0.w, w1.x, w1.y, w1.z, w1.w};
#pragma unroll
          for (int j = 0; j < 8; ++j) { hn[2 * j] = bf_lo(hw[j]); hn[2 * j + 1] = bf_hi(hw[j]); acc[2 * j] = 0.f; acc[2 * j + 1] = 0.f; } }
        for (int q8 = 0; q8 < 16; ++q8) {
            u32x4 ua[8], ub[8]; float wk[8];
#pragma unroll
            for (int q = 0; q < 8; ++q) { const int e = sele[q8 * 8 + q]; const u32x4* up = (const u32x4*)(EU + (size_t)e * 1024 + 16 * lane); ua[q] = up[0]; ub[q] = up[1]; }
#pragma unroll
            for (int q = 0; q < 8; ++q) { const unsigned uw[8] = {ua[q].x, ua[q].y, ua[q].z, ua[q].w, ub[q].x, ub[q].y, ub[q].z, ub[q].w}; float d = 0.f;
#pragma unroll
                for (int j = 0; j < 8; ++j) d += hn[2 * j] * bf_lo(uw[j]) + hn[2 * j + 1] * bf_hi(uw[j]);
                d = wave_sum(d); wk[q] = selw[q8 * 8 + q] * gelu_tanh(d); }
#pragma unroll
            for (int q = 0; q < 8; ++q) { const int e = sele[q8 * 8 + q]; const u32x4* vp = (const u32x4*)(EV + (size_t)e * 1024 + 16 * lane); ua[q] = vp[0]; ub[q] = vp[1]; }
#pragma unroll
            for (int q = 0; q < 8; ++q) { const unsigned vw[8] = {ua[q].x, ua[q].y, ua[q].z, ua[q].w, ub[q].x, ub[q].y, ub[q].z, ub[q].w};
#pragma unroll
                for (int j = 0; j < 8; ++j) { acc[2 * j] += wk[q] * bf_lo(vw[j]); acc[2 * j + 1] += wk[q] * bf_hi(vw[j]); } }
        }
        float* hp = (r < NL ? p.out + (size_t)r * 1024 : (float*)(p.ws + OFF_HC) + (size_t)(r - NL) * 1024) + 16 * lane; const int mrow = r < NL ? (r >> 11) : 16;
        const float* g2 = MODL + (size_t)mrow * 6144 + 5120 + 16 * lane; float hv[16], ss = 0.f;
#pragma unroll
        for (int j = 0; j < 4; ++j) { const f32x4 h4 = ((const f32x4*)hp)[j], g4 = ((const f32x4*)g2)[j];
#pragma unroll
            for (int i = 0; i < 4; ++i) { const float y = h4[i] + g4[i] * acc[4 * j + i]; hv[4 * j + i] = y; ss += y * y; } }
        const float rstd = rsqrtf(wave_sum(ss) * (1.f / 1024.f) + 1e-6f);
        if (layer == 0) {
#pragma unroll
            for (int j = 0; j < 4; ++j) ((f32x4*)hp)[j] = (f32x4){hv[4 * j], hv[4 * j + 1], hv[4 * j + 2], hv[4 * j + 3]};
            const float* md = MODL + 17 * 6144 + (size_t)mrow * 6144 + 16 * lane; const float* gn = p.in[6] + 1024 + 16 * lane; float y[16];
#pragma unroll
            for (int j = 0; j < 16; ++j) y[j] = hv[j] * rstd * gn[j] * (1.f + md[1024 + j]) + md[j];
            u32x4 w0, w1; w0.x = pk2(y[0], y[1]); w0.y = pk2(y[2], y[3]); w0.z = pk2(y[4], y[5]); w0.w = pk2(y[6], y[7]); w1.x = pk2(y[8], y[9]); w1.y = pk2(y[10], y[11]); w1.z = pk2(y[12], y[13]); w1.w = pk2(y[14], y[15]);
            u32x4* d = (u32x4*)(HN + (size_t)r * 1024 + 16 * lane); d[0] = w0; d[1] = w1;
        } else {
            const float* gn = p.in[26] + 16 * lane;
#pragma unroll
            for (int j = 0; j < 4; ++j) ((f32x4*)hp)[j] = (f32x4){hv[4 * j] * rstd * gn[4 * j], hv[4 * j + 1] * rstd * gn[4 * j + 1], hv[4 * j + 2] * rstd * gn[4 * j + 2], hv[4 * j + 3] * rstd * gn[4 * j + 3]};
        }
    }
}

constexpr int N_PHASES = 25;
#ifndef ONLY
#define ONLY -1
#endif
#define EN(k) (ONLY < 0 || ONLY == (k))
template <class Epi> __device__ __forceinline__ void run_gemm(LAS unsigned char* lds, const bf16_t* A, const bf16_t* Bt, int M, int N, const Epi& E) {
    pg8::Gemm g{A, Bt, M, N, 1024}; pg8::StaticOrder S; S.init(M, N, (int)gridDim.x, (int)blockIdx.x);
    pg8::gemm_phase<Epi, pg8::StaticOrder, false>(lds, g, S, E, nullptr);
}
__global__ void __launch_bounds__(512, 2) fwd_kernel(Params p) {
    extern __shared__ __attribute__((aligned(16))) unsigned char lds_raw[];
    LAS unsigned char* lds = (LAS unsigned char*)lds_raw;
    cg::grid_group grid = cg::this_grid();
    unsigned char* ws = p.ws;
    bf16_t* HN = (bf16_t*)ws; float* HC = (float*)(ws + OFF_HC);
    for (int ph = p.ph_lo; ph < p.ph_hi; ++ph) {
        int tid_l = threadIdx.x; asm volatile("" : "+v"(tid_l));
        const int tid = tid_l, lane = tid & 63, wave = __builtin_amdgcn_readfirstlane(tid >> 6);
        if (ph == 0 && EN(20)) prep_phase(p, 0, lds, tid, lane, wave);
        else if (ph == 1 && EN(21)) norm_phase(p, 0, 0, NT, p.in[0], p.in[2], lane, wave);
        else {
            const int layer = (ph - 2) / 12, sub = (ph - 2) % 12, M = layer ? NL : NT;
            if (sub == 0 && EN(0)) { EpiA E{(bf16_t*)(ws + 1 * SLOT), (bf16_t*)(ws + 3 * SLOT), (bf16_t*)(ws + 3 * SLOT) + (size_t)NT * 512, (bf16_t*)(ws + 2 * SLOT), (bf16_t*)(ws + OFF_F), 0.08838834764831845f};
                run_gemm(lds, HN, (const bf16_t*)(ws + OFF_WA), NT, 3328, E); }
            else if (sub == 1 && EN(1)) gla_naive_phase(p, layer, lds, tid);
            else if (sub == 2 && EN(2)) lru_naive_phase(p, layer, lane, wave);
            else if (sub == 3 && EN(3)) onorm_phase(p, layer, tid, lane, wave);
            else if (sub == 4 && EN(4)) { EpiB E{(bf16_t*)(ws + 3 * SLOT), (const bf16_t*)(ws + 2 * SLOT), (bf16_t*)(ws + 4 * SLOT), (bf16_t*)(ws + 1 * SLOT), (bf16_t*)(ws + 5 * SLOT)};
                run_gemm(lds, HN, (const bf16_t*)(ws + OFF_WB), M, 4096, E); }
            else if (sub == 5 && EN(5)) { EpiM<0> E{(bf16_t*)(ws + 1 * SLOT), nullptr}; run_gemm(lds, (const bf16_t*)(ws + 3 * SLOT), (const bf16_t*)(ws + OFF_WBL), M, 1024, E); }
            else if (sub == 6 && EN(6)) { EpiM<1> E{(bf16_t*)(ws + 5 * SLOT), (const bf16_t*)(ws + 1 * SLOT)}; run_gemm(lds, (const bf16_t*)(ws + 4 * SLOT), (const bf16_t*)(ws + OFF_WBL + 2 * MiB), M, 1024, E); }
            else if (sub == 7 && EN(7)) { EpiOut E{layer ? p.out : p.in[0], layer ? HC : p.in[2], p.out, HC, (const float*)(ws + OFF_MOD) + (size_t)layer * 17 * 6144};
                run_gemm(lds, (const bf16_t*)(ws + 5 * SLOT), (const bf16_t*)(ws + OFF_WBL + 4 * MiB), M, 1024, E); }
            else if (sub == 8 && EN(8)) norm_phase(p, layer, 1, M, p.out, HC, lane, wave);
            else if (sub == 9 && EN(9)) { EpiSc E{(float*)(ws + 1 * SLOT)}; run_gemm(lds, HN, (const bf16_t*)(ws + OFF_WSC), M, 2048, E); }
            else if (sub == 10 && EN(10)) peer_phase(p, layer, lds, lane, wave);
            else if (layer == 0 && EN(20)) prep_phase(p, 1, lds, tid, lane, wave);
        }
        if (p.coop && ph + 1 < p.ph_hi) grid.sync();
    }
}

extern "C" void kernel_launch(void* const* d_in, const int* in_sizes, int n_in, void* d_out, int out_size, void* d_ws, size_t ws_size, hipStream_t stream) {
    static int grid_blocks = 0;
    if (!grid_blocks) {
        int dev = 0, cus = 0, per_cu = 0;
        (void)hipGetDevice(&dev);
        (void)hipDeviceGetAttribute(&cus, hipDeviceAttributeMultiprocessorCount, dev);
        (void)hipFuncSetAttribute((const void*)fwd_kernel, hipFuncAttributeMaxDynamicSharedMemorySize, LDS_BYTES);
        (void)hipOccupancyMaxActiveBlocksPerMultiprocessor(&per_cu, (const void*)fwd_kernel, 512, LDS_BYTES);
        if (per_cu < 1) { fprintf(stderr, "kernel_launch: occupancy query says %d blocks per CU\n", per_cu); per_cu = 1; }
        grid_blocks = cus * per_cu;
        fprintf(stderr, "kernel_launch: cus %d per_cu %d grid %d ws %zu need %zu\n", cus, per_cu, grid_blocks, ws_size, (size_t)WS_END);
    }
    if (n_in != 27 || ws_size < WS_END) { fprintf(stderr, "kernel_launch: bad inputs (n_in %d, ws %zu < %zu)\n", n_in, ws_size, (size_t)WS_END); return; }
    Params p{};
    for (int i = 0; i < 27; ++i) p.in[i] = (const float*)d_in[i];
    p.out = (float*)d_out; p.ws = (unsigned char*)d_ws; p.ph_lo = 0; p.ph_hi = N_PHASES; p.coop = 1; p.pad = 0;
#if defined(MULTI_LAUNCH)
    p.coop = 0;
    for (int ph = 0; ph < N_PHASES; ++ph) { p.ph_lo = ph; p.ph_hi = ph + 1; hipLaunchKernelGGL(fwd_kernel, dim3(grid_blocks), dim3(512), LDS_BYTES, stream, p); }
#else
    void* args[] = {&p};
    hipError_t e = hipLaunchCooperativeKernel((void*)fwd_kernel, dim3(grid_blocks), dim3(512), args, LDS_BYTES, stream);
    if (e != hipSuccess) fprintf(stderr, "cooperative launch failed: %s (grid %d)\n", hipGetErrorString(e), grid_blocks);
#endif
}
```

```cpp
#define LAYOUT_SHIFT 16
#include <hip/hip_runtime.h>
#include <hip/hip_cooperative_groups.h>
#include <cstdio>
namespace cg = cooperative_groups;
namespace pg8 {
#define PG8_LAS __attribute__((address_space(3)))
typedef unsigned short bf16_t;
typedef short bf16x8 __attribute__((ext_vector_type(8)));
typedef float f32x4 __attribute__((ext_vector_type(4)));
typedef unsigned u32x4 __attribute__((ext_vector_type(4)));
constexpr int BM = 256, BK = 64, HALF = 128, HTB = HALF * BK * 2  , STAGE_BYTES = 8 * HTB, NXCD = 8, WGM = 8;

__host__ __device__ __forceinline__ int lds_byte(int r, int c) { const int st = (r >> 4) * 2 + (c >> 5), rr = r & 15, cc = c & 31, ob = rr * 64 + cc * 2; return st * 1024 + (ob ^ (((ob >> 9) & 1) << 5)); }
__host__ __device__ __forceinline__ void stage_rc(int b, int& R, int& C) { const int st = b / 1024, sb = b % 1024, swz = sb ^ (((sb >> 9) & 1) << 5); R = (st >> 1) * 16 + swz / 64; C = (st & 1) * 32 + (swz % 64) / 2; }
__host__ __device__ __forceinline__ int perm32(int rho) { const int n = rho >> 4, i = rho & 15; return 8 * (i >> 2) + 4 * n + (i & 3); }

struct Unit { int pm, pn; };
struct Gemm { const bf16_t* A; const bf16_t* Bt; int M, N, K; const bf16_t* A2; const bf16_t* Bt2; };

struct StaticOrder {
    int nM, nN, nwg, G, c;
    __host__ __device__ void init(int M, int N, int G_, int c_) { nM = M / BM; nN = N / BM; nwg = nM * nN; G = G_; c = c_; }
    __host__ __device__ bool next(int i, Unit& u) const {
        const long L = (long)i * G + c; if (L >= nwg) return false;
        int wgid = (int)L; { const int q = nwg / NXCD, r = nwg % NXCD, xcd = wgid % NXCD, off = wgid / NXCD; wgid = (xcd < r ? xcd * (q + 1) : r * (q + 1) + (xcd - r) * q) + off; }
        const int nig = WGM * nN, gid = wgid / nig, fm = gid * WGM, gsz = (nM - fm) < WGM ? (nM - fm) : WGM;
        u.pm = fm + ((wgid % nig) % gsz); u.pn = (wgid % nig) / gsz; return true;
    }
    __device__ __forceinline__ void a_ready(const Unit&) const {}
    __device__ __forceinline__ void done(const Unit&) const {}
};
__device__ __forceinline__ unsigned cvt_pk_bf16(float lo, float hi) { unsigned r; asm volatile("v_cvt_pk_bf16_f32 %0, %1, %2" : "=v"(r) : "v"(lo), "v"(hi)); return r; }
typedef float f32x2 __attribute__((ext_vector_type(2)));
typedef int i32x4 __attribute__((ext_vector_type(4)));
typedef int i32x8 __attribute__((ext_vector_type(8)));
constexpr int F8_SCALE_W = 0x79797979, F8_SCALE_A = 0x7c7c7c7c;
__device__ __forceinline__ i32x8 cat8(bf16x8 a, bf16x8 b) { const i32x4 x = __builtin_bit_cast(i32x4, a), y = __builtin_bit_cast(i32x4, b); return __builtin_shufflevector(x, y, 0, 1, 2, 3, 4, 5, 6, 7); }
template <class Epi, class Sched, bool STAMP = false, bool F8 = false>
__device__ __forceinline__ void gemm_phase(PG8_LAS unsigned char* lds, const Gemm g, const Sched& S, const Epi& E, unsigned long long* stamps) {
    int tid_l = threadIdx.x; asm volatile("" : "+v"(tid_l)); const int tid = tid_l, wid = __builtin_amdgcn_readfirstlane(tid >> 6), lane = tid & 63, wr = wid >> 2, wc = wid & 3, fr = lane & 15, fq = lane >> 4;
    const int K = g.K, nt = K / BK;
    int ts_lo = 0, ts_hi = 0, nts = 0; const unsigned long long rt_entry = STAMP ? (unsigned long long)wall_clock64() : 0ull;
#define PG8_STAMP() do { if (STAMP && wid == 0 && nts < 64) { const unsigned long long _c = (unsigned long long)clock64(); \
        ts_lo = (lane == nts) ? (int)(unsigned)_c : ts_lo; ts_hi = (lane == nts) ? (int)(unsigned)(_c >> 32) : ts_hi; ++nts; } } while (0)
    PG8_STAMP();
    unsigned voffA[2], voffB[2];
#pragma unroll
    for (int i = 0; i < 2; ++i) { int R, C; stage_rc(tid * 16 + i * 8192, R, C); const int Rb = Epi::PERM ? ((R & ~31) + perm32(R & 31)) : R;
        voffA[i] = (unsigned)(R * K + C) * 2u; voffB[i] = (unsigned)(Rb * K + C) * 2u; }
    const size_t kstep = (size_t)(BK * 2);
    const size_t hstep = (size_t)HALF * K * 2;
    const size_t tstep = 2 * hstep;
    const unsigned ldsw = (unsigned)wid * 1024u;
    const int aoff = lds_byte(wr * 64 + fr, fq * 8), boff = lds_byte(wc * 32 + fr, fq * 8);
#define PG8_SA(b, h) (((b) * 2 + (h)) * HTB)
#define PG8_SB(b, h) ((4 + (b) * 2 + (h)) * HTB)
#define PG8_STAGE(bufoff, gbase, voff) do { _Pragma("unroll") for (int _i = 0; _i < 2; ++_i) \
        __builtin_amdgcn_global_load_lds((const unsigned*)((const char*)(gbase) + (voff)[_i]), (PG8_LAS unsigned*)(lds + (bufoff) + ldsw + _i * 8192), 16, 0, 0); } while (0)
#define PG8_LDA(dst, b, h) do { _Pragma("unroll") for (int m = 0; m < 4; ++m) _Pragma("unroll") for (int k = 0; k < 2; ++k) dst[m][k] = *(const PG8_LAS bf16x8*)(lds + PG8_SA(b, h) + aoff + m * 2048 + k * 1024); } while (0)
#define PG8_LDB(dst, b, h) do { _Pragma("unroll") for (int n = 0; n < 2; ++n) _Pragma("unroll") for (int k = 0; k < 2; ++k) dst[n][k] = *(const PG8_LAS bf16x8*)(lds + PG8_SB(b, h) + boff + n * 2048 + k * 1024); } while (0)
#define PG8_MMA(ai, bj, At, Bt) do { __builtin_amdgcn_s_setprio(1); _Pragma("unroll") for (int m = 0; m < 4; ++m) _Pragma("unroll") for (int n = 0; n < 2; ++n) { \
        if constexpr (F8) asm volatile("v_mfma_scale_f32_16x16x128_f8f6f4 %0, %1, %2, %0, %3, %4 op_sel_hi:[0,0,0]" : "+v"(acc[ai][bj][m][n]) : "v"(cat8(Bt[n][0], Bt[n][1])), "v"(cat8(At[m][0], At[m][1])), "v"(f8sw), "v"(f8sa)); \
        else { _Pragma("unroll") for (int k = 0; k < 2; ++k) acc[ai][bj][m][n] = __builtin_amdgcn_mfma_f32_16x16x32_bf16(Bt[n][k], At[m][k], acc[ai][bj][m][n], 0, 0, 0); } } __builtin_amdgcn_s_setprio(0); } while (0)
#define PG8_WAIT_V(n) asm volatile("s_waitcnt vmcnt(" #n ")" ::: "memory")
#define PG8_WAIT_L(n) asm volatile("s_waitcnt lgkmcnt(" #n ")" ::: "memory")
#define PG8_BAR __builtin_amdgcn_s_barrier()
#define PG8_SCHED __builtin_amdgcn_sched_barrier(0)
    Unit cur, nxt; int ui = 0;
    int f8sw = F8_SCALE_W, f8sa = F8_SCALE_A; asm volatile("" : "+v"(f8sw), "+v"(f8sa));
    if (!S.next(0, cur)) return;
    f32x4 acc[2][2][4][2];
#pragma unroll
    for (int a = 0; a < 2; ++a)
#pragma unroll
        for (int b = 0; b < 2; ++b)
#pragma unroll
            for (int m = 0; m < 4; ++m)
#pragma unroll
                for (int n = 0; n < 2; ++n) acc[a][b][m][n] = (f32x4){0.f, 0.f, 0.f, 0.f};
    bf16x8 At[4][2], B0[2][2], B1[2][2];
    const char* cA = (const char*)g.A + (size_t)cur.pm * tstep; const char* cB = (const char*)g.Bt + (size_t)cur.pn * tstep;
    S.a_ready(cur);
    PG8_STAGE(PG8_SB(0, 0), cB, voffB); PG8_STAGE(PG8_SA(0, 0), cA, voffA); PG8_STAGE(PG8_SB(0, 1), cB + hstep, voffB); PG8_STAGE(PG8_SA(0, 1), cA + hstep, voffA);
    if (wr == 1) PG8_BAR;
    PG8_WAIT_V(4); PG8_BAR;
    PG8_STAGE(PG8_SB(1, 0), cB + kstep, voffB); PG8_STAGE(PG8_SA(1, 0), cA + kstep, voffA); PG8_STAGE(PG8_SB(1, 1), cB + hstep + kstep, voffB);
    PG8_WAIT_V(6); PG8_BAR;
    PG8_STAMP();
    for (;;) {
        const bool seg0 = (Epi::NSEG == 2) && !(ui & 1);
        bool has_next; if (seg0) { has_next = true; nxt = cur; } else has_next = S.next((ui + 1) / Epi::NSEG, nxt);
        const char* nA = has_next ? (const char*)(seg0 ? g.A2 : g.A) + (size_t)nxt.pm * tstep : cA; const char* nB = has_next ? (const char*)(seg0 ? g.Bt2 : g.Bt) + (size_t)nxt.pn * tstep : cB;
#pragma nounroll
        for (int t = 0; t < nt; t += 2) {
            const bool last = (t == nt - 2);
            const char* a1 = cA + (size_t)(t + 1) * kstep;
            const char* a2 = last ? nA : cA + (size_t)(t + 2) * kstep; const char* b2 = last ? nB : cB + (size_t)(t + 2) * kstep;
            const char* a3 = a2 + kstep; const char* b3 = b2 + kstep;
            if (last && has_next) S.a_ready(nxt);
            PG8_LDB(B0, 0, 0); PG8_SCHED; PG8_LDA(At, 0, 0); PG8_STAGE(PG8_SA(1, 1), a1 + hstep, voffA);
            PG8_WAIT_L(8); PG8_BAR; PG8_WAIT_L(0); PG8_MMA(0, 0, At, B0); PG8_BAR; PG8_SCHED;
            PG8_LDB(B1, 0, 1); PG8_STAGE(PG8_SB(0, 0), b2, voffB);
            PG8_BAR; PG8_WAIT_L(0); PG8_MMA(0, 1, At, B1); PG8_BAR;
            PG8_LDA(At, 0, 1); PG8_STAGE(PG8_SA(0, 0), a2, voffA);
            PG8_BAR; PG8_WAIT_L(0); PG8_MMA(1, 0, At, B0); PG8_BAR; PG8_SCHED;
            PG8_STAGE(PG8_SB(0, 1), b2 + hstep, voffB);
            PG8_WAIT_V(6); PG8_BAR; PG8_MMA(1, 1, At, B1); PG8_BAR;
            PG8_LDB(B0, 1, 0); PG8_SCHED; PG8_LDA(At, 1, 0); PG8_STAGE(PG8_SA(0, 1), a2 + hstep, voffA);
            PG8_WAIT_L(8); PG8_BAR; PG8_WAIT_L(0); PG8_MMA(0, 0, At, B0); PG8_BAR; PG8_SCHED;
            PG8_LDB(B1, 1, 1); PG8_STAGE(PG8_SB(1, 0), b3, voffB);
            PG8_BAR; PG8_WAIT_L(0); PG8_MMA(0, 1, At, B1); PG8_BAR;
            PG8_LDA(At, 1, 1); PG8_STAGE(PG8_SA(1, 0), a3, voffA);
            PG8_BAR; PG8_WAIT_L(0); PG8_MMA(1, 0, At, B0); PG8_BAR; PG8_SCHED;
            PG8_STAGE(PG8_SB(1, 1), b3 + hstep, voffB);
            PG8_WAIT_V(6); PG8_BAR; PG8_MMA(1, 1, At, B1); PG8_BAR;
        }
        if constexpr (F8) asm volatile("s_nop 15\n\ts_nop 15" ::: "memory");
        PG8_STAMP();
        if constexpr (Epi::NSEG == 2) { if (seg0) E.mid(acc, cur, wr, wc, fr, fq); else { E(acc, cur, wr, wc, fr, fq); S.done(cur); } }
        else if constexpr (!Epi::AFTER_DRAIN) { E(acc, cur, wr, wc, fr, fq); S.done(cur); }
        PG8_STAMP();
        if (!has_next) break;
        if (!seg0) {
#pragma unroll
        for (int a = 0; a < 2; ++a)
#pragma unroll
            for (int b = 0; b < 2; ++b)
#pragma unroll
                for (int m = 0; m < 4; ++m)
#pragma unroll
                    for (int n = 0; n < 2; ++n) acc[a][b][m][n] = (f32x4){0.f, 0.f, 0.f, 0.f};
        }
        cur = nxt; cA = nA; cB = nB; ++ui;
    }
    PG8_WAIT_V(0);
    if (wr == 0) PG8_BAR;
    PG8_BAR;
    if constexpr (Epi::AFTER_DRAIN) { E.fused(acc, cur, wr, wc, fr, fq, lds, wid, lane); S.done(cur); }
    PG8_STAMP();
    if (STAMP && wid == 0) { stamps[lane] = lane < nts ? (((unsigned long long)(unsigned)ts_hi << 32) | (unsigned)ts_lo) : 0ull;
        if (lane == 62) stamps[62] = rt_entry; if (lane == 63) stamps[63] = (unsigned long long)wall_clock64(); }
#undef PG8_STAMP
#undef PG8_SA
#undef PG8_SB
#undef PG8_STAGE
#undef PG8_LDA
#undef PG8_LDB
#undef PG8_MMA
#undef PG8_WAIT_V
#undef PG8_WAIT_L
#undef PG8_BAR
#undef PG8_SCHED
}
}

using pg8::bf16_t; using pg8::f32x4; using pg8::u32x4; using pg8::Unit;
#define LAS __attribute__((address_space(3)))
typedef unsigned u32x2 __attribute__((ext_vector_type(2)));
typedef float f32x2 __attribute__((ext_vector_type(2)));
typedef short bf16x8_t __attribute__((ext_vector_type(8)));
typedef float f32x16 __attribute__((ext_vector_type(16)));
typedef float f32x32 __attribute__((ext_vector_type(32)));
typedef unsigned u32x6 __attribute__((ext_vector_type(6)));
typedef _Float16 h2_t __attribute__((ext_vector_type(2)));
typedef _Float16 h32_t __attribute__((ext_vector_type(32)));

constexpr int NT = 36864, NL = 32768, NCX = 4096;
constexpr size_t MiB = 1u << 20;
constexpr size_t SLOT = 72 * MiB;
constexpr size_t FIX = 7 * SLOT;
constexpr size_t OFF_HC = FIX;
constexpr size_t OFF_WA = FIX + 16 * MiB;
constexpr size_t OFF_WB = OFF_WA + (size_t)3328 * 2048;
constexpr size_t OFF_WBL = OFF_WB + (size_t)4096 * 2048;
constexpr size_t OFF_WSC = OFF_WBL + 6 * MiB;
constexpr size_t OFF_MOD = OFF_WSC + 4 * MiB;
constexpr size_t OFF_BAR = OFF_MOD + 896 * 1024;
constexpr size_t WS_END = OFF_MOD + 1 * MiB;
constexpr size_t OFF_F = 6 * SLOT;
constexpr size_t OFF_WG = 6 * SLOT + 4 * MiB;
constexpr size_t OFF_EU = 6 * SLOT + 8 * MiB;
constexpr size_t OFF_EV = 6 * SLOT + 40 * MiB;
constexpr int LDS_BYTES = 144 * 1024;
constexpr size_t HSLOT = 36 * MiB;
constexpr size_t OFF_HN8 = 0, OFF_YL8 = HSLOT, OFF_SGL8 = SLOT, OFF_SGG8 = SLOT + HSLOT, OFF_MM8 = 2 * SLOT, OFF_M1 = 3 * SLOT, OFF_HN2 = 3 * SLOT, OFF_YG8 = 5 * SLOT;
constexpr float ACT_S = 8.f, WGT_S = 64.f;
constexpr float EV_S = 2.f;
constexpr float EU_S = 96.f;
typedef unsigned char u8_t;

struct Params { const float* in[27]; float* out; unsigned char* ws; int ph_lo, ph_hi, coop, pad; };
typedef const __attribute__((address_space(4))) Params* CPP;

__device__ __forceinline__ float bf_lo(unsigned w) { return __uint_as_float(w << 16); }
__device__ __forceinline__ float bf_hi(unsigned w) { return __uint_as_float(w & 0xffff0000u); }
__device__ __forceinline__ float bf2f(bf16_t b) { return __uint_as_float(((unsigned)b) << 16); }
typedef __bf16 bf16x2n __attribute__((ext_vector_type(2)));
__device__ __forceinline__ unsigned pk2(float lo, float hi) { const f32x2 v = {lo, hi}; return __builtin_bit_cast(unsigned, __builtin_convertvector(v, bf16x2n)); }
__device__ __forceinline__ bf16_t f2bf(float f) { return (bf16_t)(pk2(f, 0.f) & 0xffffu); }
__device__ __forceinline__ float sigmoidf_(float x) { return __builtin_amdgcn_rcpf(1.f + __expf(-x)); }
__device__ __forceinline__ float siluf_(float x) { return x * sigmoidf_(x); }
__device__ __forceinline__ float gelu_tanh(float x) { return x * sigmoidf_(1.5957691216f * (x + 0.044715f * x * x * x)); }
__device__ __forceinline__ unsigned pk4_f8(float a, float b, float c, float d) {
    const int w = __builtin_amdgcn_cvt_pk_fp8_f32(__builtin_amdgcn_fmed3f(a, -448.f, 448.f), __builtin_amdgcn_fmed3f(b, -448.f, 448.f), 0, false);
    return (unsigned)__builtin_amdgcn_cvt_pk_fp8_f32(__builtin_amdgcn_fmed3f(c, -448.f, 448.f), __builtin_amdgcn_fmed3f(d, -448.f, 448.f), w, true);
}
__device__ __forceinline__ unsigned pk4_u8(float a, float b, float c, float d) {
    unsigned w = __builtin_amdgcn_cvt_pk_u8_f32(a, 0u, 0u); w = __builtin_amdgcn_cvt_pk_u8_f32(b, 1u, w); w = __builtin_amdgcn_cvt_pk_u8_f32(c, 2u, w); return __builtin_amdgcn_cvt_pk_u8_f32(d, 3u, w);
}
__device__ __forceinline__ float ub0(unsigned w) { return (float)(w & 0xffu); }
__device__ __forceinline__ float ub1(unsigned w) { return (float)((w >> 8) & 0xffu); }
__device__ __forceinline__ float ub2(unsigned w) { return (float)((w >> 16) & 0xffu); }
__device__ __forceinline__ float ub3(unsigned w) { return (float)(w >> 24); }
__device__ __forceinline__ float wave_sum(float v) {
#pragma unroll
    for (int o = 32; o >= 1; o >>= 1) v += __shfl_xor(v, o);
    return v;
}
__device__ __forceinline__ float wave_max(float v) {
#pragma unroll
    for (int o = 32; o >= 1; o >>= 1) v = fmaxf(v, __shfl_xor(v, o));
    return v;
}
#define LDS_FENCE() asm volatile("s_waitcnt lgkmcnt(0)" ::: "memory")

__device__ __forceinline__ u32x4 wide_pack(u32x2 r0, u32x2 r1) {
    auto sx = __builtin_amdgcn_permlane16_swap(r0.x, r1.x, false, false); auto sy = __builtin_amdgcn_permlane16_swap(r0.y, r1.y, false, false);
    return (u32x4){sx[0], sy[0], sx[1], sy[1]};
}
__device__ __forceinline__ void wide_unpack(u32x4 w, u32x2& r0, u32x2& r1) {
    auto sx = __builtin_amdgcn_permlane16_swap(w.x, w.z, false, false); auto sy = __builtin_amdgcn_permlane16_swap(w.y, w.w, false, false);
    r0 = (u32x2){sx[0], sy[0]}; r1 = (u32x2){sx[1], sy[1]};
}
__device__ __forceinline__ int wide_col(int wc, int fq) { return wc * 32 + (fq & 1) * 128 + 16 * (fq >> 1); }

struct EpiA {
    static constexpr bool PERM = true, AFTER_DRAIN = false; static constexpr int NSEG = 1;
    bf16_t *X, *Q, *K, *V, *F; float qscale;
    __device__ __forceinline__ void operator()(const f32x4 (&acc)[2][2][4][2], const Unit& u, int wr, int wc, int fr, int fq) const {
        const int pn = u.pn, row0 = u.pm * 256 + wr * 64 + fr;
        if (pn == 12) {
            if (wc == 0) {
#pragma unroll
                for (int ai = 0; ai < 2; ++ai)
#pragma unroll
                    for (int m = 0; m < 4; ++m) { const f32x4 v0 = acc[ai][0][m][0], v1 = acc[ai][0][m][1]; u32x4 w; w.x = pk2(v0[0], v0[1]); w.y = pk2(v0[2], v0[3]); w.z = pk2(v1[0], v1[1]); w.w = pk2(v1[2], v1[3]);
                        *(u32x4*)(F + (size_t)(row0 + ai * 128 + m * 16) * 32 + 8 * fq) = w; }
            }
            return;
        }
        bf16_t* base; int ld, colt; float s = 1.f;
        if (pn < 4) { base = X; ld = 1024; colt = pn * 256; }
        else if (pn < 6) { base = Q; ld = 512; colt = (pn - 4) * 256; s = qscale; }
        else if (pn < 8) { base = K; ld = 512; colt = (pn - 6) * 256; }
        else { base = V; ld = 1024; colt = (pn - 8) * 256; }
        const int col0 = colt + wc * 32 + 8 * fq;
#pragma unroll
        for (int ai = 0; ai < 2; ++ai)
#pragma unroll
            for (int m = 0; m < 4; ++m) { bf16_t* rowp = base + (size_t)(row0 + ai * 128 + m * 16) * ld + col0;
#pragma unroll
                for (int bj = 0; bj < 2; ++bj) { const f32x4 v0 = acc[ai][bj][m][0] * s, v1 = acc[ai][bj][m][1] * s; u32x4 w; w.x = pk2(v0[0], v0[1]); w.y = pk2(v0[2], v0[3]); w.z = pk2(v1[0], v1[1]); w.w = pk2(v1[2], v1[3]);
                    *(u32x4*)(rowp + bj * 128) = w; } }
    }
};
struct EpiB {
    static constexpr bool PERM = true, AFTER_DRAIN = false; static constexpr int NSEG = 1;
    const bf16_t *HF, *HB, *ON; u8_t* ws;
    __device__ __forceinline__ void operator()(const f32x4 (&acc)[2][2][4][2], const Unit& u, int wr, int wc, int fr, int fq) const {
        const int pn = u.pn, row0 = u.pm * 256 + wr * 64 + fr, col0 = (pn & 3) * 256 + wc * 32 + 8 * fq, colw = (pn & 3) * 256 + wide_col(wc, fq);
        constexpr unsigned long long DST_MIB = (unsigned long long)(OFF_YL8 >> 20) | ((unsigned long long)(OFF_YG8 >> 20) << 16) | ((unsigned long long)(OFF_SGL8 >> 20) << 32) | ((unsigned long long)(OFF_SGG8 >> 20) << 48);
        u8_t* dst = ws + ((size_t)((DST_MIB >> (16 * (pn >> 2))) & 0xffffull) << 20);
#pragma unroll
        for (int ai = 0; ai < 2; ++ai) {
            u32x4 l0[4][2], l1[4][2];
            if (pn < 8) {
#pragma unroll
                for (int m = 0; m < 4; ++m)
#pragma unroll
                    for (int bj = 0; bj < 2; ++bj) { const size_t o = (size_t)(row0 + ai * 128 + m * 16) * 1024 + col0 + bj * 128;
                        if (pn < 4) { l0[m][bj] = *(const u32x4*)(HF + o); l1[m][bj] = *(const u32x4*)(HB + o); } else l0[m][bj] = *(const u32x4*)(ON + o); }
            }
#pragma unroll
            for (int m = 0; m < 4; ++m) { u32x2 res[2];
#pragma unroll
                for (int bj = 0; bj < 2; ++bj) { const f32x4 v0 = acc[ai][bj][m][0], v1 = acc[ai][bj][m][1]; float a[8] = {v0[0], v0[1], v0[2], v0[3], v1[0], v1[1], v1[2], v1[3]}; float y[8];
                    if (pn < 4) { const u32x4 hf = l0[m][bj], hb = l1[m][bj]; const unsigned hw[4] = {hf.x, hf.y, hf.z, hf.w}, gw[4] = {hb.x, hb.y, hb.z, hb.w};
#pragma unroll
                        for (int j = 0; j < 4; ++j) { y[2 * j] = (bf_lo(hw[j]) + bf_lo(gw[j])) * (ACT_S * gelu_tanh(a[2 * j])); y[2 * j + 1] = (bf_hi(hw[j]) + bf_hi(gw[j])) * (ACT_S * gelu_tanh(a[2 * j + 1])); }
                        res[bj] = (u32x2){pk4_f8(y[0], y[1], y[2], y[3]), pk4_f8(y[4], y[5], y[6], y[7])}; }
                    else if (pn < 8) { const u32x4 on = l0[m][bj]; const unsigned hw[4] = {on.x, on.y, on.z, on.w};
#pragma unroll
                        for (int j = 0; j < 4; ++j) { y[2 * j] = bf_lo(hw[j]) * (ACT_S * siluf_(a[2 * j])); y[2 * j + 1] = bf_hi(hw[j]) * (ACT_S * siluf_(a[2 * j + 1])); }
                        res[bj] = (u32x2){pk4_f8(y[0], y[1], y[2], y[3]), pk4_f8(y[4], y[5], y[6], y[7])}; }
                    else {
#pragma unroll
                        for (int j = 0; j < 8; ++j) y[j] = fmaxf(255.f * sigmoidf_(a[j]), 1.f);
                        res[bj] = (u32x2){pk4_u8(y[0], y[1], y[2], y[3]), pk4_u8(y[4], y[5], y[6], y[7])}; }
                }
                const u32x4 w = wide_pack(res[0], res[1]); const size_t ow = (size_t)(row0 + ai * 128 + m * 16) * 1024 + colw;
                *(u32x4*)(dst + ow) = w; }
            asm volatile("" ::: "memory"); }
    }
};
template <int SECOND> struct EpiM {
    static constexpr bool PERM = true, AFTER_DRAIN = false; static constexpr int NSEG = 1;
    const u8_t* G; bf16_t* M1; u8_t* MM;
    __device__ __forceinline__ void operator()(const f32x4 (&acc)[2][2][4][2], const Unit& u, int wr, int wc, int fr, int fq) const {
        const int row0 = u.pm * 256 + wr * 64 + fr, col0 = u.pn * 256 + wc * 32 + 8 * fq;
#pragma unroll
        for (int ai = 0; ai < 2; ++ai) {
            u32x2 gl[4][2]; u32x4 pl[4][2];
#pragma unroll
            for (int m = 0; m < 4; ++m)
#pragma unroll
                for (int bj = 0; bj < 2; ++bj) { const size_t o = (size_t)(row0 + ai * 128 + m * 16) * 1024 + col0 + bj * 128; gl[m][bj] = *(const u32x2*)(G + o); if (SECOND) pl[m][bj] = *(const u32x4*)(M1 + o); }
#pragma unroll
            for (int m = 0; m < 4; ++m) { const size_t off = (size_t)(row0 + ai * 128 + m * 16) * 1024 + col0;
#pragma unroll
                for (int bj = 0; bj < 2; ++bj) { const f32x4 v0 = acc[ai][bj][m][0], v1 = acc[ai][bj][m][1]; const float a[8] = {v0[0], v0[1], v0[2], v0[3], v1[0], v1[1], v1[2], v1[3]}; float y[8];
                    const size_t o = off + bj * 128; const u32x2 g = gl[m][bj];
                    const float gf[8] = {ub0(g.x), ub1(g.x), ub2(g.x), ub3(g.x), ub0(g.y), ub1(g.y), ub2(g.y), ub3(g.y)};
                    if (SECOND) { const u32x4 p1 = pl[m][bj]; const unsigned pw[4] = {p1.x, p1.y, p1.z, p1.w};
#pragma unroll
                        for (int j = 0; j < 4; ++j) { y[2 * j] = ACT_S * bf_lo(pw[j]) + (ACT_S / 255.f) * gf[2 * j] * a[2 * j]; y[2 * j + 1] = ACT_S * bf_hi(pw[j]) + (ACT_S / 255.f) * gf[2 * j + 1] * a[2 * j + 1]; }
                        *(u32x2*)(MM + o) = (u32x2){pk4_f8(y[0], y[1], y[2], y[3]), pk4_f8(y[4], y[5], y[6], y[7])}; }
                    else {
#pragma unroll
                        for (int j = 0; j < 8; ++j) y[j] = (1.f / 255.f) * gf[j] * a[j];
                        u32x4 w; w.x = pk2(y[0], y[1]); w.y = pk2(y[2], y[3]); w.z = pk2(y[4], y[5]); w.w = pk2(y[6], y[7]); *(u32x4*)(M1 + o) = w; } } }
            asm volatile("" ::: "memory"); }
    }
};
struct EpiMM {
    static constexpr bool PERM = true, AFTER_DRAIN = false; static constexpr int NSEG = 2;
    const u8_t *GL, *GG; u8_t* MM;
    __device__ __forceinline__ void mid(f32x4 (&acc)[2][2][4][2], const Unit& u, int wr, int wc, int fr, int fq) const {
        const int row0 = u.pm * 256 + wr * 64 + fr, colw = u.pn * 256 + wide_col(wc, fq);
#pragma unroll
        for (int ai = 0; ai < 2; ++ai)
#pragma unroll
            for (int mh = 0; mh < 2; ++mh) {
                u32x4 gl[2], gg[2];
#pragma unroll
                for (int mm = 0; mm < 2; ++mm) { const size_t o = (size_t)(row0 + ai * 128 + (2 * mh + mm) * 16) * 1024 + colw; gl[mm] = *(const u32x4*)(GL + o); gg[mm] = *(const u32x4*)(GG + o); }
#pragma unroll
                for (int mm = 0; mm < 2; ++mm) { const int m = 2 * mh + mm; u32x2 a2[2], g2[2]; wide_unpack(gl[mm], a2[0], a2[1]); wide_unpack(gg[mm], g2[0], g2[1]);
#pragma unroll
                    for (int bj = 0; bj < 2; ++bj) { const u32x2 a = a2[bj], g = g2[bj];
                        acc[ai][bj][m][0] *= (f32x4){ub0(a.x) * __builtin_amdgcn_rcpf(ub0(g.x)), ub1(a.x) * __builtin_amdgcn_rcpf(ub1(g.x)), ub2(a.x) * __builtin_amdgcn_rcpf(ub2(g.x)), ub3(a.x) * __builtin_amdgcn_rcpf(ub3(g.x))};
                        acc[ai][bj][m][1] *= (f32x4){ub0(a.y) * __builtin_amdgcn_rcpf(ub0(g.y)), ub1(a.y) * __builtin_amdgcn_rcpf(ub1(g.y)), ub2(a.y) * __builtin_amdgcn_rcpf(ub2(g.y)), ub3(a.y) * __builtin_amdgcn_rcpf(ub3(g.y))}; } }
                asm volatile("" ::: "memory"); }
    }
    __device__ __forceinline__ void operator()(const f32x4 (&acc)[2][2][4][2], const Unit& u, int wr, int wc, int fr, int fq) const {
        const int row0 = u.pm * 256 + wr * 64 + fr, colw = u.pn * 256 + wide_col(wc, fq);
#pragma unroll
        for (int ai = 0; ai < 2; ++ai) {
            u32x4 gg[4];
#pragma unroll
            for (int m = 0; m < 4; ++m) gg[m] = *(const u32x4*)(GG + (size_t)(row0 + ai * 128 + m * 16) * 1024 + colw);
#pragma unroll
            for (int m = 0; m < 4; ++m) { u32x2 g2[2], res[2]; wide_unpack(gg[m], g2[0], g2[1]); const float s = ACT_S / 255.f;
#pragma unroll
                for (int bj = 0; bj < 2; ++bj) { const u32x2 g = g2[bj]; const f32x4 v0 = acc[ai][bj][m][0], v1 = acc[ai][bj][m][1];
                    res[bj] = (u32x2){pk4_f8(s * ub0(g.x) * v0[0], s * ub1(g.x) * v0[1], s * ub2(g.x) * v0[2], s * ub3(g.x) * v0[3]), pk4_f8(s * ub0(g.y) * v1[0], s * ub1(g.y) * v1[1], s * ub2(g.y) * v1[2], s * ub3(g.y) * v1[3])}; }
                *(u32x4*)(MM + (size_t)(row0 + ai * 128 + m * 16) * 1024 + colw) = wide_pack(res[0], res[1]); }
            asm volatile("" ::: "memory"); }
    }
};
__device__ __forceinline__ bf16_t* h_row(float* out, unsigned char* ws, int r) { return r < NL ? (bf16_t*)((unsigned char*)out + (size_t)r * 4096 + 2048) : (bf16_t*)(ws + OFF_HC) + (size_t)(r - NL) * 1024; }
struct EpiOut {
    static constexpr bool PERM = true, AFTER_DRAIN = false; static constexpr int NSEG = 1;
    const float *inL, *inC; float* out; unsigned char* ws; const float* mod; int layer;
    __device__ __forceinline__ void operator()(const f32x4 (&acc)[2][2][4][2], const Unit& u, int wr, int wc, int fr, int fq) const {
        const bool lat = u.pm < 128; const int row0 = u.pm * 256 + wr * 64 + fr, col0 = u.pn * 256 + wc * 32 + 8 * fq;
        const float* g1 = mod + (size_t)(lat ? (u.pm >> 3) : 16) * 6144 + 2048 + col0;
        f32x4 gv[2][2];
#pragma unroll
        for (int bj = 0; bj < 2; ++bj) { gv[bj][0] = *(const f32x4*)(g1 + bj * 128); gv[bj][1] = *(const f32x4*)(g1 + bj * 128 + 4); }
#pragma unroll
        for (int ai = 0; ai < 2; ++ai)
#pragma unroll
            for (int mh = 0; mh < 2; ++mh) {
                f32x4 h0[2][2], h1[2][2];
#pragma unroll
                for (int mm = 0; mm < 2; ++mm)
#pragma unroll
                    for (int bj = 0; bj < 2; ++bj) { const int r = row0 + ai * 128 + (2 * mh + mm) * 16;
                        if (layer == 0) { const float* src = (lat ? inL + (size_t)r * 1024 : inC + (size_t)(r - NL) * 1024) + col0 + bj * 128; h0[mm][bj] = *(const f32x4*)src; h1[mm][bj] = *(const f32x4*)(src + 4); }
                        else { const u32x4 w = *(const u32x4*)(h_row(out, ws, r) + col0 + bj * 128); h0[mm][bj] = (f32x4){bf_lo(w.x), bf_hi(w.x), bf_lo(w.y), bf_hi(w.y)}; h1[mm][bj] = (f32x4){bf_lo(w.z), bf_hi(w.z), bf_lo(w.w), bf_hi(w.w)}; } }
#pragma unroll
                for (int mm = 0; mm < 2; ++mm) { const int m = 2 * mh + mm, r = row0 + ai * 128 + m * 16; bf16_t* hr = h_row(out, ws, r) + col0;
#pragma unroll
                    for (int bj = 0; bj < 2; ++bj) { const f32x4 y0 = h0[mm][bj] + gv[bj][0] * acc[ai][bj][m][0], y1 = h1[mm][bj] + gv[bj][1] * acc[ai][bj][m][1];
                        u32x4 o; o.x = pk2(y0[0], y0[1]); o.y = pk2(y0[2], y0[3]); o.z = pk2(y1[0], y1[1]); o.w = pk2(y1[2], y1[3]); *(u32x4*)(hr + bj * 128) = o; } }
                asm volatile("" ::: "memory"); }
    }
};
struct EpiSc {
    static constexpr bool PERM = true, AFTER_DRAIN = false; static constexpr int NSEG = 1;
    bf16_t* SC;
    __device__ __forceinline__ void operator()(const f32x4 (&acc)[2][2][4][2], const Unit& u, int wr, int wc, int fr, int fq) const {
        const int row0 = u.pm * 256 + wr * 64 + fr, col0 = u.pn * 256 + wc * 32 + 8 * fq;
#pragma unroll
        for (int ai = 0; ai < 2; ++ai)
#pragma unroll
            for (int m = 0; m < 4; ++m) { bf16_t* rowp = SC + (size_t)(row0 + ai * 128 + m * 16) * 2048 + col0;
#pragma unroll
                for (int bj = 0; bj < 2; ++bj) { const f32x4 v0 = acc[ai][bj][m][0], v1 = acc[ai][bj][m][1]; u32x4 w; w.x = pk2(v0[0], v0[1]); w.y = pk2(v0[2], v0[3]); w.z = pk2(v1[0], v1[1]); w.w = pk2(v1[2], v1[3]);
                    *(u32x4*)(rowp + bj * 128) = w; } }
    }
};
#define XB_TMO      128
#define XB_XCNT(j)  (256  + 64 * (j))
#define XB_XSUB(j)  (1280 + 64 * (j))
#define XB_XGEN(j)  (2304 + 64 * (j))
#define XB_TOP      3328
#define XB_TOPGEN   3392
#define XCD_BAR_WORDS 3456
#define XB_SPIN_CAP (1u << 18)

__device__ __forceinline__ unsigned xb_ld(unsigned* p)              { return __hip_atomic_load(p, __ATOMIC_RELAXED, __HIP_MEMORY_SCOPE_AGENT); }
__device__ __forceinline__ unsigned xb_add(unsigned* p, unsigned v) { return __hip_atomic_fetch_add(p, v, __ATOMIC_RELAXED, __HIP_MEMORY_SCOPE_AGENT); }
__device__ __forceinline__ unsigned xb_xcc_id() { return (unsigned)__builtin_amdgcn_s_getreg((3 << 11) | 20) & 0xFu; }
#define XB_SPIN(cond, bar) do { unsigned _sp = 0; while (cond) { __builtin_amdgcn_s_sleep(1); \
    if ((++_sp & 255u) == 0u) { if (xb_ld(&(bar)[XB_TMO])) break; if (_sp > XB_SPIN_CAP) { atomicAdd(&(bar)[XB_TMO], 1u); break; } } } } while (0)

struct XcdBarrier {
    unsigned* bar; unsigned x;
    volatile LAS unsigned* st;
};

__device__ __forceinline__ XcdBarrier xcd_barrier_post(unsigned* bar, volatile LAS unsigned* st) {
    XcdBarrier b; b.bar = bar; b.x = xb_xcc_id(); b.st = st;
    if (threadIdx.x == 0) (void)xb_add(&bar[XB_XCNT(b.x)], 1u);
    return b;
}
__device__ __forceinline__ void xcd_barrier_complete(unsigned* bar, unsigned x, unsigned& nloc, unsigned& nx) {
    const unsigned G = gridDim.x * gridDim.y * gridDim.z;
    unsigned sum, cnt, mine, sp = 0u;
    for (;;) {
        sum = 0u; cnt = 0u; mine = 0u;
#pragma unroll
        for (unsigned j = 0; j < 16; ++j) { const unsigned c = xb_ld(&bar[XB_XCNT(j)]); sum += c; cnt += (c > 0u) ? 1u : 0u; mine = (j == x) ? c : mine; }
        if (sum == G) break;
        __builtin_amdgcn_s_sleep(1);
        if ((++sp & 255u) == 0u) { if (xb_ld(&bar[XB_TMO])) break; if (sp > XB_SPIN_CAP) { atomicAdd(&bar[XB_TMO], 1u); break; } }
    }
    nloc = mine > 0u ? mine : 1u; nx = cnt > 0u ? cnt : 1u;
}

__device__ __forceinline__ void xcd_barrier(const XcdBarrier& b) {
    asm volatile("s_waitcnt vmcnt(0)" ::: "memory");
    __syncthreads();
    if (threadIdx.x == 0) {
        unsigned* bar = b.bar;
        __builtin_amdgcn_s_waitcnt(0);
        unsigned nloc = b.st[0], nx = b.st[1];
        if (nloc == 0u) { xcd_barrier_complete(bar, b.x, nloc, nx); b.st[0] = nloc; b.st[1] = nx; }
        const unsigned old = xb_add(&bar[XB_XSUB(b.x)], 1u);
        const unsigned gen = old / nloc;
        if (old + 1u == (gen + 1u) * nloc) {
            __builtin_amdgcn_fence(__ATOMIC_RELEASE, "agent");
            asm volatile("s_waitcnt vmcnt(0)" ::: "memory");
            const unsigned og = xb_add(&bar[XB_TOP], 1u);
            const unsigned tg = og / nx;
            if (og + 1u == (tg + 1u) * nx) xb_add(&bar[XB_TOPGEN], 1u);
            else XB_SPIN(xb_ld(&bar[XB_TOPGEN]) == tg, bar);
            __builtin_amdgcn_fence(__ATOMIC_ACQUIRE, "agent");
            xb_add(&bar[XB_XGEN(b.x)], 1u);
            asm volatile("s_waitcnt vmcnt(0)" ::: "memory");
        } else {
            XB_SPIN(xb_ld(&bar[XB_XGEN(b.x)]) == gen, bar);
            __builtin_amdgcn_fence(__ATOMIC_ACQUIRE, "agent");
            asm volatile("s_waitcnt vmcnt(0)" ::: "memory");
        }
    }
    __syncthreads();
}

__device__ __forceinline__ void transpose_item(const float* W, int N, u8_t* WT, int drow, int k0, int n0, LAS float* scr, int lane) {
#pragma unroll 8
    for (int i = 0; i < 32; ++i) { const int kk = 2 * i + (lane >> 5); scr[kk * 33 + (lane & 31)] = W[(size_t)(k0 + kk) * N + n0 + (lane & 31)]; }
    LDS_FENCE();
    const int c = lane & 7;
#pragma unroll
    for (int j = 0; j < 4; ++j) { const int n = (lane >> 3) + 8 * j; const LAS float* s = scr + (8 * c) * 33 + n;
        u32x2 o; o.x = pk4_f8(WGT_S * s[0 * 33], WGT_S * s[1 * 33], WGT_S * s[2 * 33], WGT_S * s[3 * 33]); o.y = pk4_f8(WGT_S * s[4 * 33], WGT_S * s[5 * 33], WGT_S * s[6 * 33], WGT_S * s[7 * 33]);
        *(u32x2*)(WT + (size_t)(drow + n) * 1024 + k0 + 8 * c) = o; }
    LDS_FENCE();
}
__device__ __forceinline__ void prep_phase(CPP p, int layer, LAS unsigned char* lds, int tid, int lane, int wave) {
    unsigned char* ws = p->ws;
    const int gw = blockIdx.x * 8 + wave, NGW = gridDim.x * 8;
    if (layer == 0) {
        LAS float* sc = (LAS float*)(lds + 69632);
        LAS float* red = (LAS float*)lds;
        for (int e = tid; e < 17 * 1024; e += 512) { const int r = e >> 10, k = e & 1023; const float c = r < 16 ? p->in[1][r * 1024 + k] : p->in[3][k]; sc[e] = siluf_(c); }
        __syncthreads();
        float* MOD = (float*)(ws + OFF_MOD);
        for (int it = blockIdx.x; it < 192; it += gridDim.x) {
            const int l = it / 96, n0 = (it % 96) * 64;
            float acc[17];
#pragma unroll
            for (int r = 0; r < 17; ++r) acc[r] = 0.f;
            const float* wm = p->in[4] + ((size_t)l * 1024 + wave * 128) * 6144 + n0 + lane;
#pragma unroll 4
            for (int k = 0; k < 128; ++k) { const float w = wm[(size_t)k * 6144];
#pragma unroll
                for (int r = 0; r < 17; ++r) acc[r] += sc[r * 1024 + wave * 128 + k] * w; }
#pragma unroll
            for (int r = 0; r < 17; ++r) red[(wave * 17 + r) * 64 + lane] = acc[r];
            __syncthreads();
            for (int e = tid; e < 17 * 64; e += 512) { const int r = e >> 6, nn = e & 63; float s = p->in[5][l * 6144 + n0 + nn];
#pragma unroll
                for (int w = 0; w < 8; ++w) s += red[(w * 17 + r) * 64 + nn];
                MOD[((size_t)l * 17 + r) * 6144 + n0 + nn] = s; }
            __syncthreads();
        }
    }
    LAS float* scr = (LAS float*)(lds + wave * 8448);
    u8_t* WA = ws + OFF_WA; u8_t* WB = ws + OFF_WB;
    const float* w_in = p->in[8] + (size_t)layer * 1024 * 7200;
    for (int it = gw; it < 5136; it += NGW) {
        const float* W; int N, kb, nb, drow; u8_t* WT;
        if (it < 3600) { kb = it / 225; nb = it % 225; W = w_in; N = 7200; const int n0 = nb * 32;
            if (n0 < 1024) { WT = WA; drow = n0; }
            else if (n0 < 2048) { WT = WB; drow = n0 - 1024; }
            else if (n0 < 2560) { WT = WA; drow = 1024 + (n0 - 2048); }
            else if (n0 < 3072) { WT = WA; drow = 1536 + (n0 - 2560); }
            else if (n0 < 4096) { WT = WA; drow = 2048 + (n0 - 3072); }
            else if (n0 < 5120) { WT = WB; drow = 1024 + (n0 - 4096); }
            else if (n0 < 5152) { WT = WA; drow = 3072; }
            else if (n0 < 6176) { WT = WB; drow = 2048 + (n0 - 5152); }
            else { WT = WB; drow = 3072 + (n0 - 6176); }
        } else { int r = it - 3600; const int mi = r / 512; r %= 512; kb = r / 32; nb = r % 32; N = 1024; W = p->in[19 + mi] + (size_t)layer * 1024 * 1024; WT = ws + OFF_WBL + (size_t)mi * 2 * MiB; drow = nb * 32; }
        transpose_item(W, N, WT, drow, kb * 64, nb * 32, scr, lane);
    }
    for (int i = blockIdx.x * 512 + tid; i < 224 * 1024 / 16; i += gridDim.x * 512) ((u32x4*)(WA + (size_t)3104 * 1024))[i] = (u32x4){0u, 0u, 0u, 0u};
    const float* wq = p->in[22] + (size_t)layer * 1024 * 2048; const float* keys = p->in[23] + (size_t)layer * 2 * 128 * 128; bf16_t* WSC = (bf16_t*)(ws + OFF_WSC);
    for (int it = gw; it < 2048; it += NGW) {
        const int hz = it >> 7, i0 = (it & 127) * 8, z = hz & 1;
        float a0[8], a1[8];
#pragma unroll
        for (int ii = 0; ii < 8; ++ii) { a0[ii] = 0.f; a1[ii] = 0.f; }
        const float* kr0 = keys + (size_t)(z * 128 + lane) * 128; const float* kr1 = kr0 + 64 * 128; const float* wr_ = wq + (size_t)i0 * 2048 + hz * 128;
        for (int d4 = 0; d4 < 32; ++d4) { const f32x4 k0 = *(const f32x4*)(kr0 + 4 * d4), k1 = *(const f32x4*)(kr1 + 4 * d4);
#pragma unroll
            for (int ii = 0; ii < 8; ++ii) { const f32x4 q = *(const f32x4*)(wr_ + (size_t)ii * 2048 + 4 * d4);
                a0[ii] += q[0] * k0[0] + q[1] * k0[1] + q[2] * k0[2] + q[3] * k0[3]; a1[ii] += q[0] * k1[0] + q[1] * k1[1] + q[2] * k1[2] + q[3] * k1[3]; } }
        u32x4 o; o.x = pk2(a0[0], a0[1]); o.y = pk2(a0[2], a0[3]); o.z = pk2(a0[4], a0[5]); o.w = pk2(a0[6], a0[7]); *(u32x4*)(WSC + (size_t)(hz * 128 + lane) * 1024 + i0) = o;
        o.x = pk2(a1[0], a1[1]); o.y = pk2(a1[2], a1[3]); o.z = pk2(a1[4], a1[5]); o.w = pk2(a1[6], a1[7]); *(u32x4*)(WSC + (size_t)(hz * 128 + 64 + lane) * 1024 + i0) = o;
    }
    bf16_t* WG = (bf16_t*)(ws + OFF_WG);
    for (int e = blockIdx.x * 512 + tid; e < 2 * 2 * 16 * 64 * 8; e += gridDim.x * 512) {
        const int i8 = e & 7, j = (e >> 3) & 63, hb = (e >> 9) & 15, gate = (e >> 13) & 1, dir = e >> 14;
        const float* src = p->in[gate ? 13 : 11] + ((size_t)((layer * 2 + dir) * 16 + hb) * 64 + i8 * 8) * 64 + j;
        u32x4 o; o.x = pk2(src[0], src[64]); o.y = pk2(src[128], src[192]); o.z = pk2(src[256], src[320]); o.w = pk2(src[384], src[448]);
        *(u32x4*)(WG + (size_t)e * 8) = o;
    }
}
__device__ __forceinline__ void norm_phase(CPP p, int layer, int which, int nrows, const float* HL, const float* HCp, int lane, int wave) {
    const int gw = blockIdx.x * 8 + wave, NGW = gridDim.x * 8;
    bf16_t* HN2 = (bf16_t*)(p->ws + OFF_HN2); u8_t* HN8 = p->ws + OFF_HN8; const float* MOD = (const float*)(p->ws + OFF_MOD) + (size_t)layer * 17 * 6144 + which * 3072; const float* gn = p->in[6 + which] + layer * 1024;
    if (which == 0) {
        for (int r0 = gw; r0 < nrows; r0 += 2 * NGW) {
            const bool two = r0 + NGW < nrows; const int rr[2] = {r0, two ? r0 + NGW : r0};
            f32x4 v[2][4]; float ss[2] = {0.f, 0.f};
#pragma unroll
            for (int q = 0; q < 2; ++q) { const int r = rr[q]; const float* src = r < NL ? HL + (size_t)r * 1024 : HCp + (size_t)(r - NL) * 1024;
#pragma unroll
                for (int j = 0; j < 4; ++j) v[q][j] = ((const f32x4*)src)[lane + 64 * j]; }
#pragma unroll
            for (int q = 0; q < 2; ++q)
#pragma unroll
                for (int j = 0; j < 4; ++j) ss[q] += v[q][j][0] * v[q][j][0] + v[q][j][1] * v[q][j][1] + v[q][j][2] * v[q][j][2] + v[q][j][3] * v[q][j][3];
            const float rstd[2] = {rsqrtf(wave_sum(ss[0]) * (1.f / 1024.f) + 1e-6f), rsqrtf(wave_sum(ss[1]) * (1.f / 1024.f) + 1e-6f)};
            unsigned o[2][4];
#pragma unroll
            for (int q = 0; q < 2; ++q) { const int r = rr[q]; const float* md = MOD + (size_t)(r < NL ? (r >> 11) : 16) * 6144;
#pragma unroll
                for (int j = 0; j < 4; ++j) { const f32x4 g = ((const f32x4*)gn)[lane + 64 * j], sh = ((const f32x4*)md)[lane + 64 * j], sc = ((const f32x4*)(md + 1024))[lane + 64 * j];
                    const f32x4 y = v[q][j] * rstd[q] * g * (sc + 1.f) + sh; o[q][j] = pk4_f8(ACT_S * y[0], ACT_S * y[1], ACT_S * y[2], ACT_S * y[3]); } }
#pragma unroll
            for (int j = 0; j < 4; ++j) ((unsigned*)(HN8 + (size_t)rr[0] * 1024))[lane + 64 * j] = o[0][j];
            if (two) {
#pragma unroll
                for (int j = 0; j < 4; ++j) ((unsigned*)(HN8 + (size_t)rr[1] * 1024))[lane + 64 * j] = o[1][j]; }
        }
    } else {
        for (int r0 = gw; r0 < nrows; r0 += 2 * NGW) {
            const bool two = r0 + NGW < nrows; const int rr[2] = {r0, two ? r0 + NGW : r0};
            u32x4 w[2][2]; float v[2][16], ss[2] = {0.f, 0.f};
#pragma unroll
            for (int q = 0; q < 2; ++q) { const u32x4* src = (const u32x4*)(h_row(p->out, p->ws, rr[q]) + 16 * lane); w[q][0] = src[0]; w[q][1] = src[1]; }
#pragma unroll
            for (int q = 0; q < 2; ++q) { const unsigned ww[8] = {w[q][0].x, w[q][0].y, w[q][0].z, w[q][0].w, w[q][1].x, w[q][1].y, w[q][1].z, w[q][1].w};
#pragma unroll
                for (int j = 0; j < 8; ++j) { v[q][2 * j] = bf_lo(ww[j]); v[q][2 * j + 1] = bf_hi(ww[j]); ss[q] += v[q][2 * j] * v[q][2 * j] + v[q][2 * j + 1] * v[q][2 * j + 1]; } }
            const float rstd[2] = {rsqrtf(wave_sum(ss[0]) * (1.f / 1024.f) + 1e-6f), rsqrtf(wave_sum(ss[1]) * (1.f / 1024.f) + 1e-6f)};
            u32x4 o[2][2];
#pragma unroll
            for (int q = 0; q < 2; ++q) { const int r = rr[q]; const float* md = MOD + (size_t)(r < NL ? (r >> 11) : 16) * 6144 + 16 * lane; float y[16];
#pragma unroll
                for (int j = 0; j < 4; ++j) { const f32x4 g = ((const f32x4*)(gn + 16 * lane))[j], sh = ((const f32x4*)md)[j], sc = ((const f32x4*)(md + 1024))[j];
#pragma unroll
                    for (int i = 0; i < 4; ++i) y[4 * j + i] = v[q][4 * j + i] * rstd[q] * g[i] * (sc[i] + 1.f) + sh[i]; }
                o[q][0].x = pk2(y[0], y[1]); o[q][0].y = pk2(y[2], y[3]); o[q][0].z = pk2(y[4], y[5]); o[q][0].w = pk2(y[6], y[7]); o[q][1].x = pk2(y[8], y[9]); o[q][1].y = pk2(y[10], y[11]); o[q][1].z = pk2(y[12], y[13]); o[q][1].w = pk2(y[14], y[15]); }
            { u32x4* d = (u32x4*)(HN2 + (size_t)rr[0] * 1024 + 16 * lane); d[0] = o[0][0]; d[1] = o[0][1]; }
            if (two) { u32x4* d = (u32x4*)(HN2 + (size_t)rr[1] * 1024 + 16 * lane); d[0] = o[1][0]; d[1] = o[1][1]; }
        }
    }
}
__device__ __forceinline__ int gla_row(int b, int dir, int s) {
    if (s < 256) return NL + b * 256 + (dir ? 255 - s : s);
    const int j = dir ? 2047 - (s - 256) : (s - 256);
    return b * 2048 + (j & 31) * 64 + (j >> 5);
}
__device__ __forceinline__ void gla_naive_phase(CPP p, int layer, LAS unsigned char* lds, int tid) {
    const bf16_t* Q = (const bf16_t*)(p->ws + 3 * SLOT); const bf16_t* K = Q + (size_t)NT * 512; const bf16_t* V = (const bf16_t*)(p->ws + 2 * SLOT); const bf16_t* F = (const bf16_t*)(p->ws + OFF_F);
    LAS float* sA = (LAS float*)lds; LAS float* sK = sA + 512; LAS float* sQ = sK + 512; LAS float* sO = sQ + 512;
    const int tt = tid >> 7, dkk = tid & 127, dv = tid & 255, half = tid >> 8;
    for (int item = blockIdx.x; item < 128; item += gridDim.x) {
        const int b = item >> 3, h = (item >> 1) & 3, dir = item & 1;
        bf16_t* O = (bf16_t*)(p->ws + (size_t)(4 + dir) * SLOT);
        const float* wf = p->in[16] + ((size_t)(layer * 2 + dir) * 16) * 512 + h * 128 + dkk; const float bfv = p->in[17][(layer * 2 + dir) * 512 + h * 128 + dkk];
        float wfr[16];
#pragma unroll
        for (int j = 0; j < 16; ++j) wfr[j] = wf[j * 512];
        float S[64];
#pragma unroll
        for (int i = 0; i < 64; ++i) S[i] = 0.f;
        for (int s4 = 0; s4 < 576; ++s4) {
            { const int r = gla_row(b, dir, s4 * 4 + tt);
              const u32x4* fp = (const u32x4*)(F + (size_t)r * 32 + dir * 16); const u32x4 f0 = fp[0], f1 = fp[1]; const unsigned fw[8] = {f0.x, f0.y, f0.z, f0.w, f1.x, f1.y, f1.z, f1.w};
              float z = bfv;
#pragma unroll
              for (int j = 0; j < 8; ++j) z += bf_lo(fw[j]) * wfr[2 * j] + bf_hi(fw[j]) * wfr[2 * j + 1];
              const float lg = (fminf(z, 0.f) - log1pf(__expf(-fabsf(z)))) * (1.f / 16.f);
              sA[tid] = __expf(lg); sK[tid] = bf2f(K[(size_t)r * 512 + h * 128 + dkk]); sQ[tid] = bf2f(Q[(size_t)r * 512 + h * 128 + dkk]); }
            __syncthreads();
#pragma unroll
            for (int t4 = 0; t4 < 4; ++t4) { const int r = gla_row(b, dir, s4 * 4 + t4); const float v = bf2f(V[(size_t)r * 1024 + h * 256 + dv]); float op = 0.f;
#pragma unroll
                for (int i = 0; i < 64; ++i) { const int dk = t4 * 128 + half * 64 + i; S[i] = sA[dk] * S[i] + sK[dk] * v; op += sQ[dk] * S[i]; }
                sO[(t4 * 2 + half) * 256 + dv] = op; }
            __syncthreads();
            for (int e = tid; e < 1024; e += 512) { const int t4 = e >> 8, d = e & 255; const int r = gla_row(b, dir, s4 * 4 + t4); O[(size_t)r * 1024 + h * 256 + d] = f2bf(sO[(t4 * 2) * 256 + d] + sO[(t4 * 2 + 1) * 256 + d]); }
        }
        __syncthreads();
    }
}
typedef short s16x4 __attribute__((ext_vector_type(4)));
__device__ __forceinline__ bf16x8_t bits8(u32x4 v) { return __builtin_bit_cast(bf16x8_t, v); }
__device__ __forceinline__ bf16x8_t tr8(const LAS unsigned char* p0, const LAS unsigned char* p1) {
    const s16x4 a = __builtin_amdgcn_ds_read_tr16_b64_v4i16((LAS s16x4*)p0), b = __builtin_amdgcn_ds_read_tr16_b64_v4i16((LAS s16x4*)p1);
    return __builtin_shufflevector(a, b, 0, 1, 2, 3, 4, 5, 6, 7);
}
template <int CTRL> __device__ __forceinline__ float dppz(float v) { return __int_as_float(__builtin_amdgcn_update_dpp(0, __float_as_int(v), CTRL, 0xf, 0xf, true)); }
__device__ __forceinline__ float wave_incl_scan(float v) {
    v += dppz<0x111>(v); v += dppz<0x112>(v); v += dppz<0x114>(v); v += dppz<0x118>(v);
    v += __int_as_float(__builtin_amdgcn_update_dpp(0, __float_as_int(v), 0x142, 0xa, 0xf, false));
    v += __int_as_float(__builtin_amdgcn_update_dpp(0, __float_as_int(v), 0x143, 0xc, 0xf, false));
    return v;
}
__device__ __forceinline__ void gla_phase(CPP p, int layer, LAS unsigned char* lds, int tid, int lane, int wave, int mode = 0) {
    const bf16_t* Q = (const bf16_t*)(p->ws + 3 * SLOT); const bf16_t* K = Q + (size_t)NT * 512; const bf16_t* V = (const bf16_t*)(p->ws + 2 * SLOT); const bf16_t* F = (const bf16_t*)(p->ws + OFF_F);
    LAS unsigned char* ATT = lds + 108544;
    LAS unsigned char* OST = lds + 117760;
    LAS float* GL = (LAS float*)(lds + 135168);
    LAS float* WFL = (LAS float*)(lds + 136192);
    LAS float* BFL = (LAS float*)(lds + 144384);
    const int l15 = lane & 15, g4 = lane >> 4;
    for (int item = blockIdx.x; item < 256; item += gridDim.x) {
        const int b = (item & 63) >> 2, h = item & 3, dir = item >> 7, dvh = (item >> 6) & 1;
        bf16_t* O = (bf16_t*)(p->ws + (size_t)(4 + dir) * SLOT);
        bf16x8_t afr; f32x4 bias4;
        { u32x4 t4 = (u32x4){0u, 0u, 0u, 0u};
          if (g4 < 2) { const float* wp = p->in[16] + ((size_t)(layer * 2 + dir) * 16 + 8 * g4) * 512 + h * 128 + 16 * wave + l15;
              t4.x = pk2(wp[0], wp[512]); t4.y = pk2(wp[1024], wp[1536]); t4.z = pk2(wp[2048], wp[2560]); t4.w = pk2(wp[3072], wp[3584]); }
          afr = bits8(t4); bias4 = *(const f32x4*)(p->in[17] + (layer * 2 + dir) * 512 + h * 128 + 16 * wave + 4 * g4); }
        f32x4 Sacc[8];
#pragma unroll
        for (int i = 0; i < 8; ++i) Sacc[i] = (f32x4){0.f, 0.f, 0.f, 0.f};
        u32x4 pq[2], pk[2], pv[2], pf;
        const int sgn = dir ? -1 : 1; int rC[2], rL[2], chq = tid & 15; int rCf, rLf;
#pragma unroll
        for (int k = 0; k < 2; ++k) { const int j_ = (tid >> 4) + 32 * k; rC[k] = NL + b * 256 + (dir ? 255 - j_ : j_); rL[k] = b * 2048 + (dir ? (31 - (j_ & 31)) * 64 + 63 - (j_ >> 5) : (j_ & 31) * 64 + (j_ >> 5)); }
        { const int j_ = (tid >> 1) & 63; rCf = NL + b * 256 + (dir ? 255 - j_ : j_); rLf = b * 2048 + (dir ? (31 - (j_ & 31)) * 64 + 63 - (j_ >> 5) : (j_ & 31) * 64 + (j_ >> 5)); }
        const unsigned char* wsb = p->ws;
        const unsigned cQ = (unsigned)(3 * SLOT) + h * 256 + chq * 16, cK = cQ + (unsigned)NT * 1024u, cV = (unsigned)(2 * SLOT) + h * 512 + dvh * 256 + chq * 16, cO = (unsigned)((4 + dir) * SLOT) + h * 512 + dvh * 256 + chq * 16, cF = (unsigned)OFF_F + dir * 32 + (tid & 1) * 16;
#define GLA_ROW(c_, rc_, rl_) ((c_) < 4 ? (rc_) + sgn * 64 * (c_) : (rl_) + sgn * 2 * ((c_) - 4))
#define GLA_PREFETCH(c_) do { _Pragma("unroll") for (int k = 0; k < 2; ++k) { const unsigned r_ = (unsigned)GLA_ROW(c_, rC[k], rL[k]); \
            pq[k] = *(const u32x4*)(wsb + (size_t)(cQ + r_ * 1024u)); pk[k] = *(const u32x4*)(wsb + (size_t)(cK + r_ * 1024u)); pv[k] = *(const u32x4*)(wsb + (size_t)(cV + r_ * 2048u)); } \
        if (tid < 128) { const unsigned r_ = (unsigned)GLA_ROW(c_, rCf, rLf); pf = *(const u32x4*)(wsb + (size_t)(cF + r_ * 64u)); } } while (0)
#define GLA_STAGE(bufp) do { _Pragma("unroll") for (int k = 0; k < 2; ++k) { const int id_ = tid + 512 * k, j_ = id_ >> 4, ch_ = id_ & 15; *(LAS u32x4*)((bufp) + j_ * 272 + ch_ * 16) = pq[k]; *(LAS u32x4*)((bufp) + 17408 + j_ * 272 + ch_ * 16) = pk[k]; *(LAS u32x4*)((bufp) + 34816 + j_ * 272 + ch_ * 16) = pv[k]; } \
        if (tid < 128) *(LAS u32x4*)((bufp) + 52224 + tid * 16) = pf; } while (0)
#define GLA_GATES(bufp, glp) do { f32x4 zt_[4]; \
        _Pragma("unroll") for (int nt = 0; nt < 4; ++nt) { const bf16x8_t fb_ = *(const LAS bf16x8_t*)((bufp) + 52224 + (16 * nt + l15) * 32 + 16 * (g4 & 1)); zt_[nt] = __builtin_amdgcn_mfma_f32_16x16x32_bf16(afr, fb_, bias4, 0, 0, 0); } \
        float off_[4] = {0.f, 0.f, 0.f, 0.f}; float e_[4][4]; \
        _Pragma("unroll") for (int nt = 0; nt < 4; ++nt) { _Pragma("unroll") for (int r = 0; r < 4; ++r) { const float z_ = zt_[nt][r]; float lg_ = (fminf(z_, 0.f) * 1.4426950409f - __builtin_amdgcn_logf(1.f + __builtin_amdgcn_exp2f(fabsf(z_) * -1.4426950409f))) * 0.0625f;     \
                lg_ += dppz<0x111>(lg_); lg_ += dppz<0x112>(lg_); lg_ += dppz<0x114>(lg_); lg_ += dppz<0x118>(lg_); lg_ += off_[r]; \
                if (nt < 3) off_[r] = __int_as_float(__builtin_amdgcn_ds_bpermute((lane | 15) << 2, __float_as_int(lg_))); \
                e_[nt][r] = __builtin_amdgcn_exp2f(lg_); } } \
        if (l15 == 15) *(LAS f32x4*)((glp) + 16 * wave + 4 * g4) = (f32x4){e_[3][0], e_[3][1], e_[3][2], e_[3][3]}; \
        _Pragma("unroll") for (int nt = 0; nt < 4; ++nt) { LAS u32x2* qp_ = (LAS u32x2*)((bufp) + (16 * nt + l15) * 272 + (16 * wave + 4 * g4) * 2); LAS u32x2* kp_ = (LAS u32x2*)((bufp) + 17408 + (16 * nt + l15) * 272 + (16 * wave + 4 * g4) * 2); \
            const u32x2 qv_ = *qp_, kv_ = *kp_; u32x2 qo_, ko_; \
            qo_.x = pk2(bf_lo(qv_.x) * e_[nt][0], bf_hi(qv_.x) * e_[nt][1]); qo_.y = pk2(bf_lo(qv_.y) * e_[nt][2], bf_hi(qv_.y) * e_[nt][3]); \
            ko_.x = pk2(bf_lo(kv_.x) * __builtin_amdgcn_rcpf(e_[nt][0]), bf_hi(kv_.x) * __builtin_amdgcn_rcpf(e_[nt][1])); ko_.y = pk2(bf_lo(kv_.y) * __builtin_amdgcn_rcpf(e_[nt][2]), bf_hi(kv_.y) * __builtin_amdgcn_rcpf(e_[nt][3])); \
            *qp_ = qo_; *kp_ = ko_; } } while (0)
#define GLA_ATT(bufp) do { const int mt_ = wave >> 1; \
        _Pragma("unroll") for (int n2 = 0; n2 < 2; ++n2) { const int nt_ = 2 * (wave & 1) + n2; f32x4 a4_ = (f32x4){0.f, 0.f, 0.f, 0.f}; \
            if (nt_ <= mt_) { _Pragma("unroll") for (int ks = 0; ks < 4; ++ks) { const bf16x8_t a_ = *(const LAS bf16x8_t*)((bufp) + (16 * mt_ + l15) * 272 + ks * 64 + g4 * 16), bb_ = *(const LAS bf16x8_t*)((bufp) + 17408 + (16 * nt_ + l15) * 272 + ks * 64 + g4 * 16); \
                    a4_ = __builtin_amdgcn_mfma_f32_16x16x32_bf16(a_, bb_, a4_, 0, 0, 0); } } \
            _Pragma("unroll") for (int r = 0; r < 4; ++r) { const int t_ = 16 * mt_ + 4 * g4 + r, sx_ = 16 * nt_ + l15; *(LAS bf16_t*)(ATT + t_ * 144 + sx_ * 2) = f2bf(t_ >= sx_ ? a4_[r] : 0.f); } } } while (0)
        GLA_PREFETCH(0);
        __syncthreads();
        GLA_STAGE(lds);
        GLA_PREFETCH(1);
        __syncthreads();
        GLA_GATES(lds, GL);
        __syncthreads();
        GLA_ATT(lds);
        GLA_STAGE(lds + 54272);
        GLA_PREFETCH(2);
        __syncthreads();
        for (int c = 0; c < 36; ++c) {
            if (mode) { LAS unsigned char* cb2 = lds + (c & 1) * 54272; __syncthreads(); if (c + 2 < 36) GLA_STAGE(cb2); if (c + 3 < 36) GLA_PREFETCH(c + 3); __syncthreads(); continue; }
            LAS unsigned char* cb = lds + (c & 1) * 54272; LAS unsigned char* nb = lds + ((c + 1) & 1) * 54272;
            const LAS float* glc = GL + (c & 1) * 128;
            f32x4 oacc[4];
#pragma unroll
            for (int m = 0; m < 4; ++m) oacc[m] = (f32x4){0.f, 0.f, 0.f, 0.f};
#pragma unroll
            for (int ks = 0; ks < 4; ++ks) { u32x4 sb; sb.x = pk2(Sacc[2 * ks][0], Sacc[2 * ks][1]); sb.y = pk2(Sacc[2 * ks][2], Sacc[2 * ks][3]); sb.z = pk2(Sacc[2 * ks + 1][0], Sacc[2 * ks + 1][1]); sb.w = pk2(Sacc[2 * ks + 1][2], Sacc[2 * ks + 1][3]);
                const bf16x8_t bS = bits8(sb);
#pragma unroll
                for (int m = 0; m < 4; ++m) { const LAS unsigned char* ap = cb + (16 * m + l15) * 272 + (32 * ks + 4 * g4) * 2; const u32x2 lo = *(const LAS u32x2*)ap, hi = *(const LAS u32x2*)(ap + 32);
                    oacc[m] = __builtin_amdgcn_mfma_f32_16x16x32_bf16(bits8((u32x4){lo.x, lo.y, hi.x, hi.y}), bS, oacc[m], 0, 0, 0); } }
            if (c + 1 < 36) GLA_GATES(nb, GL + ((c + 1) & 1) * 128);
            bf16x8_t bV[2];
            { const int q_ = l15 >> 2, p_ = l15 & 3;
#pragma unroll
              for (int ks = 0; ks < 2; ++ks) { const LAS unsigned char* vp = cb + 34816 + (32 * ks + 8 * g4 + q_) * 272 + (16 * wave + 4 * p_) * 2; bV[ks] = tr8(vp, vp + 4 * 272); } }
#pragma unroll
            for (int ks = 0; ks < 2; ++ks)
#pragma unroll
                for (int m = 0; m < 4; ++m) if (2 * ks <= m) { const bf16x8_t a = *(const LAS bf16x8_t*)(ATT + (16 * m + l15) * 144 + ks * 64 + g4 * 16); oacc[m] = __builtin_amdgcn_mfma_f32_16x16x32_bf16(a, bV[ks], oacc[m], 0, 0, 0); }
#pragma unroll
            for (int m = 0; m < 4; ++m)
#pragma unroll
                for (int r = 0; r < 4; ++r) *(LAS bf16_t*)(OST + (16 * m + 4 * g4 + r) * 272 + (16 * wave + l15) * 2) = f2bf(oacc[m][r]);
            { const int q_ = l15 >> 2, p_ = l15 & 3;
#pragma unroll
              for (int ks = 0; ks < 2; ++ks)
#pragma unroll
                  for (int i = 0; i < 8; ++i) { const LAS unsigned char* kp = cb + 17408 + (32 * ks + 8 * g4 + q_) * 272 + (16 * i + 4 * p_) * 2; Sacc[i] = __builtin_amdgcn_mfma_f32_16x16x32_bf16(tr8(kp, kp + 4 * 272), bV[ks], Sacc[i], 0, 0, 0); } }
#pragma unroll
            for (int i = 0; i < 8; ++i) { const f32x4 gl = *(const LAS f32x4*)(glc + 16 * i + 4 * g4); Sacc[i] = Sacc[i] * gl; }
            __syncthreads();
#pragma unroll
            for (int k = 0; k < 2; ++k) { const unsigned r_ = (unsigned)GLA_ROW(c, rC[k], rL[k]); *(u32x4*)(p->ws + (size_t)(cO + r_ * 2048u)) = *(const LAS u32x4*)(OST + ((tid >> 4) + 32 * k) * 272 + chq * 16); }
            if (c + 1 < 36) GLA_ATT(nb);
            if (c + 2 < 36) GLA_STAGE(cb);
            if (c + 3 < 36) GLA_PREFETCH(c + 3);
            __syncthreads();
        }
#undef GLA_PREFETCH
#undef GLA_ROW
#undef GLA_STAGE
#undef GLA_GATES
#undef GLA_ATT
    }
}
template <int DIR> __device__ __forceinline__ void lru_naive_item(CPP p, int layer, int b, int hb, int lane) {
    const int c = hb * 64 + lane;
    const bf16_t* X = (const bf16_t*)(p->ws + 1 * SLOT); bf16_t* Hd = (bf16_t*)(p->ws + (size_t)(DIR ? 2 : 3) * SLOT);
    const float* wa = p->in[11] + ((size_t)((layer * 2 + DIR) * 16 + hb) * 64) * 64 + lane; const float* wx = p->in[13] + ((size_t)((layer * 2 + DIR) * 16 + hb) * 64) * 64 + lane;
    float war[64], wxr[64];
#pragma unroll
    for (int i = 0; i < 64; ++i) { war[i] = wa[i * 64]; wxr[i] = wx[i * 64]; }
    const float ba = p->in[12][(layer * 2 + DIR) * 1024 + c], bx = p->in[14][(layer * 2 + DIR) * 1024 + c], lam = p->in[15][(layer * 2 + DIR) * 1024 + c];
    const float cl = -8.f * (fmaxf(-lam, 0.f) + log1pf(__expf(-fabsf(lam))));
    const float cw0 = p->in[9][(layer * 4 + 0) * 1024 + c], cw1 = p->in[9][(layer * 4 + 1) * 1024 + c], cw2 = p->in[9][(layer * 4 + 2) * 1024 + c], cw3 = p->in[9][(layer * 4 + 3) * 1024 + c], cb = p->in[10][layer * 1024 + c];
    float h = 0.f;
    for (int seg = 0; seg < 2; ++seg) {
        const int L = seg ? 2048 : 256; const size_t base = seg ? (size_t)b * 2048 : (size_t)NL + (size_t)b * 256;
        for (int ch = 0; ch < L / 16; ++ch) {
            const int tb = DIR ? L - 16 - ch * 16 : ch * 16;
            float xv[19];
#pragma unroll
            for (int j = 0; j < 19; ++j) { const int t = tb - 2 + j; xv[j] = (t >= 0 && t < L) ? bf2f(X[(base + t) * 1024 + c]) : 0.f; }
#pragma unroll
            for (int i = 0; i < 16; ++i) { const int q = DIR ? 15 - i : i;
                const float xr = cb + cw0 * xv[q] + cw1 * xv[q + 1] + cw2 * xv[q + 2] + cw3 * xv[q + 3];
                float ra = ba, ri = bx;
#pragma unroll
                for (int k = 0; k < 64; ++k) { const float xk = __int_as_float(__builtin_amdgcn_readlane(__float_as_int(xr), k)); ra += xk * war[k]; ri += xk * wxr[k]; }
                const float rg = sigmoidf_(ra), ig = sigmoidf_(ri), la = cl * rg, a = __expf(la), uu = sqrtf(fmaxf(-expm1f(2.f * la), 0.f)) * ig * xr;
                h = a * h + uu;
                Hd[(base + tb + q) * 1024 + c] = f2bf(h); }
        }
    }
}
__device__ __forceinline__ void lru_naive_phase(CPP p, int layer, int lane, int wave) {
    const int gw = wave * gridDim.x + blockIdx.x, NGW = gridDim.x * 8;
    for (int item = gw; item < 512; item += NGW) { const int b = item >> 5, hb = (item >> 1) & 15;
        if (item & 1) lru_naive_item<1>(p, layer, b, hb, lane); else lru_naive_item<0>(p, layer, b, hb, lane); }
}
__device__ __forceinline__ void lru_tile_geom(int s, int dirb, int b, int& t0, int& L, size_t& gb) {
    if (s < 4) { t0 = 64 * (dirb ? 3 - s : s); L = 256; gb = (size_t)NL + (size_t)b * 256; }
    else { t0 = 64 * (dirb ? 35 - s : s - 4); L = 2048; gb = (size_t)b * 2048; }
}
__device__ __forceinline__ void lru_phase(CPP p, int layer, LAS unsigned char* lds, int tid, int lane, int wave) {
    const bf16_t* X = (const bf16_t*)(p->ws + 1 * SLOT); const bf16_t* WG = (const bf16_t*)(p->ws + OFF_WG);
    LAS unsigned char* RAW = lds;
    LAS unsigned char* XRB = lds + 17152;
    LAS float* XRF = (LAS float*)(lds + 35584);
    LAS float* AA = (LAS float*)(lds + 68352);
    LAS float* UU = (LAS float*)(lds + 103168);
    const int td = wave >> 2, idx = tid & 255;
    const int dirw = wave >> 2, mt = (wave >> 1) & 1, nh = wave & 1, l31 = lane & 31, l5 = lane >> 5;
    for (int item = blockIdx.x; item < 256; item += gridDim.x) {
        const int b = item >> 4, hb = item & 15;
        bf16x8_t bfr[2][4];
#pragma unroll
        for (int g = 0; g < 2; ++g)
#pragma unroll
            for (int ks = 0; ks < 4; ++ks) bfr[g][ks] = *(const bf16x8_t*)(WG + ((size_t)(((dirw * 2 + g) * 16 + hb) * 64 + nh * 32 + l31)) * 64 + ks * 16 + 8 * l5);
        const int ce = hb * 64 + nh * 32 + l31;
        const float e_ba = p->in[12][(layer * 2 + dirw) * 1024 + ce], e_bx = p->in[14][(layer * 2 + dirw) * 1024 + ce]; const float lam = p->in[15][(layer * 2 + dirw) * 1024 + ce];
        const float e_cl = -8.f * (fmaxf(-lam, 0.f) + log1pf(__expf(-fabsf(lam))));
        const float k_ba = -1.4426950409f * e_ba, k_bx = -1.4426950409f * e_bx, k_cl = 1.4426950409f * e_cl;
        const int chp = idx & 31, tg = idx >> 5, cc = hb * 64 + 2 * chp;
        float cw[4][2], cbv[2];
#pragma unroll
        for (int k = 0; k < 4; ++k) { cw[k][0] = p->in[9][(layer * 4 + k) * 1024 + cc]; cw[k][1] = p->in[9][(layer * 4 + k) * 1024 + cc + 1]; }
        cbv[0] = p->in[10][layer * 1024 + cc]; cbv[1] = p->in[10][layer * 1024 + cc + 1];
        float hstate = 0.f;
        u32x4 pre[3]; int poff[3]; bool pok[3], pfirst[3], plast[3];
#pragma unroll
        for (int k = 0; k < 3; ++k) { const int id_ = idx + 256 * k, rr_ = id_ >> 3; pok[k] = id_ < 536; pfirst[k] = rr_ < 2; plast[k] = rr_ == 66; poff[k] = ((rr_ - 2) * 1024 + hb * 64 + (id_ & 7) * 8) * 2; }
#define LRU_PREFETCH(s_) do { int t0_, L_; size_t gb_; lru_tile_geom((s_), td, b, t0_, L_, gb_); const char* base_ = (const char*)X + (gb_ + t0_) * 2048; const bool fst_ = t0_ == 0, lst_ = t0_ == L_ - 64; \
        _Pragma("unroll") for (int k = 0; k < 3; ++k) { pre[k] = (u32x4){0u, 0u, 0u, 0u}; if (pok[k] && !(fst_ && pfirst[k]) && !(lst_ && plast[k])) pre[k] = *(const u32x4*)(base_ + poff[k]); } } while (0)
        LRU_PREFETCH(0);
        for (int s = 0; s < 36; ++s) {
#pragma unroll
            for (int k = 0; k < 3; ++k) { const int id_ = idx + 256 * k; if (id_ < 536) *(LAS u32x4*)(RAW + td * 8576 + id_ * 16) = pre[k]; }
            __syncthreads();
            if (s + 1 < 36) LRU_PREFETCH(s + 1);
            { float r0[11], r1[11];
#pragma unroll
              for (int j = 0; j < 11; ++j) { const unsigned w = *(const LAS unsigned*)(RAW + td * 8576 + (8 * tg + j) * 128 + chp * 4); r0[j] = bf_lo(w); r1[j] = bf_hi(w); }
#pragma unroll
              for (int t = 0; t < 8; ++t) { const float y0 = cbv[0] + cw[0][0] * r0[t] + cw[1][0] * r0[t + 1] + cw[2][0] * r0[t + 2] + cw[3][0] * r0[t + 3];
                  const float y1 = cbv[1] + cw[0][1] * r1[t] + cw[1][1] * r1[t + 1] + cw[2][1] * r1[t + 2] + cw[3][1] * r1[t + 3];
                  *(LAS f32x2*)(XRF + td * 4096 + (8 * tg + t) * 64 + 2 * chp) = (f32x2){y0, y1};
                  *(LAS unsigned*)(XRB + td * 9216 + (8 * tg + t) * 144 + chp * 4) = pk2(y0, y1); } }
            __syncthreads();
            { f32x16 ca, cx;
#pragma unroll
              for (int i = 0; i < 16; ++i) { ca[i] = 0.f; cx[i] = 0.f; }
#pragma unroll
              for (int ks = 0; ks < 4; ++ks) { const bf16x8_t a = *(const LAS bf16x8_t*)(XRB + dirw * 9216 + (mt * 32 + l31) * 144 + ks * 32 + 16 * l5);
                  ca = __builtin_amdgcn_mfma_f32_32x32x16_bf16(a, bfr[0][ks], ca, 0, 0, 0); cx = __builtin_amdgcn_mfma_f32_32x32x16_bf16(a, bfr[1][ks], cx, 0, 0, 0); }
#pragma unroll
              for (int rq = 0; rq < 4; ++rq) { const int tok0 = mt * 32 + 8 * rq + 4 * l5; f32x4 a4, u4;
#pragma unroll
                  for (int r4 = 0; r4 < 4; ++r4) { const int rg = 4 * rq + r4; const float xr = XRF[dirw * 4096 + (tok0 + r4) * 64 + nh * 32 + l31];
                      const float rgt = __builtin_amdgcn_rcpf(1.f + __builtin_amdgcn_exp2f(ca[rg] * -1.4426950409f + k_ba)), igt = __builtin_amdgcn_rcpf(1.f + __builtin_amdgcn_exp2f(cx[rg] * -1.4426950409f + k_bx));
                      const float a = __builtin_amdgcn_exp2f(k_cl * rgt); a4[r4] = a; u4[r4] = __builtin_amdgcn_sqrtf(fmaxf(__builtin_fmaf(-a, a, 1.f), 0.f)) * (igt * xr); }
                  const int o_ = (dirw * 64 + nh * 32 + l31) * 68 + tok0; *(LAS f32x4*)(AA + o_) = a4; *(LAS f32x4*)(UU + o_) = u4; } }
            __syncthreads();
            if (tid < 128) { LAS f32x4* ap = (LAS f32x4*)(AA + tid * 68); LAS f32x4* up = (LAS f32x4*)(UU + tid * 68);
                if (tid < 64) {
#pragma unroll
                    for (int hf = 0; hf < 2; ++hf) { f32x4 a[8], u[8];
#pragma unroll
                        for (int k = 0; k < 8; ++k) { a[k] = ap[8 * hf + k]; u[k] = up[8 * hf + k]; }
#pragma unroll
                        for (int k = 0; k < 8; ++k) {
#pragma unroll
                            for (int j = 0; j < 4; ++j) { hstate = a[k][j] * hstate + u[k][j]; u[k][j] = hstate; } }
#pragma unroll
                        for (int k = 0; k < 8; ++k) up[8 * hf + k] = u[k]; } }
                else {
#pragma unroll
                    for (int hf = 1; hf >= 0; --hf) { f32x4 a[8], u[8];
#pragma unroll
                        for (int k = 0; k < 8; ++k) { a[k] = ap[8 * hf + k]; u[k] = up[8 * hf + k]; }
#pragma unroll
                        for (int k = 7; k >= 0; --k) {
#pragma unroll
                            for (int j = 3; j >= 0; --j) { hstate = a[k][j] * hstate + u[k][j]; u[k][j] = hstate; } }
#pragma unroll
                        for (int k = 0; k < 8; ++k) up[8 * hf + k] = u[k]; } } }
            __syncthreads();
#pragma unroll
            for (int k = 0; k < 2; ++k) { const int tok = tid & 63, cp = wave; int t0, L; size_t gb; lru_tile_geom(s, k, b, t0, L, gb); char* Hd = (char*)(p->ws + (size_t)(k ? 2 : 3) * SLOT) + (gb + t0) * 2048;
                const LAS float* src = UU + (k * 64 + 8 * cp) * 68 + tok; u32x4 w; w.x = pk2(src[0], src[68]); w.y = pk2(src[136], src[204]); w.z = pk2(src[272], src[340]); w.w = pk2(src[408], src[476]);
                *(u32x4*)(Hd + (tok * 1024 + hb * 64 + 8 * cp) * 2) = w; }
        }
        __syncthreads();
#undef LRU_PREFETCH
    }
}
__device__ __forceinline__ void onorm_phase(CPP p, int layer, int tid, int lane, int wave) {
    const int gw = blockIdx.x * 8 + wave, NGW = gridDim.x * 8;
    bf16_t* OF = (bf16_t*)(p->ws + 4 * SLOT); const bf16_t* OB = (const bf16_t*)(p->ws + 5 * SLOT); const float* ng = p->in[18] + layer * 1024 + 16 * lane;
    const int nrows = layer == 1 ? NL : NT;
    for (int r = gw; r < nrows; r += NGW) {
        const u32x4* a = (const u32x4*)(OF + (size_t)r * 1024 + 16 * lane); const u32x4* bq = (const u32x4*)(OB + (size_t)r * 1024 + 16 * lane);
        const u32x4 a0 = a[0], a1 = a[1], b0 = bq[0], b1 = bq[1]; const unsigned aw[8] = {a0.x, a0.y, a0.z, a0.w, a1.x, a1.y, a1.z, a1.w}, bw[8] = {b0.x, b0.y, b0.z, b0.w, b1.x, b1.y, b1.z, b1.w};
        float o[16], ss = 0.f;
#pragma unroll
        for (int j = 0; j < 8; ++j) { o[2 * j] = bf_lo(aw[j]) + bf_lo(bw[j]); o[2 * j + 1] = bf_hi(aw[j]) + bf_hi(bw[j]); ss += o[2 * j] * o[2 * j] + o[2 * j + 1] * o[2 * j + 1]; }
#pragma unroll
        for (int of = 1; of < 16; of <<= 1) ss += __shfl_xor(ss, of);
        const float rs = rsqrtf(ss * (1.f / 256.f) + 1e-6f);
        u32x4 w0, w1; const f32x4 g0 = ((const f32x4*)ng)[0], g1 = ((const f32x4*)ng)[1], g2 = ((const f32x4*)ng)[2], g3 = ((const f32x4*)ng)[3];
        w0.x = pk2(o[0] * rs * g0[0], o[1] * rs * g0[1]); w0.y = pk2(o[2] * rs * g0[2], o[3] * rs * g0[3]); w0.z = pk2(o[4] * rs * g1[0], o[5] * rs * g1[1]); w0.w = pk2(o[6] * rs * g1[2], o[7] * rs * g1[3]);
        w1.x = pk2(o[8] * rs * g2[0], o[9] * rs * g2[1]); w1.y = pk2(o[10] * rs * g2[2], o[11] * rs * g2[3]); w1.z = pk2(o[12] * rs * g3[0], o[13] * rs * g3[1]); w1.w = pk2(o[14] * rs * g3[2], o[15] * rs * g3[3]);
        u32x4* d = (u32x4*)(OF + (size_t)r * 1024 + 16 * lane); d[0] = w0; d[1] = w1;
    }
    const f32x4* eu = (const f32x4*)(p->in[24] + (size_t)layer * 16384 * 1024); const f32x4* ev = (const f32x4*)(p->in[25] + (size_t)layer * 16384 * 1024);
    for (int i = blockIdx.x * 512 + tid; i < 2 * 16384 * 32; i += gridDim.x * 512) {
        const int tab = i >> 19, it = i & 524287; const f32x4* src = (tab ? ev : eu) + (size_t)it * 8;
        const f32x4* srcp = src;
        if (tab) {
            unsigned o[4];
#pragma unroll
            for (int n = 0; n < 4; ++n) { const f32x4 a = srcp[2 * n] * EV_S, b = srcp[2 * n + 1] * EV_S; unsigned w = 0u;
                w = __builtin_amdgcn_cvt_scalef32_pk_fp4_f32(w, __builtin_amdgcn_fmed3f(a[0], -6.f, 6.f), __builtin_amdgcn_fmed3f(a[1], -6.f, 6.f), 1.0f, 0);
                w = __builtin_amdgcn_cvt_scalef32_pk_fp4_f32(w, __builtin_amdgcn_fmed3f(a[2], -6.f, 6.f), __builtin_amdgcn_fmed3f(a[3], -6.f, 6.f), 1.0f, 1);
                w = __builtin_amdgcn_cvt_scalef32_pk_fp4_f32(w, __builtin_amdgcn_fmed3f(b[0], -6.f, 6.f), __builtin_amdgcn_fmed3f(b[1], -6.f, 6.f), 1.0f, 2);
                w = __builtin_amdgcn_cvt_scalef32_pk_fp4_f32(w, __builtin_amdgcn_fmed3f(b[2], -6.f, 6.f), __builtin_amdgcn_fmed3f(b[3], -6.f, 6.f), 1.0f, 3); o[n] = w; }
            *(u32x4*)(p->ws + OFF_EV + (size_t)(it >> 5) * 512 + (it & 1) * 256 + ((it & 31) >> 1) * 16) = (u32x4){o[0], o[1], o[2], o[3]};
        } else {
            unsigned o[4];
#pragma unroll
            for (int n = 0; n < 4; ++n) { const f32x4 a = srcp[2 * n] * EU_S, b = srcp[2 * n + 1] * EU_S; unsigned w = 0u;
#pragma unroll
                for (int k = 0; k < 4; ++k) { const int qa = (int)__builtin_rintf(__builtin_amdgcn_fmed3f(a[k], -8.f, 7.f)), qb = (int)__builtin_rintf(__builtin_amdgcn_fmed3f(b[k], -8.f, 7.f));
                    w |= ((unsigned)qa & 15u) << (8 * k); w |= ((unsigned)qb & 15u) << (8 * k + 4); }
                o[n] = w; }
            *(u32x4*)(p->ws + OFF_EU + (size_t)(it >> 5) * 512 + (it & 1) * 256 + ((it & 31) >> 1) * 16) = (u32x4){o[0], o[1], o[2], o[3]};
        }
    }
}
template <int CTRL> __device__ __forceinline__ float dppf(float v) { return __int_as_float(__builtin_amdgcn_update_dpp(0, __float_as_int(v), CTRL, 0xf, 0xf, true)); }
__device__ __forceinline__ float row_max16(float v) { v = fmaxf(v, dppf<0xB1>(v)); v = fmaxf(v, dppf<0x4E>(v)); v = fmaxf(v, dppf<0x141>(v)); v = fmaxf(v, dppf<0x140>(v)); return v; }
template <int CTRL> __device__ __forceinline__ int dppi(int v) { return __builtin_amdgcn_update_dpp(0, v, CTRL, 0xf, 0xf, true); }
__device__ __forceinline__ int row_max16i(int v) { v = max(v, dppi<0xB1>(v)); v = max(v, dppi<0x4E>(v)); v = max(v, dppi<0x141>(v)); v = max(v, dppi<0x140>(v)); return v; }
__device__ __forceinline__ float row_sum16(float v) { v += dppf<0xB1>(v); v += dppf<0x4E>(v); v += dppf<0x141>(v); v += dppf<0x140>(v); return v; }
__device__ __forceinline__ float xrow_sum(float t) {
    auto r = __builtin_amdgcn_permlane32_swap(__float_as_uint(t), __float_as_uint(t), false, false); t = __uint_as_float(r[0]) + __uint_as_float(r[1]);
    auto q = __builtin_amdgcn_permlane16_swap(__float_as_uint(t), __float_as_uint(t), false, false); return __uint_as_float(q[0]) + __uint_as_float(q[1]);
}
__device__ __forceinline__ float wave_sum_d(float v) { return xrow_sum(row_sum16(v)); }
__device__ __forceinline__ void peer_phase(CPP p, int layer, LAS unsigned char* lds, int lane, int wave) {
    const int gw = blockIdx.x * 8 + wave, NGW = gridDim.x * 8;
    const int nrows = layer == 1 ? NL : NT;
    const bf16_t* SC = (const bf16_t*)(p->ws + 1 * SLOT); const bf16_t* HN = (const bf16_t*)(p->ws + OFF_HN2); u8_t* HN8 = p->ws + OFF_HN8;
    const unsigned char* EU = p->ws + OFF_EU; const unsigned char* EV = p->ws + OFF_EV;
    const float* MODL = (const float*)(p->ws + OFF_MOD) + (size_t)layer * 17 * 6144;
    LAS int* topv = (LAS int*)(lds + wave * 4096);
    LAS float* selw = (LAS float*)(topv + 256);
    LAS int* sele = (LAS int*)(selw + 128);
    LAS float* sels = (LAS float*)(sele + 128);
    LAS int* se2 = (LAS int*)(sels + 128); LAS float* sw2 = (LAS float*)(se2 + 128);
    const int IMIN = (int)0x80000000;
    LAS unsigned char* ptab = (LAS unsigned char*)(sw2 + 128);
    int pi4[4], pj4[4];
#pragma unroll
    for (int m = 0; m < 4; ++m) { const int slot = (lane & 15) + 16 * m; int base = 0; bool found = false; pi4[m] = 0; pj4[m] = 0;
        for (int i = 0; i < 16; ++i) { const int cnt = 16 / (i + 1); if (!found && slot < base + cnt) { pi4[m] = i; pj4[m] = slot - base; found = true; } base += cnt; } }
    const int R = lane >> 4, c16 = lane & 15, half = lane >> 5, l31 = lane & 31;
    if (R == 0) {
#pragma unroll
        for (int m = 0; m < 4; ++m) ptab[c16 + 16 * m] = (unsigned char)((pi4[m] << 4) | pj4[m]);
    }
    LDS_FENCE();
    u32x4 scn[4];
#pragma unroll
    for (int B = 0; B < 4; ++B) scn[B] = *(const u32x4*)(SC + (size_t)(gw < nrows ? gw : 0) * 2048 + (4 * B + R) * 128 + 8 * c16);
    asm volatile("" :: "v"(scn[0]), "v"(scn[1]), "v"(scn[2]), "v"(scn[3]));
    for (int r = gw; r < nrows; r += NGW) {
        u32x4 hraw[8];
        { const u32x4* hp = (const u32x4*)(HN + (size_t)r * 1024 + 64 * c16);
#pragma unroll
          for (int q8 = 0; q8 < 8; ++q8) hraw[q8] = hp[q8]; }
        int hqh[8], hql[8]; float tscale; h2_t acch[32];
#if defined(PROBE_PEER)
        for (int rep = 0; rep < PROBE_PEER; ++rep) {
#endif
#if defined(PROBE_PK)
        const unsigned long long pk0 = __builtin_amdgcn_s_memrealtime();
#endif
#define PEER_KEY(b) ((b) ^ (((b) >> 31) & 0x7fffffff))
#pragma unroll
        for (int B = 0; B < 4; ++B) {
            const int g = 4 * B + R; int v[8];
            { const u32x4 w = scn[B]; const unsigned ww[4] = {w.x, w.y, w.z, w.w};
#pragma unroll
              for (int i = 0; i < 4; ++i) { const int k = 8 * c16 + 2 * i; const int b0 = (int)((ww[i] << 16) | (unsigned)k), b1 = (int)((ww[i] & 0xffff0000u) | (unsigned)(k + 1)); v[2 * i] = PEER_KEY(b0); v[2 * i + 1] = PEER_KEY(b1); } }
#define PEER_CE(x, y) do { const int hi_ = max(v[x], v[y]), lo_ = min(v[x], v[y]); v[x] = hi_; v[y] = lo_; } while (0)
            PEER_CE(0, 1); PEER_CE(2, 3); PEER_CE(4, 5); PEER_CE(6, 7); PEER_CE(0, 2); PEER_CE(1, 3); PEER_CE(4, 6); PEER_CE(5, 7); PEER_CE(1, 2); PEER_CE(5, 6);
            PEER_CE(0, 4); PEER_CE(1, 5); PEER_CE(2, 6); PEER_CE(3, 7); PEER_CE(2, 4); PEER_CE(3, 5); PEER_CE(1, 2); PEER_CE(3, 4); PEER_CE(5, 6);
#undef PEER_CE
            int res = IMIN;
#pragma unroll
            for (int it = 0; it < 16; ++it) {
                const int m = row_max16i(v[0]); const bool own = v[0] == m;
                res = (c16 == it) ? m : res;
#pragma unroll
                for (int i = 0; i < 7; ++i) v[i] = own ? v[i + 1] : v[i];
                v[7] = own ? IMIN : v[7];
            }
            topv[g * 16 + c16] = PEER_KEY(res);
        }
        LDS_FENCE();
        for (int P = 0; P < 2; ++P) { const int h = 4 * P + R; int cs[4];
#pragma unroll
            for (int m = 0; m < 4; ++m) { const float a = __int_as_float(topv[(2 * h) * 16 + pi4[m]]), bq = __int_as_float(topv[(2 * h + 1) * 16 + pj4[m]]);
                const int b = (int)((__float_as_uint(a + bq) & ~63u) | (unsigned)(c16 + 16 * m)); cs[m] = (c16 + 16 * m < 50) ? PEER_KEY(b) : IMIN; }
#define PEER_CE(x, y) do { const int hi_ = max(cs[x], cs[y]), lo_ = min(cs[x], cs[y]); cs[x] = hi_; cs[y] = lo_; } while (0)
            PEER_CE(0, 1); PEER_CE(2, 3); PEER_CE(0, 2); PEER_CE(1, 3); PEER_CE(1, 2);
#undef PEER_CE
            int res = IMIN;
#pragma unroll
            for (int it = 0; it < 16; ++it) {
                const int m = row_max16i(cs[0]); const bool own = cs[0] == m;
                res = (c16 == it) ? m : res;
                cs[0] = own ? cs[1] : cs[0]; cs[1] = own ? cs[2] : cs[1]; cs[2] = own ? cs[3] : cs[2]; cs[3] = own ? IMIN : cs[3];
            }
            const int bits = PEER_KEY(res), ij = ptab[bits & 63];
            sels[h * 16 + c16] = __int_as_float(bits);
            sele[h * 16 + c16] = (topv[(2 * h) * 16 + (ij >> 4)] & 127) * 128 + (topv[(2 * h + 1) * 16 + (ij & 15)] & 127);
        }
#undef PEER_KEY
        LDS_FENCE();
        { const int h = lane >> 3;
          const float s0 = sels[2 * lane], s1 = sels[2 * lane + 1];
          float mx = fmaxf(s0, s1); mx = fmaxf(mx, dppf<0xB1>(mx)); mx = fmaxf(mx, dppf<0x4E>(mx)); mx = fmaxf(mx, dppf<0x141>(mx));
          const float e0 = __expf(s0 - mx), e1 = __expf(s1 - mx); float sm = e0 + e1; sm += dppf<0xB1>(sm); sm += dppf<0x4E>(sm); sm += dppf<0x141>(sm);
          const float inv = __builtin_amdgcn_rcpf(sm); const float w0 = e0 * inv, w1 = e1 * inv; (void)h;
          const int x0 = sele[2 * lane], x1 = sele[2 * lane + 1]; const int p0 = x0 >> 10, p1 = x1 >> 10; int pos0 = 0, pos1 = 0, base = 0;
#pragma unroll
          for (int x = 0; x < 16; ++x) { const unsigned long long m0 = __ballot(p0 == x), m1 = __ballot(p1 == x); const int c0 = __popcll(m0), c1 = __popcll(m1);
              const int b0 = (int)__builtin_amdgcn_mbcnt_hi((unsigned)(m0 >> 32), __builtin_amdgcn_mbcnt_lo((unsigned)m0, 0u)), b1 = (int)__builtin_amdgcn_mbcnt_hi((unsigned)(m1 >> 32), __builtin_amdgcn_mbcnt_lo((unsigned)m1, 0u));
              pos0 = (p0 == x) ? base + b0 : pos0; pos1 = (p1 == x) ? base + c0 + b1 : pos1; base += c0 + c1; }
          se2[pos0] = x0; sw2[pos0] = w0; se2[pos1] = x1; sw2[pos1] = w1; }
        LDS_FENCE();
#if defined(PROBE_PK)
        const unsigned long long pk1 = __builtin_amdgcn_s_memrealtime();
        if (PROBE_PK == 1) { while (__builtin_amdgcn_s_memrealtime() - pk1 < pk1 - pk0) __builtin_amdgcn_s_sleep(4); }
#endif
        {
            float am = 0.f;
#pragma unroll
            for (int q8 = 0; q8 < 8; ++q8) { const unsigned ww[4] = {hraw[q8].x, hraw[q8].y, hraw[q8].z, hraw[q8].w};
#pragma unroll
                for (int j = 0; j < 4; ++j) am = fmaxf(am, fmaxf(fabsf(bf_lo(ww[j])), fabsf(bf_hi(ww[j])))); }
            am = fmaxf(row_max16(am), 1e-20f);
            const float qs = 119.f * __builtin_amdgcn_rcpf(am); tscale = am * (1.f / (119.f * EU_S));
#pragma unroll
            for (int q8 = 0; q8 < 8; ++q8) { const unsigned ww[4] = {hraw[q8].x, hraw[q8].y, hraw[q8].z, hraw[q8].w};
                unsigned c0 = 0u, c1 = 0u;
                c0 = __builtin_amdgcn_cvt_pk_u8_f32(__builtin_rintf(bf_lo(ww[0]) * qs) + 136.f, 0u, c0); c0 = __builtin_amdgcn_cvt_pk_u8_f32(__builtin_rintf(bf_hi(ww[0]) * qs) + 136.f, 1u, c0);
                c0 = __builtin_amdgcn_cvt_pk_u8_f32(__builtin_rintf(bf_lo(ww[1]) * qs) + 136.f, 2u, c0); c0 = __builtin_amdgcn_cvt_pk_u8_f32(__builtin_rintf(bf_hi(ww[1]) * qs) + 136.f, 3u, c0);
                c1 = __builtin_amdgcn_cvt_pk_u8_f32(__builtin_rintf(bf_lo(ww[2]) * qs) + 136.f, 0u, c1); c1 = __builtin_amdgcn_cvt_pk_u8_f32(__builtin_rintf(bf_hi(ww[2]) * qs) + 136.f, 1u, c1);
                c1 = __builtin_amdgcn_cvt_pk_u8_f32(__builtin_rintf(bf_lo(ww[3]) * qs) + 136.f, 2u, c1); c1 = __builtin_amdgcn_cvt_pk_u8_f32(__builtin_rintf(bf_hi(ww[3]) * qs) + 136.f, 3u, c1);
                hqh[q8] = (int)((((c0 >> 4) & 0x0f0f0f0fu) | (c1 & 0xf0f0f0f0u)) ^ 0x88888888u);
                hql[q8] = (int)(((c0 & 0x0f0f0f0fu) | ((c1 << 4) & 0xf0f0f0f0u)) ^ 0x88888888u); }
#pragma unroll
            for (int j = 0; j < 32; ++j) acch[j] = (h2_t){(_Float16)0.f, (_Float16)0.f}; }
        u32x4 A4[2][2], B4[2][2];
#define PEER_LDV(b) _Pragma("unroll") for (int i = 0; i < 2; ++i) { const int e_ = se2[(b) * 8 + 2 * R + i]; const unsigned char* rp_ = EV + (size_t)e_ * 512 + c16 * 16; B4[i][0] = *(const u32x4*)rp_; B4[i][1] = *(const u32x4*)(rp_ + 256); }
#define PEER_LDU(b) _Pragma("unroll") for (int i = 0; i < 2; ++i) { const int e_ = se2[(b) * 8 + 2 * R + i]; const unsigned char* rp_ = EU + (size_t)e_ * 512 + c16 * 16; A4[i][0] = *(const u32x4*)rp_; A4[i][1] = *(const u32x4*)(rp_ + 256); }
#define PEER_UCOMP(b) do { float d[2]; \
        _Pragma("unroll") for (int i = 0; i < 2; ++i) { int h0_ = 0, h1_ = 0, l0_ = 0, l1_ = 0; const int uw_[8] = {(int)A4[i][0].x, (int)A4[i][0].y, (int)A4[i][0].z, (int)A4[i][0].w, (int)A4[i][1].x, (int)A4[i][1].y, (int)A4[i][1].z, (int)A4[i][1].w}; \
            _Pragma("unroll") for (int n = 0; n < 8; n += 2) { h0_ = __builtin_amdgcn_sdot8(uw_[n], hqh[n], h0_, false); l0_ = __builtin_amdgcn_sdot8(uw_[n], hql[n], l0_, false); \
                h1_ = __builtin_amdgcn_sdot8(uw_[n + 1], hqh[n + 1], h1_, false); l1_ = __builtin_amdgcn_sdot8(uw_[n + 1], hql[n + 1], l1_, false); } \
            d[i] = (float)(16 * (h0_ + h1_) + l0_ + l1_); } \
        const bool b0_ = lane & 1; float t_ = (b0_ ? d[1] : d[0]) + dppf<0xB1>(b0_ ? d[0] : d[1]);        \
        t_ += dppf<0x4E>(t_); t_ += dppf<0x124>(t_); t_ += dppf<0x128>(t_); \
        if (c16 < 2) { const int k_ = (b) * 8 + 2 * R + c16; sw2[k_] = sw2[k_] * gelu_tanh(t_ * tscale); } } while (0)
#define PEER_VCOMP(b) do { _Pragma("unroll") for (int i = 0; i < 2; ++i) { const _Float16 wq_ = (_Float16)(sw2[(b) * 8 + 2 * R + i] * (1.f / EV_S)); const h2_t w2_ = (h2_t){wq_, wq_}; \
            const unsigned vw_[8] = {B4[i][0].x, B4[i][0].y, B4[i][0].z, B4[i][0].w, B4[i][1].x, B4[i][1].y, B4[i][1].z, B4[i][1].w}; \
            _Pragma("unroll") for (int n = 0; n < 8; ++n) { \
                acch[4 * n] += w2_ * __builtin_amdgcn_cvt_scalef32_pk_f16_fp4(vw_[n], 1.0f, 0); acch[4 * n + 1] += w2_ * __builtin_amdgcn_cvt_scalef32_pk_f16_fp4(vw_[n], 1.0f, 1); \
                acch[4 * n + 2] += w2_ * __builtin_amdgcn_cvt_scalef32_pk_f16_fp4(vw_[n], 1.0f, 2); acch[4 * n + 3] += w2_ * __builtin_amdgcn_cvt_scalef32_pk_f16_fp4(vw_[n], 1.0f, 3); } } } while (0)
        PEER_LDU(0); PEER_LDV(0);
        { const int rn = (r + NGW < nrows) ? r + NGW : r;
#pragma unroll
          for (int B = 0; B < 4; ++B) scn[B] = *(const u32x4*)(SC + (size_t)rn * 2048 + (4 * B + R) * 128 + 8 * c16); }
        const int cb = 64 * c16 + 16 * R; const int mrow = r < NL ? (r >> 11) : 16;
        bf16_t* hp = h_row(p->out, p->ws, r) + cb; const float* g2 = MODL + (size_t)mrow * 6144 + 5120 + cb;
        const u32x4 hr0 = ((const u32x4*)hp)[0], hr1 = ((const u32x4*)hp)[1];
        for (int b = 0; b < 16; ++b) {
            PEER_UCOMP(b);
            if (b + 1 < 16) { PEER_LDU(b + 1); }
            LDS_FENCE();
            PEER_VCOMP(b);
            if (b + 1 < 16) { PEER_LDV(b + 1); }
        }
#if defined(PROBE_PEER)

        }
#endif
#if defined(PROBE_PK)
        if (PROBE_PK == 2) { const unsigned long long pk2 = __builtin_amdgcn_s_memrealtime(); while (__builtin_amdgcn_s_memrealtime() - pk2 < pk2 - pk1) __builtin_amdgcn_s_sleep(4); }
#endif
        float a16[16];
        { h2_t f1[16];
#pragma unroll
          for (int j = 0; j < 16; ++j) { auto sx = __builtin_amdgcn_permlane32_swap(__builtin_bit_cast(unsigned, acch[j]), __builtin_bit_cast(unsigned, acch[16 + j]), false, false);
              f1[j] = __builtin_bit_cast(h2_t, (unsigned)sx[0]) + __builtin_bit_cast(h2_t, (unsigned)sx[1]); }
#pragma unroll
          for (int j = 0; j < 8; ++j) { auto sx = __builtin_amdgcn_permlane16_swap(__builtin_bit_cast(unsigned, f1[j]), __builtin_bit_cast(unsigned, f1[8 + j]), false, false);
              const h2_t x = __builtin_bit_cast(h2_t, (unsigned)sx[0]), y = __builtin_bit_cast(h2_t, (unsigned)sx[1]); a16[2 * j] = (float)x.x + (float)y.x; a16[2 * j + 1] = (float)x.y + (float)y.y; } }
        float hv[16], ss = 0.f;
        { const unsigned hw[8] = {hr0.x, hr0.y, hr0.z, hr0.w, hr1.x, hr1.y, hr1.z, hr1.w};
#pragma unroll
          for (int j = 0; j < 4; ++j) { const f32x4 g4 = ((const f32x4*)g2)[j];
#pragma unroll
            for (int i = 0; i < 4; ++i) { const unsigned w = hw[2 * j + (i >> 1)]; const float y = ((i & 1) ? bf_hi(w) : bf_lo(w)) + g4[i] * a16[4 * j + i]; hv[4 * j + i] = y; ss += y * y; } } }
        const float rstd = rsqrtf(wave_sum_d(ss) * (1.f / 1024.f) + 1e-6f);
        asm volatile("" :: "v"(scn[0]), "v"(scn[1]), "v"(scn[2]), "v"(scn[3]));
        if (layer == 0) {
            { u32x4 o0, o1; o0.x = pk2(hv[0], hv[1]); o0.y = pk2(hv[2], hv[3]); o0.z = pk2(hv[4], hv[5]); o0.w = pk2(hv[6], hv[7]); o1.x = pk2(hv[8], hv[9]); o1.y = pk2(hv[10], hv[11]); o1.z = pk2(hv[12], hv[13]); o1.w = pk2(hv[14], hv[15]);
              ((u32x4*)hp)[0] = o0; ((u32x4*)hp)[1] = o1; }
            const float* md = MODL + 17 * 6144 + (size_t)mrow * 6144 + cb; const float* gn = p->in[6] + 1024 + cb; float y[16];
#pragma unroll
            for (int j = 0; j < 16; ++j) y[j] = hv[j] * rstd * gn[j] * (1.f + md[1024 + j]) + md[j];
#pragma unroll
            for (int j = 0; j < 16; ++j) y[j] *= ACT_S;
            *(u32x4*)(HN8 + (size_t)r * 1024 + cb) = (u32x4){pk4_f8(y[0], y[1], y[2], y[3]), pk4_f8(y[4], y[5], y[6], y[7]), pk4_f8(y[8], y[9], y[10], y[11]), pk4_f8(y[12], y[13], y[14], y[15])};
        } else {
            const float* gn = p->in[26] + cb; float* op = p->out + (size_t)r * 1024 + cb;
            f32x4 gnv[4];
#pragma unroll
            for (int j = 0; j < 4; ++j) gnv[j] = ((const f32x4*)gn)[j];
#pragma unroll
            for (int j = 0; j < 4; ++j) ((f32x4*)op)[j] = (f32x4){hv[4 * j] * rstd * gnv[j][0], hv[4 * j + 1] * rstd * gnv[j][1], hv[4 * j + 2] * rstd * gnv[j][2], hv[4 * j + 3] * rstd * gnv[j][3]};
        }
    }
#undef PEER_LDU
#undef PEER_LDV
#undef PEER_UCOMP
#undef PEER_VCOMP
}
#define LAYOUT_STR2(x) #x
#define LAYOUT_STR(x) LAYOUT_STR2(x)

constexpr int N_PHASES = 25;
#ifndef ONLY
#define ONLY -1
#endif
#define EN(k) (ONLY < 0 || ONLY == (k))
template <bool F8, class Epi> __device__ __forceinline__ void run_gemm(LAS unsigned char* lds, const void* A, const void* Bt, int M, int N, const Epi& E, const void* A2 = nullptr, const void* Bt2 = nullptr) {
    pg8::Gemm g{(const bf16_t*)A, (const bf16_t*)Bt, M, N, F8 ? 512 : 1024, (const bf16_t*)A2, (const bf16_t*)Bt2}; pg8::StaticOrder S; S.init(M, N, (int)gridDim.x, (int)blockIdx.x);
    pg8::gemm_phase<Epi, pg8::StaticOrder, false, F8>(lds, g, S, E, nullptr);
}
__global__ void __launch_bounds__(512, 2) fwd_kernel(Params p_unused) {
    extern __shared__ __attribute__((aligned(16))) unsigned char lds_raw[];
#if defined(LAYOUT_SHIFT)
    asm volatile(".fill " LAYOUT_STR(LAYOUT_SHIFT) ", 4, 0xBF800000" :::);
#endif
    LAS unsigned char* lds = (LAS unsigned char*)lds_raw;
    cg::grid_group grid = cg::this_grid();
    CPP p0 = (CPP)__builtin_amdgcn_kernarg_segment_ptr();
    const int ph_lo = p0->ph_lo, ph_hi = p0->ph_hi, coop = p0->coop;
    volatile LAS unsigned* bst = (volatile LAS unsigned*)(lds + LDS_BYTES - 16);
    if (threadIdx.x < 4) bst[threadIdx.x] = 0u;
    __syncthreads();
    XcdBarrier bar = xcd_barrier_post((unsigned*)(p0->ws + OFF_BAR), bst);
    for (int ph = ph_lo; ph < ph_hi; ++ph) {
        CPP p = p0; asm volatile("" : "+s"(p));
        unsigned char* ws = p->ws; float* HC = (float*)(ws + OFF_HC);
        int tid_l = threadIdx.x; asm volatile("" : "+v"(tid_l));
        const int tid = tid_l, lane = tid & 63, wave = __builtin_amdgcn_readfirstlane(tid >> 6);
#if defined(PROBE_STRETCH)
        const unsigned long long pst0 = __builtin_amdgcn_s_memrealtime();
#endif
        if (ph == 0 && EN(20)) prep_phase(p, 0, lds, tid, lane, wave);
        else if (ph == 1 && EN(21)) norm_phase(p, 0, 0, NT, p->in[0], p->in[2], lane, wave);
        else {
            const int layer = (ph - 2) / 12, sub = (ph - 2) % 12, M = layer ? NL : NT;
            if (sub == 0 && EN(0)) { EpiA E{(bf16_t*)(ws + 1 * SLOT), (bf16_t*)(ws + 3 * SLOT), (bf16_t*)(ws + 3 * SLOT) + (size_t)NT * 512, (bf16_t*)(ws + 2 * SLOT), (bf16_t*)(ws + OFF_F), 0.08838834764831845f};
                run_gemm<true>(lds, ws + OFF_HN8, ws + OFF_WA, NT, 3328, E); }
            else if (sub == 1 && EN(1)) gla_phase(p, layer, lds, tid, lane, wave);
            else if (sub == 2 && EN(2)) { lru_phase(p, layer, lds, tid, lane, wave); onorm_phase(p, layer, tid, lane, wave); }
            else if (sub == 3) { }
            else if (sub == 4 && EN(4)) { EpiB E{(const bf16_t*)(ws + 3 * SLOT), (const bf16_t*)(ws + 2 * SLOT), (const bf16_t*)(ws + 4 * SLOT), ws};
                run_gemm<true>(lds, ws + OFF_HN8, ws + OFF_WB, M, 4096, E); }
            else if (sub == 5 && EN(5)) { EpiMM E{ws + OFF_SGL8, ws + OFF_SGG8, ws + OFF_MM8}; run_gemm<true>(lds, ws + OFF_YL8, ws + OFF_WBL, M, 1024, E, ws + OFF_YG8, ws + OFF_WBL + 2 * MiB); }
            else if (sub == 6) { }
            else if (sub == 7 && EN(7)) { EpiOut E{p->in[0], p->in[2], p->out, ws, (const float*)(ws + OFF_MOD) + (size_t)layer * 17 * 6144, layer};
                run_gemm<true>(lds, ws + OFF_MM8, ws + OFF_WBL + 4 * MiB, M, 1024, E); }
            else if (sub == 8 && EN(8)) norm_phase(p, layer, 1, M, p->out, HC, lane, wave);
            else if (sub == 9 && EN(9)) { EpiSc E{(bf16_t*)(ws + 1 * SLOT)}; run_gemm<false>(lds, ws + OFF_HN2, ws + OFF_WSC, M, 2048, E); }
            else if (sub == 10 && EN(10)) peer_phase(p, layer, lds, lane, wave);
            else if (layer == 0 && EN(20)) prep_phase(p, 1, lds, tid, lane, wave);
        }
#if defined(PROBE_STRETCH)
        { const int code = ph == 0 ? 12 : ph == 1 ? 13 : (ph - 2) % 12;
          if ((PROBE_STRETCH >> code) & 1) { const unsigned long long pst1 = __builtin_amdgcn_s_memrealtime(); while (__builtin_amdgcn_s_memrealtime() - pst1 < pst1 - pst0) __builtin_amdgcn_s_sleep(8); } }
#endif
        const bool no_seam = ph >= 2 && ((ph - 2) % 12 == 6 || (ph - 2) % 12 == 3);
        if (coop && ph + 1 < ph_hi && !no_seam) { if (ph == ph_lo) grid.sync(); else xcd_barrier(bar);
#if defined(PROBE_BAR)
            for (int rep = 0; rep < PROBE_BAR; ++rep) xcd_barrier(bar);
#endif
        }
    }
}

extern "C" void kernel_launch(void* const* d_in, const int* in_sizes, int n_in, void* d_out, int out_size, void* d_ws, size_t ws_size, hipStream_t stream) {
    static int grid_blocks = 0;
    if (!grid_blocks) {
        int dev = 0, cus = 0, per_cu = 0;
        (void)hipGetDevice(&dev);
        (void)hipDeviceGetAttribute(&cus, hipDeviceAttributeMultiprocessorCount, dev);
        (void)hipFuncSetAttribute((const void*)fwd_kernel, hipFuncAttributeMaxDynamicSharedMemorySize, LDS_BYTES);
        (void)hipOccupancyMaxActiveBlocksPerMultiprocessor(&per_cu, (const void*)fwd_kernel, 512, LDS_BYTES);
        if (per_cu < 1) { fprintf(stderr, "kernel_launch: occupancy query says %d blocks per CU\n", per_cu); per_cu = 1; }
        grid_blocks = cus * per_cu;
        fprintf(stderr, "kernel_launch: cus %d per_cu %d grid %d ws %zu need %zu\n", cus, per_cu, grid_blocks, ws_size, (size_t)WS_END);
    }
    if (n_in != 27 || ws_size < WS_END) { fprintf(stderr, "kernel_launch: bad inputs (n_in %d, ws %zu < %zu)\n", n_in, ws_size, (size_t)WS_END); return; }
    (void)hipMemsetAsync((char*)d_ws + OFF_BAR, 0, XCD_BAR_WORDS * 4, stream);
    Params p{};
    for (int i = 0; i < 27; ++i) p.in[i] = (const float*)d_in[i];
    p.out = (float*)d_out; p.ws = (unsigned char*)d_ws; p.ph_lo = 0; p.ph_hi = N_PHASES; p.coop = 1; p.pad = 0;
#if defined(MULTI_LAUNCH)
    p.coop = 0;
    for (int ph = 0; ph < N_PHASES; ++ph) { p.ph_lo = ph; p.ph_hi = ph + 1; hipLaunchKernelGGL(fwd_kernel, dim3(grid_blocks), dim3(512), LDS_BYTES, stream, p); }
#else
    void* args[] = {&p};
    hipError_t e = hipLaunchCooperativeKernel((void*)fwd_kernel, dim3(grid_blocks), dim3(512), args, LDS_BYTES, stream);
    if (e != hipSuccess) fprintf(stderr, "cooperative launch failed: %s (grid %d)\n", hipGetErrorString(e), grid_blocks);
#endif
}
```

```cpp
#define LAYOUT_SHIFT 32
#include <hip/hip_runtime.h>
#include <hip/hip_cooperative_groups.h>
#include <cstdio>
namespace cg = cooperative_groups;
namespace pg8 {
#define PG8_LAS __attribute__((address_space(3)))
typedef unsigned short bf16_t;
typedef short bf16x8 __attribute__((ext_vector_type(8)));
typedef float f32x4 __attribute__((ext_vector_type(4)));
typedef unsigned u32x4 __attribute__((ext_vector_type(4)));
constexpr int BM = 256, BK = 64, HALF = 128, HTB = HALF * BK * 2  , STAGE_BYTES = 8 * HTB, NXCD = 8, WGM = 8;

__host__ __device__ __forceinline__ int lds_byte(int r, int c) { const int st = (r >> 4) * 2 + (c >> 5), rr = r & 15, cc = c & 31, ob = rr * 64 + cc * 2; return st * 1024 + (ob ^ (((ob >> 9) & 1) << 5)); }
__host__ __device__ __forceinline__ void stage_rc(int b, int& R, int& C) { const int st = b / 1024, sb = b % 1024, swz = sb ^ (((sb >> 9) & 1) << 5); R = (st >> 1) * 16 + swz / 64; C = (st & 1) * 32 + (swz % 64) / 2; }
__host__ __device__ __forceinline__ int perm32(int rho) { const int n = rho >> 4, i = rho & 15; return 8 * (i >> 2) + 4 * n + (i & 3); }

struct Unit { int pm, pn; };
struct Gemm { const bf16_t* A; const bf16_t* Bt; int M, N, K; const bf16_t* A2; const bf16_t* Bt2; };

struct StaticOrder {
    int nM, nN, nwg, G, c;
    __host__ __device__ void init(int M, int N, int G_, int c_) { nM = M / BM; nN = N / BM; nwg = nM * nN; G = G_; c = c_; }
    __host__ __device__ bool next(int i, Unit& u) const {
        const long L = (long)i * G + c; if (L >= nwg) return false;
        int wgid = (int)L; { const int q = nwg / NXCD, r = nwg % NXCD, xcd = wgid % NXCD, off = wgid / NXCD; wgid = (xcd < r ? xcd * (q + 1) : r * (q + 1) + (xcd - r) * q) + off; }
        const int nig = WGM * nN, gid = wgid / nig, fm = gid * WGM, gsz = (nM - fm) < WGM ? (nM - fm) : WGM;
        u.pm = fm + ((wgid % nig) % gsz); u.pn = (wgid % nig) / gsz; return true;
    }
    __device__ __forceinline__ void a_ready(const Unit&) const {}
    __device__ __forceinline__ void done(const Unit&) const {}
};
__device__ __forceinline__ unsigned cvt_pk_bf16(float lo, float hi) { unsigned r; asm volatile("v_cvt_pk_bf16_f32 %0, %1, %2" : "=v"(r) : "v"(lo), "v"(hi)); return r; }
typedef float f32x2 __attribute__((ext_vector_type(2)));
typedef int i32x4 __attribute__((ext_vector_type(4)));
typedef int i32x8 __attribute__((ext_vector_type(8)));
constexpr int F8_SCALE_W = 0x79797979, F8_SCALE_A = 0x7c7c7c7c;
__device__ __forceinline__ i32x8 cat8(bf16x8 a, bf16x8 b) { const i32x4 x = __builtin_bit_cast(i32x4, a), y = __builtin_bit_cast(i32x4, b); return __builtin_shufflevector(x, y, 0, 1, 2, 3, 4, 5, 6, 7); }
template <class Epi, class Sched, bool STAMP = false, bool F8 = false>
__device__ __forceinline__ void gemm_phase(PG8_LAS unsigned char* lds, const Gemm g, const Sched& S, const Epi& E, unsigned long long* stamps) {
    int tid_l = threadIdx.x; asm volatile("" : "+v"(tid_l)); const int tid = tid_l, wid = __builtin_amdgcn_readfirstlane(tid >> 6), lane = tid & 63, wr = wid >> 2, wc = wid & 3, fr = lane & 15, fq = lane >> 4;
    const int K = g.K, nt = K / BK;
    int ts_lo = 0, ts_hi = 0, nts = 0; const unsigned long long rt_entry = STAMP ? (unsigned long long)wall_clock64() : 0ull;
#define PG8_STAMP() do { if (STAMP && wid == 0 && nts < 64) { const unsigned long long _c = (unsigned long long)clock64(); \
        ts_lo = (lane == nts) ? (int)(unsigned)_c : ts_lo; ts_hi = (lane == nts) ? (int)(unsigned)(_c >> 32) : ts_hi; ++nts; } } while (0)
    PG8_STAMP();
    unsigned voffA[2], voffB[2];
#pragma unroll
    for (int i = 0; i < 2; ++i) { int R, C; stage_rc(tid * 16 + i * 8192, R, C); const int Rb = Epi::PERM ? ((R & ~31) + perm32(R & 31)) : R;
        voffA[i] = (unsigned)(R * K + C) * 2u; voffB[i] = (unsigned)(Rb * K + C) * 2u; }
    const size_t kstep = (size_t)(BK * 2);
    const size_t hstep = (size_t)HALF * K * 2;
    const size_t tstep = 2 * hstep;
    const unsigned ldsw = (unsigned)wid * 1024u;
    const int aoff = lds_byte(wr * 64 + fr, fq * 8), boff = lds_byte(wc * 32 + fr, fq * 8);
#define PG8_SA(b, h) (((b) * 2 + (h)) * HTB)
#define PG8_SB(b, h) ((4 + (b) * 2 + (h)) * HTB)
#define PG8_STAGE(bufoff, gbase, voff) do { _Pragma("unroll") for (int _i = 0; _i < 2; ++_i) \
        __builtin_amdgcn_global_load_lds((const unsigned*)((const char*)(gbase) + (voff)[_i]), (PG8_LAS unsigned*)(lds + (bufoff) + ldsw + _i * 8192), 16, 0, 0); } while (0)
#define PG8_LDA(dst, b, h) do { _Pragma("unroll") for (int m = 0; m < 4; ++m) _Pragma("unroll") for (int k = 0; k < 2; ++k) dst[m][k] = *(const PG8_LAS bf16x8*)(lds + PG8_SA(b, h) + aoff + m * 2048 + k * 1024); } while (0)
#define PG8_LDB(dst, b, h) do { _Pragma("unroll") for (int n = 0; n < 2; ++n) _Pragma("unroll") for (int k = 0; k < 2; ++k) dst[n][k] = *(const PG8_LAS bf16x8*)(lds + PG8_SB(b, h) + boff + n * 2048 + k * 1024); } while (0)
#define PG8_MMA(ai, bj, At, Bt) do { __builtin_amdgcn_s_setprio(1); _Pragma("unroll") for (int m = 0; m < 4; ++m) _Pragma("unroll") for (int n = 0; n < 2; ++n) { \
        if constexpr (F8) asm volatile("v_mfma_scale_f32_16x16x128_f8f6f4 %0, %1, %2, %0, %3, %4 op_sel_hi:[0,0,0]" : "+v"(acc[ai][bj][m][n]) : "v"(cat8(Bt[n][0], Bt[n][1])), "v"(cat8(At[m][0], At[m][1])), "v"(f8sw), "v"(f8sa)); \
        else { _Pragma("unroll") for (int k = 0; k < 2; ++k) acc[ai][bj][m][n] = __builtin_amdgcn_mfma_f32_16x16x32_bf16(Bt[n][k], At[m][k], acc[ai][bj][m][n], 0, 0, 0); } } __builtin_amdgcn_s_setprio(0); } while (0)
#define PG8_WAIT_V(n) asm volatile("s_waitcnt vmcnt(" #n ")" ::: "memory")
#define PG8_WAIT_L(n) asm volatile("s_waitcnt lgkmcnt(" #n ")" ::: "memory")
#define PG8_BAR __builtin_amdgcn_s_barrier()
#define PG8_SCHED __builtin_amdgcn_sched_barrier(0)
    Unit cur, nxt; int ui = 0;
    int f8sw = F8_SCALE_W, f8sa = F8_SCALE_A; asm volatile("" : "+v"(f8sw), "+v"(f8sa));
    if (!S.next(0, cur)) return;
    f32x4 acc[2][2][4][2];
#pragma unroll
    for (int a = 0; a < 2; ++a)
#pragma unroll
        for (int b = 0; b < 2; ++b)
#pragma unroll
            for (int m = 0; m < 4; ++m)
#pragma unroll
                for (int n = 0; n < 2; ++n) acc[a][b][m][n] = (f32x4){0.f, 0.f, 0.f, 0.f};
    bf16x8 At[4][2], B0[2][2], B1[2][2];
    const char* cA = (const char*)g.A + (size_t)cur.pm * tstep; const char* cB = (const char*)g.Bt + (size_t)cur.pn * tstep;
    S.a_ready(cur);
    PG8_STAGE(PG8_SB(0, 0), cB, voffB); PG8_STAGE(PG8_SA(0, 0), cA, voffA); PG8_STAGE(PG8_SB(0, 1), cB + hstep, voffB); PG8_STAGE(PG8_SA(0, 1), cA + hstep, voffA);
    if (wr == 1) PG8_BAR;
    PG8_WAIT_V(4); PG8_BAR;
    PG8_STAGE(PG8_SB(1, 0), cB + kstep, voffB); PG8_STAGE(PG8_SA(1, 0), cA + kstep, voffA); PG8_STAGE(PG8_SB(1, 1), cB + hstep + kstep, voffB);
    PG8_WAIT_V(6); PG8_BAR;
    PG8_STAMP();
    for (;;) {
        const bool seg0 = (Epi::NSEG == 2) && !(ui & 1);
        bool has_next; if (seg0) { has_next = true; nxt = cur; } else has_next = S.next((ui + 1) / Epi::NSEG, nxt);
        const char* nA = has_next ? (const char*)(seg0 ? g.A2 : g.A) + (size_t)nxt.pm * tstep : cA; const char* nB = has_next ? (const char*)(seg0 ? g.Bt2 : g.Bt) + (size_t)nxt.pn * tstep : cB;
#pragma nounroll
        for (int t = 0; t < nt; t += 2) {
            const bool last = (t == nt - 2);
            const char* a1 = cA + (size_t)(t + 1) * kstep;
            const char* a2 = last ? nA : cA + (size_t)(t + 2) * kstep; const char* b2 = last ? nB : cB + (size_t)(t + 2) * kstep;
            const char* a3 = a2 + kstep; const char* b3 = b2 + kstep;
            if (last && has_next) S.a_ready(nxt);
            PG8_LDB(B0, 0, 0); PG8_SCHED; PG8_LDA(At, 0, 0); PG8_STAGE(PG8_SA(1, 1), a1 + hstep, voffA);
            PG8_WAIT_L(8); PG8_BAR; PG8_WAIT_L(0); PG8_MMA(0, 0, At, B0); PG8_BAR; PG8_SCHED;
            PG8_LDB(B1, 0, 1); PG8_STAGE(PG8_SB(0, 0), b2, voffB);
            PG8_BAR; PG8_WAIT_L(0); PG8_MMA(0, 1, At, B1); PG8_BAR;
            PG8_LDA(At, 0, 1); PG8_STAGE(PG8_SA(0, 0), a2, voffA);
            PG8_BAR; PG8_WAIT_L(0); PG8_MMA(1, 0, At, B0); PG8_BAR; PG8_SCHED;
            PG8_STAGE(PG8_SB(0, 1), b2 + hstep, voffB);
            PG8_WAIT_V(6); PG8_BAR; PG8_MMA(1, 1, At, B1); PG8_BAR;
            PG8_LDB(B0, 1, 0); PG8_SCHED; PG8_LDA(At, 1, 0); PG8_STAGE(PG8_SA(0, 1), a2 + hstep, voffA);
            PG8_WAIT_L(8); PG8_BAR; PG8_WAIT_L(0); PG8_MMA(0, 0, At, B0); PG8_BAR; PG8_SCHED;
            PG8_LDB(B1, 1, 1); PG8_STAGE(PG8_SB(1, 0), b3, voffB);
            PG8_BAR; PG8_WAIT_L(0); PG8_MMA(0, 1, At, B1); PG8_BAR;
            PG8_LDA(At, 1, 1); PG8_STAGE(PG8_SA(1, 0), a3, voffA);
            PG8_BAR; PG8_WAIT_L(0); PG8_MMA(1, 0, At, B0); PG8_BAR; PG8_SCHED;
            PG8_STAGE(PG8_SB(1, 1), b3 + hstep, voffB);
            PG8_WAIT_V(6); PG8_BAR; PG8_MMA(1, 1, At, B1); PG8_BAR;
        }
        if constexpr (F8) asm volatile("s_nop 15\n\ts_nop 15" ::: "memory");
        PG8_STAMP();
        if constexpr (Epi::NSEG == 2) { if (seg0) E.mid(acc, cur, wr, wc, fr, fq); else { E(acc, cur, wr, wc, fr, fq); S.done(cur); } }
        else if constexpr (!Epi::AFTER_DRAIN) { E(acc, cur, wr, wc, fr, fq); S.done(cur); }
        PG8_STAMP();
        if (!has_next) break;
        if (!seg0) {
#pragma unroll
        for (int a = 0; a < 2; ++a)
#pragma unroll
            for (int b = 0; b < 2; ++b)
#pragma unroll
                for (int m = 0; m < 4; ++m)
#pragma unroll
                    for (int n = 0; n < 2; ++n) acc[a][b][m][n] = (f32x4){0.f, 0.f, 0.f, 0.f};
        }
        cur = nxt; cA = nA; cB = nB; ++ui;
    }
    PG8_WAIT_V(0);
    if (wr == 0) PG8_BAR;
    PG8_BAR;
    if constexpr (Epi::AFTER_DRAIN) { E.fused(acc, cur, wr, wc, fr, fq, lds, wid, lane); S.done(cur); }
    PG8_STAMP();
    if (STAMP && wid == 0) { stamps[lane] = lane < nts ? (((unsigned long long)(unsigned)ts_hi << 32) | (unsigned)ts_lo) : 0ull;
        if (lane == 62) stamps[62] = rt_entry; if (lane == 63) stamps[63] = (unsigned long long)wall_clock64(); }
#undef PG8_STAMP
#undef PG8_SA
#undef PG8_SB
#undef PG8_STAGE
#undef PG8_LDA
#undef PG8_LDB
#undef PG8_MMA
#undef PG8_WAIT_V
#undef PG8_WAIT_L
#undef PG8_BAR
#undef PG8_SCHED
}
}

using pg8::bf16_t; using pg8::f32x4; using pg8::u32x4; using pg8::Unit;
#define LAS __attribute__((address_space(3)))
typedef unsigned u32x2 __attribute__((ext_vector_type(2)));
typedef float f32x2 __attribute__((ext_vector_type(2)));
typedef short bf16x8_t __attribute__((ext_vector_type(8)));
typedef float f32x16 __attribute__((ext_vector_type(16)));
typedef float f32x32 __attribute__((ext_vector_type(32)));
typedef unsigned u32x6 __attribute__((ext_vector_type(6)));
typedef _Float16 h2_t __attribute__((ext_vector_type(2)));
typedef _Float16 h32_t __attribute__((ext_vector_type(32)));

constexpr int NT = 36864, NL = 32768, NCX = 4096;
constexpr size_t MiB = 1u << 20;
constexpr size_t SLOT = 72 * MiB;
constexpr size_t FIX = 7 * SLOT;
constexpr size_t OFF_HC = FIX;
constexpr size_t OFF_WA = FIX + 16 * MiB;
constexpr size_t OFF_WB = OFF_WA + (size_t)3328 * 2048;
constexpr size_t OFF_WBL = OFF_WB + (size_t)4096 * 2048;
constexpr size_t OFF_WSC = OFF_WBL + 6 * MiB;
constexpr size_t OFF_MOD = OFF_WSC + 4 * MiB;
constexpr size_t OFF_BAR = OFF_MOD + 896 * 1024;
constexpr size_t WS_END = OFF_MOD + 1 * MiB;
constexpr size_t OFF_F = 6 * SLOT;
constexpr size_t OFF_WG = 6 * SLOT + 4 * MiB;
constexpr size_t OFF_EU = 6 * SLOT + 8 * MiB;
constexpr size_t OFF_EV = 6 * SLOT + 40 * MiB;
constexpr int LDS_BYTES = 144 * 1024;
constexpr size_t HSLOT = 36 * MiB;
constexpr size_t OFF_HN8 = 0, OFF_YL8 = HSLOT, OFF_SGL8 = SLOT, OFF_SGG8 = SLOT + HSLOT, OFF_MM8 = 2 * SLOT, OFF_M1 = 3 * SLOT, OFF_HN2 = 3 * SLOT, OFF_YG8 = 5 * SLOT;
constexpr float ACT_S = 8.f, WGT_S = 64.f;
constexpr float EV_S = 2.f;
constexpr float EU_S = 96.f;
typedef unsigned char u8_t;

struct Params { const float* in[27]; float* out; unsigned char* ws; int ph_lo, ph_hi, coop, pad; };
typedef const __attribute__((address_space(4))) Params* CPP;

__device__ __forceinline__ float bf_lo(unsigned w) { return __uint_as_float(w << 16); }
__device__ __forceinline__ float bf_hi(unsigned w) { return __uint_as_float(w & 0xffff0000u); }
__device__ __forceinline__ float bf2f(bf16_t b) { return __uint_as_float(((unsigned)b) << 16); }
typedef __bf16 bf16x2n __attribute__((ext_vector_type(2)));
__device__ __forceinline__ unsigned pk2(float lo, float hi) { const f32x2 v = {lo, hi}; return __builtin_bit_cast(unsigned, __builtin_convertvector(v, bf16x2n)); }
__device__ __forceinline__ bf16_t f2bf(float f) { return (bf16_t)(pk2(f, 0.f) & 0xffffu); }
__device__ __forceinline__ float sigmoidf_(float x) { return __builtin_amdgcn_rcpf(1.f + __expf(-x)); }
__device__ __forceinline__ float siluf_(float x) { return x * sigmoidf_(x); }
__device__ __forceinline__ float gelu_tanh(float x) { return x * sigmoidf_(1.5957691216f * (x + 0.044715f * x * x * x)); }
__device__ __forceinline__ unsigned pk4_f8(float a, float b, float c, float d) {
    const int w = __builtin_amdgcn_cvt_pk_fp8_f32(__builtin_amdgcn_fmed3f(a, -448.f, 448.f), __builtin_amdgcn_fmed3f(b, -448.f, 448.f), 0, false);
    return (unsigned)__builtin_amdgcn_cvt_pk_fp8_f32(__builtin_amdgcn_fmed3f(c, -448.f, 448.f), __builtin_amdgcn_fmed3f(d, -448.f, 448.f), w, true);
}
__device__ __forceinline__ unsigned pk4_u8(float a, float b, float c, float d) {
    unsigned w = __builtin_amdgcn_cvt_pk_u8_f32(a, 0u, 0u); w = __builtin_amdgcn_cvt_pk_u8_f32(b, 1u, w); w = __builtin_amdgcn_cvt_pk_u8_f32(c, 2u, w); return __builtin_amdgcn_cvt_pk_u8_f32(d, 3u, w);
}
__device__ __forceinline__ float ub0(unsigned w) { return (float)(w & 0xffu); }
__device__ __forceinline__ float ub1(unsigned w) { return (float)((w >> 8) & 0xffu); }
__device__ __forceinline__ float ub2(unsigned w) { return (float)((w >> 16) & 0xffu); }
__device__ __forceinline__ float ub3(unsigned w) { return (float)(w >> 24); }
__device__ __forceinline__ float wave_sum(float v) {
#pragma unroll
    for (int o = 32; o >= 1; o >>= 1) v += __shfl_xor(v, o);
    return v;
}
__device__ __forceinline__ float wave_max(float v) {
#pragma unroll
    for (int o = 32; o >= 1; o >>= 1) v = fmaxf(v, __shfl_xor(v, o));
    return v;
}
#define LDS_FENCE() asm volatile("s_waitcnt lgkmcnt(0)" ::: "memory")

__device__ __forceinline__ u32x4 wide_pack(u32x2 r0, u32x2 r1) {
    auto sx = __builtin_amdgcn_permlane16_swap(r0.x, r1.x, false, false); auto sy = __builtin_amdgcn_permlane16_swap(r0.y, r1.y, false, false);
    return (u32x4){sx[0], sy[0], sx[1], sy[1]};
}
__device__ __forceinline__ void wide_unpack(u32x4 w, u32x2& r0, u32x2& r1) {
    auto sx = __builtin_amdgcn_permlane16_swap(w.x, w.z, false, false); auto sy = __builtin_amdgcn_permlane16_swap(w.y, w.w, false, false);
    r0 = (u32x2){sx[0], sy[0]}; r1 = (u32x2){sx[1], sy[1]};
}
__device__ __forceinline__ int wide_col(int wc, int fq) { return wc * 32 + (fq & 1) * 128 + 16 * (fq >> 1); }

struct EpiA {
    static constexpr bool PERM = true, AFTER_DRAIN = false; static constexpr int NSEG = 1;
    bf16_t *X, *Q, *K, *V, *F; float qscale;
    __device__ __forceinline__ void operator()(const f32x4 (&acc)[2][2][4][2], const Unit& u, int wr, int wc, int fr, int fq) const {
        const int pn = u.pn, row0 = u.pm * 256 + wr * 64 + fr;
        if (pn == 12) {
            if (wc == 0) {
#pragma unroll
                for (int ai = 0; ai < 2; ++ai)
#pragma unroll
                    for (int m = 0; m < 4; ++m) { const f32x4 v0 = acc[ai][0][m][0], v1 = acc[ai][0][m][1]; u32x4 w; w.x = pk2(v0[0], v0[1]); w.y = pk2(v0[2], v0[3]); w.z = pk2(v1[0], v1[1]); w.w = pk2(v1[2], v1[3]);
                        *(u32x4*)(F + (size_t)(row0 + ai * 128 + m * 16) * 32 + 8 * fq) = w; }
            }
            return;
        }
        bf16_t* base; int ld, colt; float s = 1.f;
        if (pn < 4) { base = X; ld = 1024; colt = pn * 256; }
        else if (pn < 6) { base = Q; ld = 512; colt = (pn - 4) * 256; s = qscale; }
        else if (pn < 8) { base = K; ld = 512; colt = (pn - 6) * 256; }
        else { base = V; ld = 1024; colt = (pn - 8) * 256; }
        const int col0 = colt + wc * 32 + 8 * fq;
#pragma unroll
        for (int ai = 0; ai < 2; ++ai)
#pragma unroll
            for (int m = 0; m < 4; ++m) { bf16_t* rowp = base + (size_t)(row0 + ai * 128 + m * 16) * ld + col0;
#pragma unroll
                for (int bj = 0; bj < 2; ++bj) { const f32x4 v0 = acc[ai][bj][m][0] * s, v1 = acc[ai][bj][m][1] * s; u32x4 w; w.x = pk2(v0[0], v0[1]); w.y = pk2(v0[2], v0[3]); w.z = pk2(v1[0], v1[1]); w.w = pk2(v1[2], v1[3]);
                    *(u32x4*)(rowp + bj * 128) = w; } }
    }
};
struct EpiB {
    static constexpr bool PERM = true, AFTER_DRAIN = false; static constexpr int NSEG = 1;
    const bf16_t *HF, *HB, *ON; u8_t* ws;
    __device__ __forceinline__ void operator()(const f32x4 (&acc)[2][2][4][2], const Unit& u, int wr, int wc, int fr, int fq) const {
        const int pn = u.pn, row0 = u.pm * 256 + wr * 64 + fr, col0 = (pn & 3) * 256 + wc * 32 + 8 * fq, colw = (pn & 3) * 256 + wide_col(wc, fq);
        constexpr unsigned long long DST_MIB = (unsigned long long)(OFF_YL8 >> 20) | ((unsigned long long)(OFF_YG8 >> 20) << 16) | ((unsigned long long)(OFF_SGL8 >> 20) << 32) | ((unsigned long long)(OFF_SGG8 >> 20) << 48);
        u8_t* dst = ws + ((size_t)((DST_MIB >> (16 * (pn >> 2))) & 0xffffull) << 20);
#pragma unroll
        for (int ai = 0; ai < 2; ++ai) {
            u32x4 l0[4][2], l1[4][2];
            if (pn < 8) {
#pragma unroll
                for (int m = 0; m < 4; ++m)
#pragma unroll
                    for (int bj = 0; bj < 2; ++bj) { const size_t o = (size_t)(row0 + ai * 128 + m * 16) * 1024 + col0 + bj * 128;
                        if (pn < 4) { l0[m][bj] = *(const u32x4*)(HF + o); l1[m][bj] = *(const u32x4*)(HB + o); } else l0[m][bj] = *(const u32x4*)(ON + o); }
            }
#pragma unroll
            for (int m = 0; m < 4; ++m) { u32x2 res[2];
#pragma unroll
                for (int bj = 0; bj < 2; ++bj) { const f32x4 v0 = acc[ai][bj][m][0], v1 = acc[ai][bj][m][1]; float a[8] = {v0[0], v0[1], v0[2], v0[3], v1[0], v1[1], v1[2], v1[3]}; float y[8];
                    if (pn < 4) { const u32x4 hf = l0[m][bj], hb = l1[m][bj]; const unsigned hw[4] = {hf.x, hf.y, hf.z, hf.w}, gw[4] = {hb.x, hb.y, hb.z, hb.w};
#pragma unroll
                        for (int j = 0; j < 4; ++j) { y[2 * j] = (bf_lo(hw[j]) + bf_lo(gw[j])) * (ACT_S * gelu_tanh(a[2 * j])); y[2 * j + 1] = (bf_hi(hw[j]) + bf_hi(gw[j])) * (ACT_S * gelu_tanh(a[2 * j + 1])); }
                        res[bj] = (u32x2){pk4_f8(y[0], y[1], y[2], y[3]), pk4_f8(y[4], y[5], y[6], y[7])}; }
                    else if (pn < 8) { const u32x4 on = l0[m][bj]; const unsigned hw[4] = {on.x, on.y, on.z, on.w};
#pragma unroll
                        for (int j = 0; j < 4; ++j) { y[2 * j] = bf_lo(hw[j]) * (ACT_S * siluf_(a[2 * j])); y[2 * j + 1] = bf_hi(hw[j]) * (ACT_S * siluf_(a[2 * j + 1])); }
                        res[bj] = (u32x2){pk4_f8(y[0], y[1], y[2], y[3]), pk4_f8(y[4], y[5], y[6], y[7])}; }
                    else {
#pragma unroll
                        for (int j = 0; j < 8; ++j) y[j] = fmaxf(255.f * sigmoidf_(a[j]), 1.f);
                        res[bj] = (u32x2){pk4_u8(y[0], y[1], y[2], y[3]), pk4_u8(y[4], y[5], y[6], y[7])}; }
                }
                const u32x4 w = wide_pack(res[0], res[1]); const size_t ow = (size_t)(row0 + ai * 128 + m * 16) * 1024 + colw;
                *(u32x4*)(dst + ow) = w; }
            asm volatile("" ::: "memory"); }
    }
};
template <int SECOND> struct EpiM {
    static constexpr bool PERM = true, AFTER_DRAIN = false; static constexpr int NSEG = 1;
    const u8_t* G; bf16_t* M1; u8_t* MM;
    __device__ __forceinline__ void operator()(const f32x4 (&acc)[2][2][4][2], const Unit& u, int wr, int wc, int fr, int fq) const {
        const int row0 = u.pm * 256 + wr * 64 + fr, col0 = u.pn * 256 + wc * 32 + 8 * fq;
#pragma unroll
        for (int ai = 0; ai < 2; ++ai) {
            u32x2 gl[4][2]; u32x4 pl[4][2];
#pragma unroll
            for (int m = 0; m < 4; ++m)
#pragma unroll
                for (int bj = 0; bj < 2; ++bj) { const size_t o = (size_t)(row0 + ai * 128 + m * 16) * 1024 + col0 + bj * 128; gl[m][bj] = *(const u32x2*)(G + o); if (SECOND) pl[m][bj] = *(const u32x4*)(M1 + o); }
#pragma unroll
            for (int m = 0; m < 4; ++m) { const size_t off = (size_t)(row0 + ai * 128 + m * 16) * 1024 + col0;
#pragma unroll
                for (int bj = 0; bj < 2; ++bj) { const f32x4 v0 = acc[ai][bj][m][0], v1 = acc[ai][bj][m][1]; const float a[8] = {v0[0], v0[1], v0[2], v0[3], v1[0], v1[1], v1[2], v1[3]}; float y[8];
                    const size_t o = off + bj * 128; const u32x2 g = gl[m][bj];
                    const float gf[8] = {ub0(g.x), ub1(g.x), ub2(g.x), ub3(g.x), ub0(g.y), ub1(g.y), ub2(g.y), ub3(g.y)};
                    if (SECOND) { const u32x4 p1 = pl[m][bj]; const unsigned pw[4] = {p1.x, p1.y, p1.z, p1.w};
#pragma unroll
                        for (int j = 0; j < 4; ++j) { y[2 * j] = ACT_S * bf_lo(pw[j]) + (ACT_S / 255.f) * gf[2 * j] * a[2 * j]; y[2 * j + 1] = ACT_S * bf_hi(pw[j]) + (ACT_S / 255.f) * gf[2 * j + 1] * a[2 * j + 1]; }
                        *(u32x2*)(MM + o) = (u32x2){pk4_f8(y[0], y[1], y[2], y[3]), pk4_f8(y[4], y[5], y[6], y[7])}; }
                    else {
#pragma unroll
                        for (int j = 0; j < 8; ++j) y[j] = (1.f / 255.f) * gf[j] * a[j];
                        u32x4 w; w.x = pk2(y[0], y[1]); w.y = pk2(y[2], y[3]); w.z = pk2(y[4], y[5]); w.w = pk2(y[6], y[7]); *(u32x4*)(M1 + o) = w; } } }
            asm volatile("" ::: "memory"); }
    }
};
struct EpiMM {
    static constexpr bool PERM = true, AFTER_DRAIN = false; static constexpr int NSEG = 2;
    const u8_t *GL, *GG; u8_t* MM;
    __device__ __forceinline__ void mid(f32x4 (&acc)[2][2][4][2], const Unit& u, int wr, int wc, int fr, int fq) const {
        const int row0 = u.pm * 256 + wr * 64 + fr, colw = u.pn * 256 + wide_col(wc, fq);
#pragma unroll
        for (int ai = 0; ai < 2; ++ai)
#pragma unroll
            for (int mh = 0; mh < 2; ++mh) {
                u32x4 gl[2], gg[2];
#pragma unroll
                for (int mm = 0; mm < 2; ++mm) { const size_t o = (size_t)(row0 + ai * 128 + (2 * mh + mm) * 16) * 1024 + colw; gl[mm] = *(const u32x4*)(GL + o); gg[mm] = *(const u32x4*)(GG + o); }
#pragma unroll
                for (int mm = 0; mm < 2; ++mm) { const int m = 2 * mh + mm; u32x2 a2[2], g2[2]; wide_unpack(gl[mm], a2[0], a2[1]); wide_unpack(gg[mm], g2[0], g2[1]);
#pragma unroll
                    for (int bj = 0; bj < 2; ++bj) { const u32x2 a = a2[bj], g = g2[bj];
                        acc[ai][bj][m][0] *= (f32x4){ub0(a.x) * __builtin_amdgcn_rcpf(ub0(g.x)), ub1(a.x) * __builtin_amdgcn_rcpf(ub1(g.x)), ub2(a.x) * __builtin_amdgcn_rcpf(ub2(g.x)), ub3(a.x) * __builtin_amdgcn_rcpf(ub3(g.x))};
                        acc[ai][bj][m][1] *= (f32x4){ub0(a.y) * __builtin_amdgcn_rcpf(ub0(g.y)), ub1(a.y) * __builtin_amdgcn_rcpf(ub1(g.y)), ub2(a.y) * __builtin_amdgcn_rcpf(ub2(g.y)), ub3(a.y) * __builtin_amdgcn_rcpf(ub3(g.y))}; } }
                asm volatile("" ::: "memory"); }
    }
    __device__ __forceinline__ void operator()(const f32x4 (&acc)[2][2][4][2], const Unit& u, int wr, int wc, int fr, int fq) const {
        const int row0 = u.pm * 256 + wr * 64 + fr, colw = u.pn * 256 + wide_col(wc, fq);
#pragma unroll
        for (int ai = 0; ai < 2; ++ai) {
            u32x4 gg[4];
#pragma unroll
            for (int m = 0; m < 4; ++m) gg[m] = *(const u32x4*)(GG + (size_t)(row0 + ai * 128 + m * 16) * 1024 + colw);
#pragma unroll
            for (int m = 0; m < 4; ++m) { u32x2 g2[2], res[2]; wide_unpack(gg[m], g2[0], g2[1]); const float s = ACT_S / 255.f;
#pragma unroll
                for (int bj = 0; bj < 2; ++bj) { const u32x2 g = g2[bj]; const f32x4 v0 = acc[ai][bj][m][0], v1 = acc[ai][bj][m][1];
                    res[bj] = (u32x2){pk4_f8(s * ub0(g.x) * v0[0], s * ub1(g.x) * v0[1], s * ub2(g.x) * v0[2], s * ub3(g.x) * v0[3]), pk4_f8(s * ub0(g.y) * v1[0], s * ub1(g.y) * v1[1], s * ub2(g.y) * v1[2], s * ub3(g.y) * v1[3])}; }
                *(u32x4*)(MM + (size_t)(row0 + ai * 128 + m * 16) * 1024 + colw) = wide_pack(res[0], res[1]); }
            asm volatile("" ::: "memory"); }
    }
};
__device__ __forceinline__ bf16_t* h_row(float* out, unsigned char* ws, int r) { return r < NL ? (bf16_t*)((unsigned char*)out + (size_t)r * 4096 + 2048) : (bf16_t*)(ws + OFF_HC) + (size_t)(r - NL) * 1024; }
struct EpiOut {
    static constexpr bool PERM = true, AFTER_DRAIN = false; static constexpr int NSEG = 1;
    const float *inL, *inC; float* out; unsigned char* ws; const float* mod; int layer;
    __device__ __forceinline__ void operator()(const f32x4 (&acc)[2][2][4][2], const Unit& u, int wr, int wc, int fr, int fq) const {
        const bool lat = u.pm < 128; const int row0 = u.pm * 256 + wr * 64 + fr, col0 = u.pn * 256 + wc * 32 + 8 * fq;
        const float* g1 = mod + (size_t)(lat ? (u.pm >> 3) : 16) * 6144 + 2048 + col0;
        f32x4 gv[2][2];
#pragma unroll
        for (int bj = 0; bj < 2; ++bj) { gv[bj][0] = *(const f32x4*)(g1 + bj * 128); gv[bj][1] = *(const f32x4*)(g1 + bj * 128 + 4); }
#pragma unroll
        for (int ai = 0; ai < 2; ++ai)
#pragma unroll
            for (int mh = 0; mh < 2; ++mh) {
                f32x4 h0[2][2], h1[2][2];
#pragma unroll
                for (int mm = 0; mm < 2; ++mm)
#pragma unroll
                    for (int bj = 0; bj < 2; ++bj) { const int r = row0 + ai * 128 + (2 * mh + mm) * 16;
                        if (layer == 0) { const float* src = (lat ? inL + (size_t)r * 1024 : inC + (size_t)(r - NL) * 1024) + col0 + bj * 128; h0[mm][bj] = *(const f32x4*)src; h1[mm][bj] = *(const f32x4*)(src + 4); }
                        else { const u32x4 w = *(const u32x4*)(h_row(out, ws, r) + col0 + bj * 128); h0[mm][bj] = (f32x4){bf_lo(w.x), bf_hi(w.x), bf_lo(w.y), bf_hi(w.y)}; h1[mm][bj] = (f32x4){bf_lo(w.z), bf_hi(w.z), bf_lo(w.w), bf_hi(w.w)}; } }
#pragma unroll
                for (int mm = 0; mm < 2; ++mm) { const int m = 2 * mh + mm, r = row0 + ai * 128 + m * 16; bf16_t* hr = h_row(out, ws, r) + col0;
#pragma unroll
                    for (int bj = 0; bj < 2; ++bj) { const f32x4 y0 = h0[mm][bj] + gv[bj][0] * acc[ai][bj][m][0], y1 = h1[mm][bj] + gv[bj][1] * acc[ai][bj][m][1];
                        u32x4 o; o.x = pk2(y0[0], y0[1]); o.y = pk2(y0[2], y0[3]); o.z = pk2(y1[0], y1[1]); o.w = pk2(y1[2], y1[3]); *(u32x4*)(hr + bj * 128) = o; } }
                asm volatile("" ::: "memory"); }
    }
};
struct EpiSc {
    static constexpr bool PERM = true, AFTER_DRAIN = false; static constexpr int NSEG = 1;
    bf16_t* SC;
    __device__ __forceinline__ void operator()(const f32x4 (&acc)[2][2][4][2], const Unit& u, int wr, int wc, int fr, int fq) const {
        const int row0 = u.pm * 256 + wr * 64 + fr, col0 = u.pn * 256 + wc * 32 + 8 * fq;
#pragma unroll
        for (int ai = 0; ai < 2; ++ai)
#pragma unroll
            for (int m = 0; m < 4; ++m) { bf16_t* rowp = SC + (size_t)(row0 + ai * 128 + m * 16) * 2048 + col0;
#pragma unroll
                for (int bj = 0; bj < 2; ++bj) { const f32x4 v0 = acc[ai][bj][m][0], v1 = acc[ai][bj][m][1]; u32x4 w; w.x = pk2(v0[0], v0[1]); w.y = pk2(v0[2], v0[3]); w.z = pk2(v1[0], v1[1]); w.w = pk2(v1[2], v1[3]);
                    *(u32x4*)(rowp + bj * 128) = w; } }
    }
};
#define XB_TMO      128
#define XB_XCNT(j)  (256  + 64 * (j))
#define XB_XSUB(j)  (1280 + 64 * (j))
#define XB_XGEN(j)  (2304 + 64 * (j))
#define XB_TOP      3328
#define XB_TOPGEN   3392
#define XCD_BAR_WORDS 3456
#define XB_SPIN_CAP (1u << 18)

__device__ __forceinline__ unsigned xb_ld(unsigned* p)              { return __hip_atomic_load(p, __ATOMIC_RELAXED, __HIP_MEMORY_SCOPE_AGENT); }
__device__ __forceinline__ unsigned xb_add(unsigned* p, unsigned v) { return __hip_atomic_fetch_add(p, v, __ATOMIC_RELAXED, __HIP_MEMORY_SCOPE_AGENT); }
__device__ __forceinline__ unsigned xb_xcc_id() { return (unsigned)__builtin_amdgcn_s_getreg((3 << 11) | 20) & 0xFu; }
#define XB_SPIN(cond, bar) do { unsigned _sp = 0; while (cond) { __builtin_amdgcn_s_sleep(1); \
    if ((++_sp & 255u) == 0u) { if (xb_ld(&(bar)[XB_TMO])) break; if (_sp > XB_SPIN_CAP) { atomicAdd(&(bar)[XB_TMO], 1u); break; } } } } while (0)

struct XcdBarrier {
    unsigned* bar; unsigned x;
    volatile LAS unsigned* st;
};

__device__ __forceinline__ XcdBarrier xcd_barrier_post(unsigned* bar, volatile LAS unsigned* st) {
    XcdBarrier b; b.bar = bar; b.x = xb_xcc_id(); b.st = st;
    if (threadIdx.x == 0) (void)xb_add(&bar[XB_XCNT(b.x)], 1u);
    return b;
}
__device__ __forceinline__ void xcd_barrier_complete(unsigned* bar, unsigned x, unsigned& nloc, unsigned& nx) {
    const unsigned G = gridDim.x * gridDim.y * gridDim.z;
    unsigned sum, cnt, mine, sp = 0u;
    for (;;) {
        sum = 0u; cnt = 0u; mine = 0u;
#pragma unroll
        for (unsigned j = 0; j < 16; ++j) { const unsigned c = xb_ld(&bar[XB_XCNT(j)]); sum += c; cnt += (c > 0u) ? 1u : 0u; mine = (j == x) ? c : mine; }
        if (sum == G) break;
        __builtin_amdgcn_s_sleep(1);
        if ((++sp & 255u) == 0u) { if (xb_ld(&bar[XB_TMO])) break; if (sp > XB_SPIN_CAP) { atomicAdd(&bar[XB_TMO], 1u); break; } }
    }
    nloc = mine > 0u ? mine : 1u; nx = cnt > 0u ? cnt : 1u;
}

__device__ __forceinline__ void xcd_barrier(const XcdBarrier& b) {
    asm volatile("s_waitcnt vmcnt(0)" ::: "memory");
    __syncthreads();
    if (threadIdx.x == 0) {
        unsigned* bar = b.bar;
        __builtin_amdgcn_s_waitcnt(0);
        unsigned nloc = b.st[0], nx = b.st[1];
        if (nloc == 0u) { xcd_barrier_complete(bar, b.x, nloc, nx); b.st[0] = nloc; b.st[1] = nx; }
        const unsigned old = xb_add(&bar[XB_XSUB(b.x)], 1u);
        const unsigned gen = old / nloc;
        if (old + 1u == (gen + 1u) * nloc) {
            __builtin_amdgcn_fence(__ATOMIC_RELEASE, "agent");
            asm volatile("s_waitcnt vmcnt(0)" ::: "memory");
            const unsigned og = xb_add(&bar[XB_TOP], 1u);
            const unsigned tg = og / nx;
            if (og + 1u == (tg + 1u) * nx) xb_add(&bar[XB_TOPGEN], 1u);
            else XB_SPIN(xb_ld(&bar[XB_TOPGEN]) == tg, bar);
            __builtin_amdgcn_fence(__ATOMIC_ACQUIRE, "agent");
            xb_add(&bar[XB_XGEN(b.x)], 1u);
            asm volatile("s_waitcnt vmcnt(0)" ::: "memory");
        } else {
            XB_SPIN(xb_ld(&bar[XB_XGEN(b.x)]) == gen, bar);
            __builtin_amdgcn_fence(__ATOMIC_ACQUIRE, "agent");
            asm volatile("s_waitcnt vmcnt(0)" ::: "memory");
        }
    }
    __syncthreads();
}

__device__ __forceinline__ void transpose_item(const float* W, int N, u8_t* WT, int drow, int k0, int n0, LAS float* scr, int lane) {
#pragma unroll 8
    for (int i = 0; i < 32; ++i) { const int kk = 2 * i + (lane >> 5); scr[kk * 33 + (lane & 31)] = W[(size_t)(k0 + kk) * N + n0 + (lane & 31)]; }
    LDS_FENCE();
    const int c = lane & 7;
#pragma unroll
    for (int j = 0; j < 4; ++j) { const int n = (lane >> 3) + 8 * j; const LAS float* s = scr + (8 * c) * 33 + n;
        u32x2 o; o.x = pk4_f8(WGT_S * s[0 * 33], WGT_S * s[1 * 33], WGT_S * s[2 * 33], WGT_S * s[3 * 33]); o.y = pk4_f8(WGT_S * s[4 * 33], WGT_S * s[5 * 33], WGT_S * s[6 * 33], WGT_S * s[7 * 33]);
        *(u32x2*)(WT + (size_t)(drow + n) * 1024 + k0 + 8 * c) = o; }
    LDS_FENCE();
}
__device__ __forceinline__ void prep_phase(CPP p, int layer, LAS unsigned char* lds, int tid, int lane, int wave) {
    unsigned char* ws = p->ws;
    const int gw = blockIdx.x * 8 + wave, NGW = gridDim.x * 8;
    if (layer == 0) {
        LAS float* sc = (LAS float*)(lds + 69632);
        LAS float* red = (LAS float*)lds;
        for (int e = tid; e < 17 * 1024; e += 512) { const int r = e >> 10, k = e & 1023; const float c = r < 16 ? p->in[1][r * 1024 + k] : p->in[3][k]; sc[e] = siluf_(c); }
        __syncthreads();
        float* MOD = (float*)(ws + OFF_MOD);
        for (int it = blockIdx.x; it < 192; it += gridDim.x) {
            const int l = it / 96, n0 = (it % 96) * 64;
            float acc[17];
#pragma unroll
            for (int r = 0; r < 17; ++r) acc[r] = 0.f;
            const float* wm = p->in[4] + ((size_t)l * 1024 + wave * 128) * 6144 + n0 + lane;
#pragma unroll 4
            for (int k = 0; k < 128; ++k) { const float w = wm[(size_t)k * 6144];
#pragma unroll
                for (int r = 0; r < 17; ++r) acc[r] += sc[r * 1024 + wave * 128 + k] * w; }
#pragma unroll
            for (int r = 0; r < 17; ++r) red[(wave * 17 + r) * 64 + lane] = acc[r];
            __syncthreads();
            for (int e = tid; e < 17 * 64; e += 512) { const int r = e >> 6, nn = e & 63; float s = p->in[5][l * 6144 + n0 + nn];
#pragma unroll
                for (int w = 0; w < 8; ++w) s += red[(w * 17 + r) * 64 + nn];
                MOD[((size_t)l * 17 + r) * 6144 + n0 + nn] = s; }
            __syncthreads();
        }
    }
    LAS float* scr = (LAS float*)(lds + wave * 8448);
    u8_t* WA = ws + OFF_WA; u8_t* WB = ws + OFF_WB;
    const float* w_in = p->in[8] + (size_t)layer * 1024 * 7200;
    for (int it = gw; it < 5136; it += NGW) {
        const float* W; int N, kb, nb, drow; u8_t* WT;
        if (it < 3600) { kb = it / 225; nb = it % 225; W = w_in; N = 7200; const int n0 = nb * 32;
            if (n0 < 1024) { WT = WA; drow = n0; }
            else if (n0 < 2048) { WT = WB; drow = n0 - 1024; }
            else if (n0 < 2560) { WT = WA; drow = 1024 + (n0 - 2048); }
            else if (n0 < 3072) { WT = WA; drow = 1536 + (n0 - 2560); }
            else if (n0 < 4096) { WT = WA; drow = 2048 + (n0 - 3072); }
            else if (n0 < 5120) { WT = WB; drow = 1024 + (n0 - 4096); }
            else if (n0 < 5152) { WT = WA; drow = 3072; }
            else if (n0 < 6176) { WT = WB; drow = 2048 + (n0 - 5152); }
            else { WT = WB; drow = 3072 + (n0 - 6176); }
        } else { int r = it - 3600; const int mi = r / 512; r %= 512; kb = r / 32; nb = r % 32; N = 1024; W = p->in[19 + mi] + (size_t)layer * 1024 * 1024; WT = ws + OFF_WBL + (size_t)mi * 2 * MiB; drow = nb * 32; }
        transpose_item(W, N, WT, drow, kb * 64, nb * 32, scr, lane);
    }
    for (int i = blockIdx.x * 512 + tid; i < 224 * 1024 / 16; i += gridDim.x * 512) ((u32x4*)(WA + (size_t)3104 * 1024))[i] = (u32x4){0u, 0u, 0u, 0u};
    const float* wq = p->in[22] + (size_t)layer * 1024 * 2048; const float* keys = p->in[23] + (size_t)layer * 2 * 128 * 128; bf16_t* WSC = (bf16_t*)(ws + OFF_WSC);
    for (int it = gw; it < 2048; it += NGW) {
        const int hz = it >> 7, i0 = (it & 127) * 8, z = hz & 1;
        float a0[8], a1[8];
#pragma unroll
        for (int ii = 0; ii < 8; ++ii) { a0[ii] = 0.f; a1[ii] = 0.f; }
        const float* kr0 = keys + (size_t)(z * 128 + lane) * 128; const float* kr1 = kr0 + 64 * 128; const float* wr_ = wq + (size_t)i0 * 2048 + hz * 128;
        for (int d4 = 0; d4 < 32; ++d4) { const f32x4 k0 = *(const f32x4*)(kr0 + 4 * d4), k1 = *(const f32x4*)(kr1 + 4 * d4);
#pragma unroll
            for (int ii = 0; ii < 8; ++ii) { const f32x4 q = *(const f32x4*)(wr_ + (size_t)ii * 2048 + 4 * d4);
                a0[ii] += q[0] * k0[0] + q[1] * k0[1] + q[2] * k0[2] + q[3] * k0[3]; a1[ii] += q[0] * k1[0] + q[1] * k1[1] + q[2] * k1[2] + q[3] * k1[3]; } }
        u32x4 o; o.x = pk2(a0[0], a0[1]); o.y = pk2(a0[2], a0[3]); o.z = pk2(a0[4], a0[5]); o.w = pk2(a0[6], a0[7]); *(u32x4*)(WSC + (size_t)(hz * 128 + lane) * 1024 + i0) = o;
        o.x = pk2(a1[0], a1[1]); o.y = pk2(a1[2], a1[3]); o.z = pk2(a1[4], a1[5]); o.w = pk2(a1[6], a1[7]); *(u32x4*)(WSC + (size_t)(hz * 128 + 64 + lane) * 1024 + i0) = o;
    }
    bf16_t* WG = (bf16_t*)(ws + OFF_WG);
    for (int e = blockIdx.x * 512 + tid; e < 2 * 2 * 16 * 64 * 8; e += gridDim.x * 512) {
        const int i8 = e & 7, j = (e >> 3) & 63, hb = (e >> 9) & 15, gate = (e >> 13) & 1, dir = e >> 14;
        const float* src = p->in[gate ? 13 : 11] + ((size_t)((layer * 2 + dir) * 16 + hb) * 64 + i8 * 8) * 64 + j;
        u32x4 o; o.x = pk2(src[0], src[64]); o.y = pk2(src[128], src[192]); o.z = pk2(src[256], src[320]); o.w = pk2(src[384], src[448]);
        *(u32x4*)(WG + (size_t)e * 8) = o;
    }
}
__device__ __forceinline__ void norm_phase(CPP p, int layer, int which, int nrows, const float* HL, const float* HCp, int lane, int wave) {
    const int gw = blockIdx.x * 8 + wave, NGW = gridDim.x * 8;
    bf16_t* HN2 = (bf16_t*)(p->ws + OFF_HN2); u8_t* HN8 = p->ws + OFF_HN8; const float* MOD = (const float*)(p->ws + OFF_MOD) + (size_t)layer * 17 * 6144 + which * 3072; const float* gn = p->in[6 + which] + layer * 1024;
    if (which == 0) {
        for (int r0 = gw; r0 < nrows; r0 += 2 * NGW) {
            const bool two = r0 + NGW < nrows; const int rr[2] = {r0, two ? r0 + NGW : r0};
            f32x4 v[2][4]; float ss[2] = {0.f, 0.f};
#pragma unroll
            for (int q = 0; q < 2; ++q) { const int r = rr[q]; const float* src = r < NL ? HL + (size_t)r * 1024 : HCp + (size_t)(r - NL) * 1024;
#pragma unroll
                for (int j = 0; j < 4; ++j) v[q][j] = ((const f32x4*)src)[lane + 64 * j]; }
#pragma unroll
            for (int q = 0; q < 2; ++q)
#pragma unroll
                for (int j = 0; j < 4; ++j) ss[q] += v[q][j][0] * v[q][j][0] + v[q][j][1] * v[q][j][1] + v[q][j][2] * v[q][j][2] + v[q][j][3] * v[q][j][3];
            const float rstd[2] = {rsqrtf(wave_sum(ss[0]) * (1.f / 1024.f) + 1e-6f), rsqrtf(wave_sum(ss[1]) * (1.f / 1024.f) + 1e-6f)};
            unsigned o[2][4];
#pragma unroll
            for (int q = 0; q < 2; ++q) { const int r = rr[q]; const float* md = MOD + (size_t)(r < NL ? (r >> 11) : 16) * 6144;
#pragma unroll
                for (int j = 0; j < 4; ++j) { const f32x4 g = ((const f32x4*)gn)[lane + 64 * j], sh = ((const f32x4*)md)[lane + 64 * j], sc = ((const f32x4*)(md + 1024))[lane + 64 * j];
                    const f32x4 y = v[q][j] * rstd[q] * g * (sc + 1.f) + sh; o[q][j] = pk4_f8(ACT_S * y[0], ACT_S * y[1], ACT_S * y[2], ACT_S * y[3]); } }
#pragma unroll
            for (int j = 0; j < 4; ++j) ((unsigned*)(HN8 + (size_t)rr[0] * 1024))[lane + 64 * j] = o[0][j];
            if (two) {
#pragma unroll
                for (int j = 0; j < 4; ++j) ((unsigned*)(HN8 + (size_t)rr[1] * 1024))[lane + 64 * j] = o[1][j]; }
        }
    } else {
        for (int r0 = gw; r0 < nrows; r0 += 2 * NGW) {
            const bool two = r0 + NGW < nrows; const int rr[2] = {r0, two ? r0 + NGW : r0};
            u32x4 w[2][2]; float v[2][16], ss[2] = {0.f, 0.f};
#pragma unroll
            for (int q = 0; q < 2; ++q) { const u32x4* src = (const u32x4*)(h_row(p->out, p->ws, rr[q]) + 16 * lane); w[q][0] = src[0]; w[q][1] = src[1]; }
#pragma unroll
            for (int q = 0; q < 2; ++q) { const unsigned ww[8] = {w[q][0].x, w[q][0].y, w[q][0].z, w[q][0].w, w[q][1].x, w[q][1].y, w[q][1].z, w[q][1].w};
#pragma unroll
                for (int j = 0; j < 8; ++j) { v[q][2 * j] = bf_lo(ww[j]); v[q][2 * j + 1] = bf_hi(ww[j]); ss[q] += v[q][2 * j] * v[q][2 * j] + v[q][2 * j + 1] * v[q][2 * j + 1]; } }
            const float rstd[2] = {rsqrtf(wave_sum(ss[0]) * (1.f / 1024.f) + 1e-6f), rsqrtf(wave_sum(ss[1]) * (1.f / 1024.f) + 1e-6f)};
            u32x4 o[2][2];
#pragma unroll
            for (int q = 0; q < 2; ++q) { const int r = rr[q]; const float* md = MOD + (size_t)(r < NL ? (r >> 11) : 16) * 6144 + 16 * lane; float y[16];
#pragma unroll
                for (int j = 0; j < 4; ++j) { const f32x4 g = ((const f32x4*)(gn + 16 * lane))[j], sh = ((const f32x4*)md)[j], sc = ((const f32x4*)(md + 1024))[j];
#pragma unroll
                    for (int i = 0; i < 4; ++i) y[4 * j + i] = v[q][4 * j + i] * rstd[q] * g[i] * (sc[i] + 1.f) + sh[i]; }
                o[q][0].x = pk2(y[0], y[1]); o[q][0].y = pk2(y[2], y[3]); o[q][0].z = pk2(y[4], y[5]); o[q][0].w = pk2(y[6], y[7]); o[q][1].x = pk2(y[8], y[9]); o[q][1].y = pk2(y[10], y[11]); o[q][1].z = pk2(y[12], y[13]); o[q][1].w = pk2(y[14], y[15]); }
            { u32x4* d = (u32x4*)(HN2 + (size_t)rr[0] * 1024 + 16 * lane); d[0] = o[0][0]; d[1] = o[0][1]; }
            if (two) { u32x4* d = (u32x4*)(HN2 + (size_t)rr[1] * 1024 + 16 * lane); d[0] = o[1][0]; d[1] = o[1][1]; }
        }
    }
}
__device__ __forceinline__ int gla_row(int b, int dir, int s) {
    if (s < 256) return NL + b * 256 + (dir ? 255 - s : s);
    const int j = dir ? 2047 - (s - 256) : (s - 256);
    return b * 2048 + (j & 31) * 64 + (j >> 5);
}
__device__ __forceinline__ void gla_naive_phase(CPP p, int layer, LAS unsigned char* lds, int tid) {
    const bf16_t* Q = (const bf16_t*)(p->ws + 3 * SLOT); const bf16_t* K = Q + (size_t)NT * 512; const bf16_t* V = (const bf16_t*)(p->ws + 2 * SLOT); const bf16_t* F = (const bf16_t*)(p->ws + OFF_F);
    LAS float* sA = (LAS float*)lds; LAS float* sK = sA + 512; LAS float* sQ = sK + 512; LAS float* sO = sQ + 512;
    const int tt = tid >> 7, dkk = tid & 127, dv = tid & 255, half = tid >> 8;
    for (int item = blockIdx.x; item < 128; item += gridDim.x) {
        const int b = item >> 3, h = (item >> 1) & 3, dir = item & 1;
        bf16_t* O = (bf16_t*)(p->ws + (size_t)(4 + dir) * SLOT);
        const float* wf = p->in[16] + ((size_t)(layer * 2 + dir) * 16) * 512 + h * 128 + dkk; const float bfv = p->in[17][(layer * 2 + dir) * 512 + h * 128 + dkk];
        float wfr[16];
#pragma unroll
        for (int j = 0; j < 16; ++j) wfr[j] = wf[j * 512];
        float S[64];
#pragma unroll
        for (int i = 0; i < 64; ++i) S[i] = 0.f;
        for (int s4 = 0; s4 < 576; ++s4) {
            { const int r = gla_row(b, dir, s4 * 4 + tt);
              const u32x4* fp = (const u32x4*)(F + (size_t)r * 32 + dir * 16); const u32x4 f0 = fp[0], f1 = fp[1]; const unsigned fw[8] = {f0.x, f0.y, f0.z, f0.w, f1.x, f1.y, f1.z, f1.w};
              float z = bfv;
#pragma unroll
              for (int j = 0; j < 8; ++j) z += bf_lo(fw[j]) * wfr[2 * j] + bf_hi(fw[j]) * wfr[2 * j + 1];
              const float lg = (fminf(z, 0.f) - log1pf(__expf(-fabsf(z)))) * (1.f / 16.f);
              sA[tid] = __expf(lg); sK[tid] = bf2f(K[(size_t)r * 512 + h * 128 + dkk]); sQ[tid] = bf2f(Q[(size_t)r * 512 + h * 128 + dkk]); }
            __syncthreads();
#pragma unroll
            for (int t4 = 0; t4 < 4; ++t4) { const int r = gla_row(b, dir, s4 * 4 + t4); const float v = bf2f(V[(size_t)r * 1024 + h * 256 + dv]); float op = 0.f;
#pragma unroll
                for (int i = 0; i < 64; ++i) { const int dk = t4 * 128 + half * 64 + i; S[i] = sA[dk] * S[i] + sK[dk] * v; op += sQ[dk] * S[i]; }
                sO[(t4 * 2 + half) * 256 + dv] = op; }
            __syncthreads();
            for (int e = tid; e < 1024; e += 512) { const int t4 = e >> 8, d = e & 255; const int r = gla_row(b, dir, s4 * 4 + t4); O[(size_t)r * 1024 + h * 256 + d] = f2bf(sO[(t4 * 2) * 256 + d] + sO[(t4 * 2 + 1) * 256 + d]); }
        }
        __syncthreads();
    }
}
typedef short s16x4 __attribute__((ext_vector_type(4)));
__device__ __forceinline__ bf16x8_t bits8(u32x4 v) { return __builtin_bit_cast(bf16x8_t, v); }
__device__ __forceinline__ bf16x8_t tr8(const LAS unsigned char* p0, const LAS unsigned char* p1) {
    const s16x4 a = __builtin_amdgcn_ds_read_tr16_b64_v4i16((LAS s16x4*)p0), b = __builtin_amdgcn_ds_read_tr16_b64_v4i16((LAS s16x4*)p1);
    return __builtin_shufflevector(a, b, 0, 1, 2, 3, 4, 5, 6, 7);
}
template <int CTRL> __device__ __forceinline__ float dppz(float v) { return __int_as_float(__builtin_amdgcn_update_dpp(0, __float_as_int(v), CTRL, 0xf, 0xf, true)); }
__device__ __forceinline__ float wave_incl_scan(float v) {
    v += dppz<0x111>(v); v += dppz<0x112>(v); v += dppz<0x114>(v); v += dppz<0x118>(v);
    v += __int_as_float(__builtin_amdgcn_update_dpp(0, __float_as_int(v), 0x142, 0xa, 0xf, false));
    v += __int_as_float(__builtin_amdgcn_update_dpp(0, __float_as_int(v), 0x143, 0xc, 0xf, false));
    return v;
}
__device__ __forceinline__ void gla_phase(CPP p, int layer, LAS unsigned char* lds, int tid, int lane, int wave, int mode = 0) {
    const bf16_t* Q = (const bf16_t*)(p->ws + 3 * SLOT); const bf16_t* K = Q + (size_t)NT * 512; const bf16_t* V = (const bf16_t*)(p->ws + 2 * SLOT); const bf16_t* F = (const bf16_t*)(p->ws + OFF_F);
    LAS unsigned char* ATT = lds + 108544;
    LAS unsigned char* OST = lds + 117760;
    LAS float* GL = (LAS float*)(lds + 135168);
    LAS float* WFL = (LAS float*)(lds + 136192);
    LAS float* BFL = (LAS float*)(lds + 144384);
    const int l15 = lane & 15, g4 = lane >> 4;
    for (int item = blockIdx.x; item < 256; item += gridDim.x) {
        const int b = (item & 63) >> 2, h = item & 3, dir = item >> 7, dvh = (item >> 6) & 1;
        bf16_t* O = (bf16_t*)(p->ws + (size_t)(4 + dir) * SLOT);
        bf16x8_t afr; f32x4 bias4;
        { u32x4 t4 = (u32x4){0u, 0u, 0u, 0u};
          if (g4 < 2) { const float* wp = p->in[16] + ((size_t)(layer * 2 + dir) * 16 + 8 * g4) * 512 + h * 128 + 16 * wave + l15;
              t4.x = pk2(wp[0], wp[512]); t4.y = pk2(wp[1024], wp[1536]); t4.z = pk2(wp[2048], wp[2560]); t4.w = pk2(wp[3072], wp[3584]); }
          afr = bits8(t4); bias4 = *(const f32x4*)(p->in[17] + (layer * 2 + dir) * 512 + h * 128 + 16 * wave + 4 * g4); }
        f32x4 Sacc[8];
#pragma unroll
        for (int i = 0; i < 8; ++i) Sacc[i] = (f32x4){0.f, 0.f, 0.f, 0.f};
        u32x4 pq[2], pk[2], pv[2], pf;
        const int sgn = dir ? -1 : 1; int rC[2], rL[2], chq = tid & 15; int rCf, rLf;
#pragma unroll
        for (int k = 0; k < 2; ++k) { const int j_ = (tid >> 4) + 32 * k; rC[k] = NL + b * 256 + (dir ? 255 - j_ : j_); rL[k] = b * 2048 + (dir ? (31 - (j_ & 31)) * 64 + 63 - (j_ >> 5) : (j_ & 31) * 64 + (j_ >> 5)); }
        { const int j_ = (tid >> 1) & 63; rCf = NL + b * 256 + (dir ? 255 - j_ : j_); rLf = b * 2048 + (dir ? (31 - (j_ & 31)) * 64 + 63 - (j_ >> 5) : (j_ & 31) * 64 + (j_ >> 5)); }
        const unsigned char* wsb = p->ws;
        const unsigned cQ = (unsigned)(3 * SLOT) + h * 256 + chq * 16, cK = cQ + (unsigned)NT * 1024u, cV = (unsigned)(2 * SLOT) + h * 512 + dvh * 256 + chq * 16, cO = (unsigned)((4 + dir) * SLOT) + h * 512 + dvh * 256 + chq * 16, cF = (unsigned)OFF_F + dir * 32 + (tid & 1) * 16;
#define GLA_ROW(c_, rc_, rl_) ((c_) < 4 ? (rc_) + sgn * 64 * (c_) : (rl_) + sgn * 2 * ((c_) - 4))
#define GLA_PREFETCH(c_) do { _Pragma("unroll") for (int k = 0; k < 2; ++k) { const unsigned r_ = (unsigned)GLA_ROW(c_, rC[k], rL[k]); \
            pq[k] = *(const u32x4*)(wsb + (size_t)(cQ + r_ * 1024u)); pk[k] = *(const u32x4*)(wsb + (size_t)(cK + r_ * 1024u)); pv[k] = *(const u32x4*)(wsb + (size_t)(cV + r_ * 2048u)); } \
        if (tid < 128) { const unsigned r_ = (unsigned)GLA_ROW(c_, rCf, rLf); pf = *(const u32x4*)(wsb + (size_t)(cF + r_ * 64u)); } } while (0)
#define GLA_STAGE(bufp) do { _Pragma("unroll") for (int k = 0; k < 2; ++k) { const int id_ = tid + 512 * k, j_ = id_ >> 4, ch_ = id_ & 15; *(LAS u32x4*)((bufp) + j_ * 272 + ch_ * 16) = pq[k]; *(LAS u32x4*)((bufp) + 17408 + j_ * 272 + ch_ * 16) = pk[k]; *(LAS u32x4*)((bufp) + 34816 + j_ * 272 + ch_ * 16) = pv[k]; } \
        if (tid < 128) *(LAS u32x4*)((bufp) + 52224 + tid * 16) = pf; } while (0)
#define GLA_GATES(bufp, glp) do { f32x4 zt_[4]; \
        _Pragma("unroll") for (int nt = 0; nt < 4; ++nt) { const bf16x8_t fb_ = *(const LAS bf16x8_t*)((bufp) + 52224 + (16 * nt + l15) * 32 + 16 * (g4 & 1)); zt_[nt] = __builtin_amdgcn_mfma_f32_16x16x32_bf16(afr, fb_, bias4, 0, 0, 0); } \
        float off_[4] = {0.f, 0.f, 0.f, 0.f}; float e_[4][4]; \
        _Pragma("unroll") for (int nt = 0; nt < 4; ++nt) { _Pragma("unroll") for (int r = 0; r < 4; ++r) { const float z_ = zt_[nt][r]; float lg_ = (fminf(z_, 0.f) * 1.4426950409f - __builtin_amdgcn_logf(1.f + __builtin_amdgcn_exp2f(fabsf(z_) * -1.4426950409f))) * 0.0625f;     \
                lg_ += dppz<0x111>(lg_); lg_ += dppz<0x112>(lg_); lg_ += dppz<0x114>(lg_); lg_ += dppz<0x118>(lg_); lg_ += off_[r]; \
                if (nt < 3) off_[r] = __int_as_float(__builtin_amdgcn_ds_bpermute((lane | 15) << 2, __float_as_int(lg_))); \
                e_[nt][r] = __builtin_amdgcn_exp2f(lg_); } } \
        if (l15 == 15) *(LAS f32x4*)((glp) + 16 * wave + 4 * g4) = (f32x4){e_[3][0], e_[3][1], e_[3][2], e_[3][3]}; \
        _Pragma("unroll") for (int nt = 0; nt < 4; ++nt) { LAS u32x2* qp_ = (LAS u32x2*)((bufp) + (16 * nt + l15) * 272 + (16 * wave + 4 * g4) * 2); LAS u32x2* kp_ = (LAS u32x2*)((bufp) + 17408 + (16 * nt + l15) * 272 + (16 * wave + 4 * g4) * 2); \
            const u32x2 qv_ = *qp_, kv_ = *kp_; u32x2 qo_, ko_; \
            qo_.x = pk2(bf_lo(qv_.x) * e_[nt][0], bf_hi(qv_.x) * e_[nt][1]); qo_.y = pk2(bf_lo(qv_.y) * e_[nt][2], bf_hi(qv_.y) * e_[nt][3]); \
            ko_.x = pk2(bf_lo(kv_.x) * __builtin_amdgcn_rcpf(e_[nt][0]), bf_hi(kv_.x) * __builtin_amdgcn_rcpf(e_[nt][1])); ko_.y = pk2(bf_lo(kv_.y) * __builtin_amdgcn_rcpf(e_[nt][2]), bf_hi(kv_.y) * __builtin_amdgcn_rcpf(e_[nt][3])); \
            *qp_ = qo_; *kp_ = ko_; } } while (0)
#define GLA_ATT(bufp) do { const int mt_ = wave >> 1; \
        _Pragma("unroll") for (int n2 = 0; n2 < 2; ++n2) { const int nt_ = 2 * (wave & 1) + n2; f32x4 a4_ = (f32x4){0.f, 0.f, 0.f, 0.f}; \
            if (nt_ <= mt_) { _Pragma("unroll") for (int ks = 0; ks < 4; ++ks) { const bf16x8_t a_ = *(const LAS bf16x8_t*)((bufp) + (16 * mt_ + l15) * 272 + ks * 64 + g4 * 16), bb_ = *(const LAS bf16x8_t*)((bufp) + 17408 + (16 * nt_ + l15) * 272 + ks * 64 + g4 * 16); \
                    a4_ = __builtin_amdgcn_mfma_f32_16x16x32_bf16(a_, bb_, a4_, 0, 0, 0); } } \
            _Pragma("unroll") for (int r = 0; r < 4; ++r) { const int t_ = 16 * mt_ + 4 * g4 + r, sx_ = 16 * nt_ + l15; *(LAS bf16_t*)(ATT + t_ * 144 + sx_ * 2) = f2bf(t_ >= sx_ ? a4_[r] : 0.f); } } } while (0)
        GLA_PREFETCH(0);
        __syncthreads();
        GLA_STAGE(lds);
        GLA_PREFETCH(1);
        __syncthreads();
        GLA_GATES(lds, GL);
        __syncthreads();
        GLA_ATT(lds);
        GLA_STAGE(lds + 54272);
        GLA_PREFETCH(2);
        __syncthreads();
        for (int c = 0; c < 36; ++c) {
            if (mode) { LAS unsigned char* cb2 = lds + (c & 1) * 54272; __syncthreads(); if (c + 2 < 36) GLA_STAGE(cb2); if (c + 3 < 36) GLA_PREFETCH(c + 3); __syncthreads(); continue; }
            LAS unsigned char* cb = lds + (c & 1) * 54272; LAS unsigned char* nb = lds + ((c + 1) & 1) * 54272;
            const LAS float* glc = GL + (c & 1) * 128;
            f32x4 oacc[4];
#pragma unroll
            for (int m = 0; m < 4; ++m) oacc[m] = (f32x4){0.f, 0.f, 0.f, 0.f};
#pragma unroll
            for (int ks = 0; ks < 4; ++ks) { u32x4 sb; sb.x = pk2(Sacc[2 * ks][0], Sacc[2 * ks][1]); sb.y = pk2(Sacc[2 * ks][2], Sacc[2 * ks][3]); sb.z = pk2(Sacc[2 * ks + 1][0], Sacc[2 * ks + 1][1]); sb.w = pk2(Sacc[2 * ks + 1][2], Sacc[2 * ks + 1][3]);
                const bf16x8_t bS = bits8(sb);
#pragma unroll
                for (int m = 0; m < 4; ++m) { const LAS unsigned char* ap = cb + (16 * m + l15) * 272 + (32 * ks + 4 * g4) * 2; const u32x2 lo = *(const LAS u32x2*)ap, hi = *(const LAS u32x2*)(ap + 32);
                    oacc[m] = __builtin_amdgcn_mfma_f32_16x16x32_bf16(bits8((u32x4){lo.x, lo.y, hi.x, hi.y}), bS, oacc[m], 0, 0, 0); } }
            if (c + 1 < 36) GLA_GATES(nb, GL + ((c + 1) & 1) * 128);
            bf16x8_t bV[2];
            { const int q_ = l15 >> 2, p_ = l15 & 3;
#pragma unroll
              for (int ks = 0; ks < 2; ++ks) { const LAS unsigned char* vp = cb + 34816 + (32 * ks + 8 * g4 + q_) * 272 + (16 * wave + 4 * p_) * 2; bV[ks] = tr8(vp, vp + 4 * 272); } }
#pragma unroll
            for (int ks = 0; ks < 2; ++ks)
#pragma unroll
                for (int m = 0; m < 4; ++m) if (2 * ks <= m) { const bf16x8_t a = *(const LAS bf16x8_t*)(ATT + (16 * m + l15) * 144 + ks * 64 + g4 * 16); oacc[m] = __builtin_amdgcn_mfma_f32_16x16x32_bf16(a, bV[ks], oacc[m], 0, 0, 0); }
#pragma unroll
            for (int m = 0; m < 4; ++m)
#pragma unroll
                for (int r = 0; r < 4; ++r) *(LAS bf16_t*)(OST + (16 * m + 4 * g4 + r) * 272 + (16 * wave + l15) * 2) = f2bf(oacc[m][r]);
            { const int q_ = l15 >> 2, p_ = l15 & 3;
#pragma unroll
              for (int ks = 0; ks < 2; ++ks)
#pragma unroll
                  for (int i = 0; i < 8; ++i) { const LAS unsigned char* kp = cb + 17408 + (32 * ks + 8 * g4 + q_) * 272 + (16 * i + 4 * p_) * 2; Sacc[i] = __builtin_amdgcn_mfma_f32_16x16x32_bf16(tr8(kp, kp + 4 * 272), bV[ks], Sacc[i], 0, 0, 0); } }
#pragma unroll
            for (int i = 0; i < 8; ++i) { const f32x4 gl = *(const LAS f32x4*)(glc + 16 * i + 4 * g4); Sacc[i] = Sacc[i] * gl; }
            __syncthreads();
#pragma unroll
            for (int k = 0; k < 2; ++k) { const unsigned r_ = (unsigned)GLA_ROW(c, rC[k], rL[k]); *(u32x4*)(p->ws + (size_t)(cO + r_ * 2048u)) = *(const LAS u32x4*)(OST + ((tid >> 4) + 32 * k) * 272 + chq * 16); }
            if (c + 1 < 36) GLA_ATT(nb);
            if (c + 2 < 36) GLA_STAGE(cb);
            if (c + 3 < 36) GLA_PREFETCH(c + 3);
            __syncthreads();
        }
#undef GLA_PREFETCH
#undef GLA_ROW
#undef GLA_STAGE
#undef GLA_GATES
#undef GLA_ATT
    }
}
template <int DIR> __device__ __forceinline__ void lru_naive_item(CPP p, int layer, int b, int hb, int lane) {
    const int c = hb * 64 + lane;
    const bf16_t* X = (const bf16_t*)(p->ws + 1 * SLOT); bf16_t* Hd = (bf16_t*)(p->ws + (size_t)(DIR ? 2 : 3) * SLOT);
    const float* wa = p->in[11] + ((size_t)((layer * 2 + DIR) * 16 + hb) * 64) * 64 + lane; const float* wx = p->in[13] + ((size_t)((layer * 2 + DIR) * 16 + hb) * 64) * 64 + lane;
    float war[64], wxr[64];
#pragma unroll
    for (int i = 0; i < 64; ++i) { war[i] = wa[i * 64]; wxr[i] = wx[i * 64]; }
    const float ba = p->in[12][(layer * 2 + DIR) * 1024 + c], bx = p->in[14][(layer * 2 + DIR) * 1024 + c], lam = p->in[15][(layer * 2 + DIR) * 1024 + c];
    const float cl = -8.f * (fmaxf(-lam, 0.f) + log1pf(__expf(-fabsf(lam))));
    const float cw0 = p->in[9][(layer * 4 + 0) * 1024 + c], cw1 = p->in[9][(layer * 4 + 1) * 1024 + c], cw2 = p->in[9][(layer * 4 + 2) * 1024 + c], cw3 = p->in[9][(layer * 4 + 3) * 1024 + c], cb = p->in[10][layer * 1024 + c];
    float h = 0.f;
    for (int seg = 0; seg < 2; ++seg) {
        const int L = seg ? 2048 : 256; const size_t base = seg ? (size_t)b * 2048 : (size_t)NL + (size_t)b * 256;
        for (int ch = 0; ch < L / 16; ++ch) {
            const int tb = DIR ? L - 16 - ch * 16 : ch * 16;
            float xv[19];
#pragma unroll
            for (int j = 0; j < 19; ++j) { const int t = tb - 2 + j; xv[j] = (t >= 0 && t < L) ? bf2f(X[(base + t) * 1024 + c]) : 0.f; }
#pragma unroll
            for (int i = 0; i < 16; ++i) { const int q = DIR ? 15 - i : i;
                const float xr = cb + cw0 * xv[q] + cw1 * xv[q + 1] + cw2 * xv[q + 2] + cw3 * xv[q + 3];
                float ra = ba, ri = bx;
#pragma unroll
                for (int k = 0; k < 64; ++k) { const float xk = __int_as_float(__builtin_amdgcn_readlane(__float_as_int(xr), k)); ra += xk * war[k]; ri += xk * wxr[k]; }
                const float rg = sigmoidf_(ra), ig = sigmoidf_(ri), la = cl * rg, a = __expf(la), uu = sqrtf(fmaxf(-expm1f(2.f * la), 0.f)) * ig * xr;
                h = a * h + uu;
                Hd[(base + tb + q) * 1024 + c] = f2bf(h); }
        }
    }
}
__device__ __forceinline__ void lru_naive_phase(CPP p, int layer, int lane, int wave) {
    const int gw = wave * gridDim.x + blockIdx.x, NGW = gridDim.x * 8;
    for (int item = gw; item < 512; item += NGW) { const int b = item >> 5, hb = (item >> 1) & 15;
        if (item & 1) lru_naive_item<1>(p, layer, b, hb, lane); else lru_naive_item<0>(p, layer, b, hb, lane); }
}
__device__ __forceinline__ void lru_tile_geom(int s, int dirb, int b, int& t0, int& L, size_t& gb) {
    if (s < 4) { t0 = 64 * (dirb ? 3 - s : s); L = 256; gb = (size_t)NL + (size_t)b * 256; }
    else { t0 = 64 * (dirb ? 35 - s : s - 4); L = 2048; gb = (size_t)b * 2048; }
}
__device__ __forceinline__ void lru_phase(CPP p, int layer, LAS unsigned char* lds, int tid, int lane, int wave) {
    const bf16_t* X = (const bf16_t*)(p->ws + 1 * SLOT); const bf16_t* WG = (const bf16_t*)(p->ws + OFF_WG);
    LAS unsigned char* RAW = lds;
    LAS unsigned char* XRB = lds + 17152;
    LAS float* XRF = (LAS float*)(lds + 35584);
    LAS float* AA = (LAS float*)(lds + 68352);
    LAS float* UU = (LAS float*)(lds + 103168);
    const int td = wave >> 2, idx = tid & 255;
    const int dirw = wave >> 2, mt = (wave >> 1) & 1, nh = wave & 1, l31 = lane & 31, l5 = lane >> 5;
    for (int item = blockIdx.x; item < 256; item += gridDim.x) {
        const int b = item >> 4, hb = item & 15;
        bf16x8_t bfr[2][4];
#pragma unroll
        for (int g = 0; g < 2; ++g)
#pragma unroll
            for (int ks = 0; ks < 4; ++ks) bfr[g][ks] = *(const bf16x8_t*)(WG + ((size_t)(((dirw * 2 + g) * 16 + hb) * 64 + nh * 32 + l31)) * 64 + ks * 16 + 8 * l5);
        const int ce = hb * 64 + nh * 32 + l31;
        const float e_ba = p->in[12][(layer * 2 + dirw) * 1024 + ce], e_bx = p->in[14][(layer * 2 + dirw) * 1024 + ce]; const float lam = p->in[15][(layer * 2 + dirw) * 1024 + ce];
        const float e_cl = -8.f * (fmaxf(-lam, 0.f) + log1pf(__expf(-fabsf(lam))));
        const float k_ba = -1.4426950409f * e_ba, k_bx = -1.4426950409f * e_bx, k_cl = 1.4426950409f * e_cl;
        const int chp = idx & 31, tg = idx >> 5, cc = hb * 64 + 2 * chp;
        float cw[4][2], cbv[2];
#pragma unroll
        for (int k = 0; k < 4; ++k) { cw[k][0] = p->in[9][(layer * 4 + k) * 1024 + cc]; cw[k][1] = p->in[9][(layer * 4 + k) * 1024 + cc + 1]; }
        cbv[0] = p->in[10][layer * 1024 + cc]; cbv[1] = p->in[10][layer * 1024 + cc + 1];
        float hstate = 0.f;
        u32x4 pre[3]; int poff[3]; bool pok[3], pfirst[3], plast[3];
#pragma unroll
        for (int k = 0; k < 3; ++k) { const int id_ = idx + 256 * k, rr_ = id_ >> 3; pok[k] = id_ < 536; pfirst[k] = rr_ < 2; plast[k] = rr_ == 66; poff[k] = ((rr_ - 2) * 1024 + hb * 64 + (id_ & 7) * 8) * 2; }
#define LRU_PREFETCH(s_) do { int t0_, L_; size_t gb_; lru_tile_geom((s_), td, b, t0_, L_, gb_); const char* base_ = (const char*)X + (gb_ + t0_) * 2048; const bool fst_ = t0_ == 0, lst_ = t0_ == L_ - 64; \
        _Pragma("unroll") for (int k = 0; k < 3; ++k) { pre[k] = (u32x4){0u, 0u, 0u, 0u}; if (pok[k] && !(fst_ && pfirst[k]) && !(lst_ && plast[k])) pre[k] = *(const u32x4*)(base_ + poff[k]); } } while (0)
        LRU_PREFETCH(0);
        for (int s = 0; s < 36; ++s) {
#pragma unroll
            for (int k = 0; k < 3; ++k) { const int id_ = idx + 256 * k; if (id_ < 536) *(LAS u32x4*)(RAW + td * 8576 + id_ * 16) = pre[k]; }
            __syncthreads();
            if (s + 1 < 36) LRU_PREFETCH(s + 1);
            { float r0[11], r1[11];
#pragma unroll
              for (int j = 0; j < 11; ++j) { const unsigned w = *(const LAS unsigned*)(RAW + td * 8576 + (8 * tg + j) * 128 + chp * 4); r0[j] = bf_lo(w); r1[j] = bf_hi(w); }
#pragma unroll
              for (int t = 0; t < 8; ++t) { const float y0 = cbv[0] + cw[0][0] * r0[t] + cw[1][0] * r0[t + 1] + cw[2][0] * r0[t + 2] + cw[3][0] * r0[t + 3];
                  const float y1 = cbv[1] + cw[0][1] * r1[t] + cw[1][1] * r1[t + 1] + cw[2][1] * r1[t + 2] + cw[3][1] * r1[t + 3];
                  *(LAS f32x2*)(XRF + td * 4096 + (8 * tg + t) * 64 + 2 * chp) = (f32x2){y0, y1};
                  *(LAS unsigned*)(XRB + td * 9216 + (8 * tg + t) * 144 + chp * 4) = pk2(y0, y1); } }
            __syncthreads();
            { f32x16 ca, cx;
#pragma unroll
              for (int i = 0; i < 16; ++i) { ca[i] = 0.f; cx[i] = 0.f; }
#pragma unroll
              for (int ks = 0; ks < 4; ++ks) { const bf16x8_t a = *(const LAS bf16x8_t*)(XRB + dirw * 9216 + (mt * 32 + l31) * 144 + ks * 32 + 16 * l5);
                  ca = __builtin_amdgcn_mfma_f32_32x32x16_bf16(a, bfr[0][ks], ca, 0, 0, 0); cx = __builtin_amdgcn_mfma_f32_32x32x16_bf16(a, bfr[1][ks], cx, 0, 0, 0); }
#pragma unroll
              for (int rq = 0; rq < 4; ++rq) { const int tok0 = mt * 32 + 8 * rq + 4 * l5; f32x4 a4, u4;
#pragma unroll
                  for (int r4 = 0; r4 < 4; ++r4) { const int rg = 4 * rq + r4; const float xr = XRF[dirw * 4096 + (tok0 + r4) * 64 + nh * 32 + l31];
                      const float rgt = __builtin_amdgcn_rcpf(1.f + __builtin_amdgcn_exp2f(ca[rg] * -1.4426950409f + k_ba)), igt = __builtin_amdgcn_rcpf(1.f + __builtin_amdgcn_exp2f(cx[rg] * -1.4426950409f + k_bx));
                      const float a = __builtin_amdgcn_exp2f(k_cl * rgt); a4[r4] = a; u4[r4] = __builtin_amdgcn_sqrtf(fmaxf(__builtin_fmaf(-a, a, 1.f), 0.f)) * (igt * xr); }
                  const int o_ = (dirw * 64 + nh * 32 + l31) * 68 + tok0; *(LAS f32x4*)(AA + o_) = a4; *(LAS f32x4*)(UU + o_) = u4; } }
            __syncthreads();
            if (tid < 128) { LAS f32x4* ap = (LAS f32x4*)(AA + tid * 68); LAS f32x4* up = (LAS f32x4*)(UU + tid * 68);
                if (tid < 64) {
#pragma unroll
                    for (int hf = 0; hf < 2; ++hf) { f32x4 a[8], u[8];
#pragma unroll
                        for (int k = 0; k < 8; ++k) { a[k] = ap[8 * hf + k]; u[k] = up[8 * hf + k]; }
#pragma unroll
                        for (int k = 0; k < 8; ++k) {
#pragma unroll
                            for (int j = 0; j < 4; ++j) { hstate = a[k][j] * hstate + u[k][j]; u[k][j] = hstate; } }
#pragma unroll
                        for (int k = 0; k < 8; ++k) up[8 * hf + k] = u[k]; } }
                else {
#pragma unroll
                    for (int hf = 1; hf >= 0; --hf) { f32x4 a[8], u[8];
#pragma unroll
                        for (int k = 0; k < 8; ++k) { a[k] = ap[8 * hf + k]; u[k] = up[8 * hf + k]; }
#pragma unroll
                        for (int k = 7; k >= 0; --k) {
#pragma unroll
                            for (int j = 3; j >= 0; --j) { hstate = a[k][j] * hstate + u[k][j]; u[k][j] = hstate; } }
#pragma unroll
                        for (int k = 0; k < 8; ++k) up[8 * hf + k] = u[k]; } } }
            __syncthreads();
#pragma unroll
            for (int k = 0; k < 2; ++k) { const int tok = tid & 63, cp = wave; int t0, L; size_t gb; lru_tile_geom(s, k, b, t0, L, gb); char* Hd = (char*)(p->ws + (size_t)(k ? 2 : 3) * SLOT) + (gb + t0) * 2048;
                const LAS float* src = UU + (k * 64 + 8 * cp) * 68 + tok; u32x4 w; w.x = pk2(src[0], src[68]); w.y = pk2(src[136], src[204]); w.z = pk2(src[272], src[340]); w.w = pk2(src[408], src[476]);
                *(u32x4*)(Hd + (tok * 1024 + hb * 64 + 8 * cp) * 2) = w; }
        }
        __syncthreads();
#undef LRU_PREFETCH
    }
}
__device__ __forceinline__ void onorm_phase(CPP p, int layer, int tid, int lane, int wave) {
    const int gw = blockIdx.x * 8 + wave, NGW = gridDim.x * 8;
    bf16_t* OF = (bf16_t*)(p->ws + 4 * SLOT); const bf16_t* OB = (const bf16_t*)(p->ws + 5 * SLOT); const float* ng = p->in[18] + layer * 1024 + 16 * lane;
    const int nrows = layer == 1 ? NL : NT;
    for (int r = gw; r < nrows; r += NGW) {
        const u32x4* a = (const u32x4*)(OF + (size_t)r * 1024 + 16 * lane); const u32x4* bq = (const u32x4*)(OB + (size_t)r * 1024 + 16 * lane);
        const u32x4 a0 = a[0], a1 = a[1], b0 = bq[0], b1 = bq[1]; const unsigned aw[8] = {a0.x, a0.y, a0.z, a0.w, a1.x, a1.y, a1.z, a1.w}, bw[8] = {b0.x, b0.y, b0.z, b0.w, b1.x, b1.y, b1.z, b1.w};
        float o[16], ss = 0.f;
#pragma unroll
        for (int j = 0; j < 8; ++j) { o[2 * j] = bf_lo(aw[j]) + bf_lo(bw[j]); o[2 * j + 1] = bf_hi(aw[j]) + bf_hi(bw[j]); ss += o[2 * j] * o[2 * j] + o[2 * j + 1] * o[2 * j + 1]; }
#pragma unroll
        for (int of = 1; of < 16; of <<= 1) ss += __shfl_xor(ss, of);
        const float rs = rsqrtf(ss * (1.f / 256.f) + 1e-6f);
        u32x4 w0, w1; const f32x4 g0 = ((const f32x4*)ng)[0], g1 = ((const f32x4*)ng)[1], g2 = ((const f32x4*)ng)[2], g3 = ((const f32x4*)ng)[3];
        w0.x = pk2(o[0] * rs * g0[0], o[1] * rs * g0[1]); w0.y = pk2(o[2] * rs * g0[2], o[3] * rs * g0[3]); w0.z = pk2(o[4] * rs * g1[0], o[5] * rs * g1[1]); w0.w = pk2(o[6] * rs * g1[2], o[7] * rs * g1[3]);
        w1.x = pk2(o[8] * rs * g2[0], o[9] * rs * g2[1]); w1.y = pk2(o[10] * rs * g2[2], o[11] * rs * g2[3]); w1.z = pk2(o[12] * rs * g3[0], o[13] * rs * g3[1]); w1.w = pk2(o[14] * rs * g3[2], o[15] * rs * g3[3]);
        u32x4* d = (u32x4*)(OF + (size_t)r * 1024 + 16 * lane); d[0] = w0; d[1] = w1;
    }
    const f32x4* eu = (const f32x4*)(p->in[24] + (size_t)layer * 16384 * 1024); const f32x4* ev = (const f32x4*)(p->in[25] + (size_t)layer * 16384 * 1024);
    for (int i = blockIdx.x * 512 + tid; i < 2 * 16384 * 32; i += gridDim.x * 512) {
        const int tab = i >> 19, it = i & 524287; const f32x4* src = (tab ? ev : eu) + (size_t)it * 8;
        const f32x4* srcp = src;
        if (tab) {
            unsigned o[4];
#pragma unroll
            for (int n = 0; n < 4; ++n) { const f32x4 a = srcp[2 * n] * EV_S, b = srcp[2 * n + 1] * EV_S; unsigned w = 0u;
                w = __builtin_amdgcn_cvt_scalef32_pk_fp4_f32(w, __builtin_amdgcn_fmed3f(a[0], -6.f, 6.f), __builtin_amdgcn_fmed3f(a[1], -6.f, 6.f), 1.0f, 0);
                w = __builtin_amdgcn_cvt_scalef32_pk_fp4_f32(w, __builtin_amdgcn_fmed3f(a[2], -6.f, 6.f), __builtin_amdgcn_fmed3f(a[3], -6.f, 6.f), 1.0f, 1);
                w = __builtin_amdgcn_cvt_scalef32_pk_fp4_f32(w, __builtin_amdgcn_fmed3f(b[0], -6.f, 6.f), __builtin_amdgcn_fmed3f(b[1], -6.f, 6.f), 1.0f, 2);
                w = __builtin_amdgcn_cvt_scalef32_pk_fp4_f32(w, __builtin_amdgcn_fmed3f(b[2], -6.f, 6.f), __builtin_amdgcn_fmed3f(b[3], -6.f, 6.f), 1.0f, 3); o[n] = w; }
            *(u32x4*)(p->ws + OFF_EV + (size_t)(it >> 5) * 512 + (it & 1) * 256 + ((it & 31) >> 1) * 16) = (u32x4){o[0], o[1], o[2], o[3]};
        } else {
            unsigned o[4];
#pragma unroll
            for (int n = 0; n < 4; ++n) { const f32x4 a = srcp[2 * n] * EU_S, b = srcp[2 * n + 1] * EU_S; unsigned w = 0u;
#pragma unroll
                for (int k = 0; k < 4; ++k) { const int qa = (int)__builtin_rintf(__builtin_amdgcn_fmed3f(a[k], -8.f, 7.f)), qb = (int)__builtin_rintf(__builtin_amdgcn_fmed3f(b[k], -8.f, 7.f));
                    w |= ((unsigned)qa & 15u) << (8 * k); w |= ((unsigned)qb & 15u) << (8 * k + 4); }
                o[n] = w; }
            *(u32x4*)(p->ws + OFF_EU + (size_t)(it >> 5) * 512 + (it & 1) * 256 + ((it & 31) >> 1) * 16) = (u32x4){o[0], o[1], o[2], o[3]};
        }
    }
}
template <int CTRL> __device__ __forceinline__ float dppf(float v) { return __int_as_float(__builtin_amdgcn_update_dpp(0, __float_as_int(v), CTRL, 0xf, 0xf, true)); }
__device__ __forceinline__ float row_max16(float v) { v = fmaxf(v, dppf<0xB1>(v)); v = fmaxf(v, dppf<0x4E>(v)); v = fmaxf(v, dppf<0x141>(v)); v = fmaxf(v, dppf<0x140>(v)); return v; }
template <int CTRL> __device__ __forceinline__ int dppi(int v) { return __builtin_amdgcn_update_dpp(0, v, CTRL, 0xf, 0xf, true); }
__device__ __forceinline__ int row_max16i(int v) { v = max(v, dppi<0xB1>(v)); v = max(v, dppi<0x4E>(v)); v = max(v, dppi<0x141>(v)); v = max(v, dppi<0x140>(v)); return v; }
__device__ __forceinline__ float row_sum16(float v) { v += dppf<0xB1>(v); v += dppf<0x4E>(v); v += dppf<0x141>(v); v += dppf<0x140>(v); return v; }
__device__ __forceinline__ float xrow_sum(float t) {
    auto r = __builtin_amdgcn_permlane32_swap(__float_as_uint(t), __float_as_uint(t), false, false); t = __uint_as_float(r[0]) + __uint_as_float(r[1]);
    auto q = __builtin_amdgcn_permlane16_swap(__float_as_uint(t), __float_as_uint(t), false, false); return __uint_as_float(q[0]) + __uint_as_float(q[1]);
}
__device__ __forceinline__ float wave_sum_d(float v) { return xrow_sum(row_sum16(v)); }
__device__ __forceinline__ void peer_phase(CPP p, int layer, LAS unsigned char* lds, int lane, int wave) {
    const int gw = blockIdx.x * 8 + wave, NGW = gridDim.x * 8;
    const int nrows = layer == 1 ? NL : NT;
    const bf16_t* SC = (const bf16_t*)(p->ws + 1 * SLOT); const bf16_t* HN = (const bf16_t*)(p->ws + OFF_HN2); u8_t* HN8 = p->ws + OFF_HN8;
    const unsigned char* EU = p->ws + OFF_EU; const unsigned char* EV = p->ws + OFF_EV;
    const float* MODL = (const float*)(p->ws + OFF_MOD) + (size_t)layer * 17 * 6144;
    LAS int* topv = (LAS int*)(lds + wave * 4096);
    LAS float* selw = (LAS float*)(topv + 256);
    LAS int* sele = (LAS int*)(selw + 128);
    LAS float* sels = (LAS float*)(sele + 128);
    LAS int* se2 = (LAS int*)(sels + 128); LAS float* sw2 = (LAS float*)(se2 + 128);
    const int IMIN = (int)0x80000000;
    LAS unsigned char* ptab = (LAS unsigned char*)(sw2 + 128);
    int pi4[4], pj4[4];
#pragma unroll
    for (int m = 0; m < 4; ++m) { const int slot = (lane & 15) + 16 * m; int base = 0; bool found = false; pi4[m] = 0; pj4[m] = 0;
        for (int i = 0; i < 16; ++i) { const int cnt = 16 / (i + 1); if (!found && slot < base + cnt) { pi4[m] = i; pj4[m] = slot - base; found = true; } base += cnt; } }
    const int R = lane >> 4, c16 = lane & 15, half = lane >> 5, l31 = lane & 31;
    if (R == 0) {
#pragma unroll
        for (int m = 0; m < 4; ++m) ptab[c16 + 16 * m] = (unsigned char)((pi4[m] << 4) | pj4[m]);
    }
    LDS_FENCE();
    u32x4 scn[4];
#pragma unroll
    for (int B = 0; B < 4; ++B) scn[B] = *(const u32x4*)(SC + (size_t)(gw < nrows ? gw : 0) * 2048 + (4 * B + R) * 128 + 8 * c16);
    asm volatile("" :: "v"(scn[0]), "v"(scn[1]), "v"(scn[2]), "v"(scn[3]));
    for (int r = gw; r < nrows; r += NGW) {
        u32x4 hraw[8];
        { const u32x4* hp = (const u32x4*)(HN + (size_t)r * 1024 + 64 * c16);
#pragma unroll
          for (int q8 = 0; q8 < 8; ++q8) hraw[q8] = hp[q8]; }
        int hqh[8], hql[8]; float tscale; h2_t acch[32];
#if defined(PROBE_PEER)
        for (int rep = 0; rep < PROBE_PEER; ++rep) {
#endif
#if defined(PROBE_PK)
        const unsigned long long pk0 = __builtin_amdgcn_s_memrealtime();
#endif
#define PEER_KEY(b) ((b) ^ (((b) >> 31) & 0x7fffffff))
#pragma unroll
        for (int B = 0; B < 4; ++B) {
            const int g = 4 * B + R; int v[8];
            { const u32x4 w = scn[B]; const unsigned ww[4] = {w.x, w.y, w.z, w.w};
#pragma unroll
              for (int i = 0; i < 4; ++i) { const int k = 8 * c16 + 2 * i; const int b0 = (int)((ww[i] << 16) | (unsigned)k), b1 = (int)((ww[i] & 0xffff0000u) | (unsigned)(k + 1)); v[2 * i] = PEER_KEY(b0); v[2 * i + 1] = PEER_KEY(b1); } }
#define PEER_CE(x, y) do { const int hi_ = max(v[x], v[y]), lo_ = min(v[x], v[y]); v[x] = hi_; v[y] = lo_; } while (0)
            PEER_CE(0, 1); PEER_CE(2, 3); PEER_CE(4, 5); PEER_CE(6, 7); PEER_CE(0, 2); PEER_CE(1, 3); PEER_CE(4, 6); PEER_CE(5, 7); PEER_CE(1, 2); PEER_CE(5, 6);
            PEER_CE(0, 4); PEER_CE(1, 5); PEER_CE(2, 6); PEER_CE(3, 7); PEER_CE(2, 4); PEER_CE(3, 5); PEER_CE(1, 2); PEER_CE(3, 4); PEER_CE(5, 6);
#undef PEER_CE
            int res = IMIN;
#pragma unroll
            for (int it = 0; it < 16; ++it) {
                const int m = row_max16i(v[0]); const bool own = v[0] == m;
                res = (c16 == it) ? m : res;
#pragma unroll
                for (int i = 0; i < 7; ++i) v[i] = own ? v[i + 1] : v[i];
                v[7] = own ? IMIN : v[7];
            }
            topv[g * 16 + c16] = PEER_KEY(res);
        }
        LDS_FENCE();
        for (int P = 0; P < 2; ++P) { const int h = 4 * P + R; int cs[4];
#pragma unroll
            for (int m = 0; m < 4; ++m) { const float a = __int_as_float(topv[(2 * h) * 16 + pi4[m]]), bq = __int_as_float(topv[(2 * h + 1) * 16 + pj4[m]]);
                const int b = (int)((__float_as_uint(a + bq) & ~63u) | (unsigned)(c16 + 16 * m)); cs[m] = (c16 + 16 * m < 50) ? PEER_KEY(b) : IMIN; }
#define PEER_CE(x, y) do { const int hi_ = max(cs[x], cs[y]), lo_ = min(cs[x], cs[y]); cs[x] = hi_; cs[y] = lo_; } while (0)
            PEER_CE(0, 1); PEER_CE(2, 3); PEER_CE(0, 2); PEER_CE(1, 3); PEER_CE(1, 2);
#undef PEER_CE
            int res = IMIN;
#pragma unroll
            for (int it = 0; it < 16; ++it) {
                const int m = row_max16i(cs[0]); const bool own = cs[0] == m;
                res = (c16 == it) ? m : res;
                cs[0] = own ? cs[1] : cs[0]; cs[1] = own ? cs[2] : cs[1]; cs[2] = own ? cs[3] : cs[2]; cs[3] = own ? IMIN : cs[3];
            }
            const int bits = PEER_KEY(res), ij = ptab[bits & 63];
            sels[h * 16 + c16] = __int_as_float(bits);
            sele[h * 16 + c16] = (topv[(2 * h) * 16 + (ij >> 4)] & 127) * 128 + (topv[(2 * h + 1) * 16 + (ij & 15)] & 127);
        }
#undef PEER_KEY
        LDS_FENCE();
        { const int h = lane >> 3;
          const float s0 = sels[2 * lane], s1 = sels[2 * lane + 1];
          float mx = fmaxf(s0, s1); mx = fmaxf(mx, dppf<0xB1>(mx)); mx = fmaxf(mx, dppf<0x4E>(mx)); mx = fmaxf(mx, dppf<0x141>(mx));
          const float e0 = __expf(s0 - mx), e1 = __expf(s1 - mx); float sm = e0 + e1; sm += dppf<0xB1>(sm); sm += dppf<0x4E>(sm); sm += dppf<0x141>(sm);
          const float inv = __builtin_amdgcn_rcpf(sm); const float w0 = e0 * inv, w1 = e1 * inv; (void)h;
          const int x0 = sele[2 * lane], x1 = sele[2 * lane + 1]; const int p0 = x0 >> 10, p1 = x1 >> 10; int pos0 = 0, pos1 = 0, base = 0;
#pragma unroll
          for (int x = 0; x < 16; ++x) { const unsigned long long m0 = __ballot(p0 == x), m1 = __ballot(p1 == x); const int c0 = __popcll(m0), c1 = __popcll(m1);
              const int b0 = (int)__builtin_amdgcn_mbcnt_hi((unsigned)(m0 >> 32), __builtin_amdgcn_mbcnt_lo((unsigned)m0, 0u)), b1 = (int)__builtin_amdgcn_mbcnt_hi((unsigned)(m1 >> 32), __builtin_amdgcn_mbcnt_lo((unsigned)m1, 0u));
              pos0 = (p0 == x) ? base + b0 : pos0; pos1 = (p1 == x) ? base + c0 + b1 : pos1; base += c0 + c1; }
          se2[pos0] = x0; sw2[pos0] = w0; se2[pos1] = x1; sw2[pos1] = w1; }
        LDS_FENCE();
#if defined(PROBE_PK)
        const unsigned long long pk1 = __builtin_amdgcn_s_memrealtime();
        if (PROBE_PK == 1) { while (__builtin_amdgcn_s_memrealtime() - pk1 < pk1 - pk0) __builtin_amdgcn_s_sleep(4); }
#endif
        {
            float am = 0.f;
#pragma unroll
            for (int q8 = 0; q8 < 8; ++q8) { const unsigned ww[4] = {hraw[q8].x, hraw[q8].y, hraw[q8].z, hraw[q8].w};
#pragma unroll
                for (int j = 0; j < 4; ++j) am = fmaxf(am, fmaxf(fabsf(bf_lo(ww[j])), fabsf(bf_hi(ww[j])))); }
            am = fmaxf(row_max16(am), 1e-20f);
            const float qs = 119.f * __builtin_amdgcn_rcpf(am); tscale = am * (1.f / (119.f * EU_S));
#pragma unroll
            for (int q8 = 0; q8 < 8; ++q8) { const unsigned ww[4] = {hraw[q8].x, hraw[q8].y, hraw[q8].z, hraw[q8].w};
                unsigned c0 = 0u, c1 = 0u;
                c0 = __builtin_amdgcn_cvt_pk_u8_f32(__builtin_rintf(bf_lo(ww[0]) * qs) + 136.f, 0u, c0); c0 = __builtin_amdgcn_cvt_pk_u8_f32(__builtin_rintf(bf_hi(ww[0]) * qs) + 136.f, 1u, c0);
                c0 = __builtin_amdgcn_cvt_pk_u8_f32(__builtin_rintf(bf_lo(ww[1]) * qs) + 136.f, 2u, c0); c0 = __builtin_amdgcn_cvt_pk_u8_f32(__builtin_rintf(bf_hi(ww[1]) * qs) + 136.f, 3u, c0);
                c1 = __builtin_amdgcn_cvt_pk_u8_f32(__builtin_rintf(bf_lo(ww[2]) * qs) + 136.f, 0u, c1); c1 = __builtin_amdgcn_cvt_pk_u8_f32(__builtin_rintf(bf_hi(ww[2]) * qs) + 136.f, 1u, c1);
                c1 = __builtin_amdgcn_cvt_pk_u8_f32(__builtin_rintf(bf_lo(ww[3]) * qs) + 136.f, 2u, c1); c1 = __builtin_amdgcn_cvt_pk_u8_f32(__builtin_rintf(bf_hi(ww[3]) * qs) + 136.f, 3u, c1);
                hqh[q8] = (int)((((c0 >> 4) & 0x0f0f0f0fu) | (c1 & 0xf0f0f0f0u)) ^ 0x88888888u);
                hql[q8] = (int)(((c0 & 0x0f0f0f0fu) | ((c1 << 4) & 0xf0f0f0f0u)) ^ 0x88888888u); }
#pragma unroll
            for (int j = 0; j < 32; ++j) acch[j] = (h2_t){(_Float16)0.f, (_Float16)0.f}; }
        u32x4 A4[2][2], B4[2][2];
#define PEER_LDV(b) _Pragma("unroll") for (int i = 0; i < 2; ++i) { const int e_ = se2[(b) * 8 + 2 * R + i]; const unsigned char* rp_ = EV + (size_t)e_ * 512 + c16 * 16; B4[i][0] = *(const u32x4*)rp_; B4[i][1] = *(const u32x4*)(rp_ + 256); }
#define PEER_LDU(b) _Pragma("unroll") for (int i = 0; i < 2; ++i) { const int e_ = se2[(b) * 8 + 2 * R + i]; const unsigned char* rp_ = EU + (size_t)e_ * 512 + c16 * 16; A4[i][0] = *(const u32x4*)rp_; A4[i][1] = *(const u32x4*)(rp_ + 256); }
#define PEER_UCOMP(b) do { float d[2]; \
        _Pragma("unroll") for (int i = 0; i < 2; ++i) { int h0_ = 0, h1_ = 0, l0_ = 0, l1_ = 0; const int uw_[8] = {(int)A4[i][0].x, (int)A4[i][0].y, (int)A4[i][0].z, (int)A4[i][0].w, (int)A4[i][1].x, (int)A4[i][1].y, (int)A4[i][1].z, (int)A4[i][1].w}; \
            _Pragma("unroll") for (int n = 0; n < 8; n += 2) { h0_ = __builtin_amdgcn_sdot8(uw_[n], hqh[n], h0_, false); l0_ = __builtin_amdgcn_sdot8(uw_[n], hql[n], l0_, false); \
                h1_ = __builtin_amdgcn_sdot8(uw_[n + 1], hqh[n + 1], h1_, false); l1_ = __builtin_amdgcn_sdot8(uw_[n + 1], hql[n + 1], l1_, false); } \
            d[i] = (float)(16 * (h0_ + h1_) + l0_ + l1_); } \
        const bool b0_ = lane & 1; float t_ = (b0_ ? d[1] : d[0]) + dppf<0xB1>(b0_ ? d[0] : d[1]);        \
        t_ += dppf<0x4E>(t_); t_ += dppf<0x124>(t_); t_ += dppf<0x128>(t_); \
        if (c16 < 2) { const int k_ = (b) * 8 + 2 * R + c16; sw2[k_] = sw2[k_] * gelu_tanh(t_ * tscale); } } while (0)
#define PEER_VCOMP(b) do { _Pragma("unroll") for (int i = 0; i < 2; ++i) { const _Float16 wq_ = (_Float16)(sw2[(b) * 8 + 2 * R + i] * (1.f / EV_S)); const h2_t w2_ = (h2_t){wq_, wq_}; \
            const unsigned vw_[8] = {B4[i][0].x, B4[i][0].y, B4[i][0].z, B4[i][0].w, B4[i][1].x, B4[i][1].y, B4[i][1].z, B4[i][1].w}; \
            _Pragma("unroll") for (int n = 0; n < 8; ++n) { \
                acch[4 * n] += w2_ * __builtin_amdgcn_cvt_scalef32_pk_f16_fp4(vw_[n], 1.0f, 0); acch[4 * n + 1] += w2_ * __builtin_amdgcn_cvt_scalef32_pk_f16_fp4(vw_[n], 1.0f, 1); \
                acch[4 * n + 2] += w2_ * __builtin_amdgcn_cvt_scalef32_pk_f16_fp4(vw_[n], 1.0f, 2); acch[4 * n + 3] += w2_ * __builtin_amdgcn_cvt_scalef32_pk_f16_fp4(vw_[n], 1.0f, 3); } } } while (0)
        PEER_LDU(0); PEER_LDV(0);
        { const int rn = (r + NGW < nrows) ? r + NGW : r;
#pragma unroll
          for (int B = 0; B < 4; ++B) scn[B] = *(const u32x4*)(SC + (size_t)rn * 2048 + (4 * B + R) * 128 + 8 * c16); }
        const int cb = 64 * c16 + 16 * R; const int mrow = r < NL ? (r >> 11) : 16;
        bf16_t* hp = h_row(p->out, p->ws, r) + cb; const float* g2 = MODL + (size_t)mrow * 6144 + 5120 + cb;
        const u32x4 hr0 = ((const u32x4*)hp)[0], hr1 = ((const u32x4*)hp)[1];
        for (int b = 0; b < 16; ++b) {
            PEER_UCOMP(b);
            if (b + 1 < 16) { PEER_LDU(b + 1); }
            LDS_FENCE();
            PEER_VCOMP(b);
            if (b + 1 < 16) { PEER_LDV(b + 1); }
        }
#if defined(PROBE_PEER)

        }
#endif
#if defined(PROBE_PK)
        if (PROBE_PK == 2) { const unsigned long long pk2 = __builtin_amdgcn_s_memrealtime(); while (__builtin_amdgcn_s_memrealtime() - pk2 < pk2 - pk1) __builtin_amdgcn_s_sleep(4); }
#endif
        float a16[16];
        { h2_t f1[16];
#pragma unroll
          for (int j = 0; j < 16; ++j) { auto sx = __builtin_amdgcn_permlane32_swap(__builtin_bit_cast(unsigned, acch[j]), __builtin_bit_cast(unsigned, acch[16 + j]), false, false);
              f1[j] = __builtin_bit_cast(h2_t, (unsigned)sx[0]) + __builtin_bit_cast(h2_t, (unsigned)sx[1]); }
#pragma unroll
          for (int j = 0; j < 8; ++j) { auto sx = __builtin_amdgcn_permlane16_swap(__builtin_bit_cast(unsigned, f1[j]), __builtin_bit_cast(unsigned, f1[8 + j]), false, false);
              const h2_t x = __builtin_bit_cast(h2_t, (unsigned)sx[0]), y = __builtin_bit_cast(h2_t, (unsigned)sx[1]); a16[2 * j] = (float)x.x + (float)y.x; a16[2 * j + 1] = (float)x.y + (float)y.y; } }
        float hv[16], ss = 0.f;
        { const unsigned hw[8] = {hr0.x, hr0.y, hr0.z, hr0.w, hr1.x, hr1.y, hr1.z, hr1.w};
#pragma unroll
          for (int j = 0; j < 4; ++j) { const f32x4 g4 = ((const f32x4*)g2)[j];
#pragma unroll
            for (int i = 0; i < 4; ++i) { const unsigned w = hw[2 * j + (i >> 1)]; const float y = ((i & 1) ? bf_hi(w) : bf_lo(w)) + g4[i] * a16[4 * j + i]; hv[4 * j + i] = y; ss += y * y; } } }
        const float rstd = rsqrtf(wave_sum_d(ss) * (1.f / 1024.f) + 1e-6f);
        asm volatile("" :: "v"(scn[0]), "v"(scn[1]), "v"(scn[2]), "v"(scn[3]));
        if (layer == 0) {
            { u32x4 o0, o1; o0.x = pk2(hv[0], hv[1]); o0.y = pk2(hv[2], hv[3]); o0.z = pk2(hv[4], hv[5]); o0.w = pk2(hv[6], hv[7]); o1.x = pk2(hv[8], hv[9]); o1.y = pk2(hv[10], hv[11]); o1.z = pk2(hv[12], hv[13]); o1.w = pk2(hv[14], hv[15]);
              ((u32x4*)hp)[0] = o0; ((u32x4*)hp)[1] = o1; }
            const float* md = MODL + 17 * 6144 + (size_t)mrow * 6144 + cb; const float* gn = p->in[6] + 1024 + cb; float y[16];
#pragma unroll
            for (int j = 0; j < 16; ++j) y[j] = hv[j] * rstd * gn[j] * (1.f + md[1024 + j]) + md[j];
#pragma unroll
            for (int j = 0; j < 16; ++j) y[j] *= ACT_S;
            *(u32x4*)(HN8 + (size_t)r * 1024 + cb) = (u32x4){pk4_f8(y[0], y[1], y[2], y[3]), pk4_f8(y[4], y[5], y[6], y[7]), pk4_f8(y[8], y[9], y[10], y[11]), pk4_f8(y[12], y[13], y[14], y[15])};
        } else {
            const float* gn = p->in[26] + cb; float* op = p->out + (size_t)r * 1024 + cb;
            f32x4 gnv[4];
#pragma unroll
            for (int j = 0; j < 4; ++j) gnv[j] = ((const f32x4*)gn)[j];
#pragma unroll
            for (int j = 0; j < 4; ++j) ((f32x4*)op)[j] = (f32x4){hv[4 * j] * rstd * gnv[j][0], hv[4 * j + 1] * rstd * gnv[j][1], hv[4 * j + 2] * rstd * gnv[j][2], hv[4 * j + 3] * rstd * gnv[j][3]};
        }
    }
#undef PEER_LDU
#undef PEER_LDV
#undef PEER_UCOMP
#undef PEER_VCOMP
}
#define LAYOUT_STR2(x) #x
#define LAYOUT_STR(x) LAYOUT_STR2(x)

constexpr int N_PHASES = 25;
#ifndef ONLY
#define ONLY -1
#endif
#define EN(k) (ONLY < 0 || ONLY == (k))
template <bool F8, class Epi> __device__ __forceinline__ void run_gemm(LAS unsigned char* lds, const void* A, const void* Bt, int M, int N, const Epi& E, const void* A2 = nullptr, const void* Bt2 = nullptr) {
    pg8::Gemm g{(const bf16_t*)A, (const bf16_t*)Bt, M, N, F8 ? 512 : 1024, (const bf16_t*)A2, (const bf16_t*)Bt2}; pg8::StaticOrder S; S.init(M, N, (int)gridDim.x, (int)blockIdx.x);
    pg8::gemm_phase<Epi, pg8::StaticOrder, false, F8>(lds, g, S, E, nullptr);
}
__global__ void __launch_bounds__(512, 2) fwd_kernel(Params p_unused) {
    extern __shared__ __attribute__((aligned(16))) unsigned char lds_raw[];
#if defined(LAYOUT_SHIFT)
    asm volatile(".fill " LAYOUT_STR(LAYOUT_SHIFT) ", 4, 0xBF800000" :::);
#endif
    LAS unsigned char* lds = (LAS unsigned char*)lds_raw;
    cg::grid_group grid = cg::this_grid();
    CPP p0 = (CPP)__builtin_amdgcn_kernarg_segment_ptr();
    const int ph_lo = p0->ph_lo, ph_hi = p0->ph_hi, coop = p0->coop;
    volatile LAS unsigned* bst = (volatile LAS unsigned*)(lds + LDS_BYTES - 16);
    if (threadIdx.x < 4) bst[threadIdx.x] = 0u;
    __syncthreads();
    XcdBarrier bar = xcd_barrier_post((unsigned*)(p0->ws + OFF_BAR), bst);
    for (int ph = ph_lo; ph < ph_hi; ++ph) {
        CPP p = p0; asm volatile("" : "+s"(p));
        unsigned char* ws = p->ws; float* HC = (float*)(ws + OFF_HC);
        int tid_l = threadIdx.x; asm volatile("" : "+v"(tid_l));
        const int tid = tid_l, lane = tid & 63, wave = __builtin_amdgcn_readfirstlane(tid >> 6);
#if defined(PROBE_STRETCH)
        const unsigned long long pst0 = __builtin_amdgcn_s_memrealtime();
#endif
        if (ph == 0 && EN(20)) prep_phase(p, 0, lds, tid, lane, wave);
        else if (ph == 1 && EN(21)) norm_phase(p, 0, 0, NT, p->in[0], p->in[2], lane, wave);
        else {
            const int layer = (ph - 2) / 12, sub = (ph - 2) % 12, M = layer ? NL : NT;
            if (sub == 0 && EN(0)) { EpiA E{(bf16_t*)(ws + 1 * SLOT), (bf16_t*)(ws + 3 * SLOT), (bf16_t*)(ws + 3 * SLOT) + (size_t)NT * 512, (bf16_t*)(ws + 2 * SLOT), (bf16_t*)(ws + OFF_F), 0.08838834764831845f};
                run_gemm<true>(lds, ws + OFF_HN8, ws + OFF_WA, NT, 3328, E); }
            else if (sub == 1 && EN(1)) gla_phase(p, layer, lds, tid, lane, wave);
            else if (sub == 2 && EN(2)) { lru_phase(p, layer, lds, tid, lane, wave); onorm_phase(p, layer, tid, lane, wave); }
            else if (sub == 3) { }
            else if (sub == 4 && EN(4)) { EpiB E{(const bf16_t*)(ws + 3 * SLOT), (const bf16_t*)(ws + 2 * SLOT), (const bf16_t*)(ws + 4 * SLOT), ws};
                run_gemm<true>(lds, ws + OFF_HN8, ws + OFF_WB, M, 4096, E); }
            else if (sub == 5 && EN(5)) { EpiMM E{ws + OFF_SGL8, ws + OFF_SGG8, ws + OFF_MM8}; run_gemm<true>(lds, ws + OFF_YL8, ws + OFF_WBL, M, 1024, E, ws + OFF_YG8, ws + OFF_WBL + 2 * MiB); }
            else if (sub == 6) { }
            else if (sub == 7 && EN(7)) { EpiOut E{p->in[0], p->in[2], p->out, ws, (const float*)(ws + OFF_MOD) + (size_t)layer * 17 * 6144, layer};
                run_gemm<true>(lds, ws + OFF_MM8, ws + OFF_WBL + 4 * MiB, M, 1024, E); }
            else if (sub == 8 && EN(8)) norm_phase(p, layer, 1, M, p->out, HC, lane, wave);
            else if (sub == 9 && EN(9)) { EpiSc E{(bf16_t*)(ws + 1 * SLOT)}; run_gemm<false>(lds, ws + OFF_HN2, ws + OFF_WSC, M, 2048, E); }
            else if (sub == 10 && EN(10)) peer_phase(p, layer, lds, lane, wave);
            else if (layer == 0 && EN(20)) prep_phase(p, 1, lds, tid, lane, wave);
        }
#if defined(PROBE_STRETCH)
        { const int code = ph == 0 ? 12 : ph == 1 ? 13 : (ph - 2) % 12;
          if ((PROBE_STRETCH >> code) & 1) { const unsigned long long pst1 = __builtin_amdgcn_s_memrealtime(); while (__builtin_amdgcn_s_memrealtime() - pst1 < pst1 - pst0) __builtin_amdgcn_s_sleep(8); } }
#endif
        const bool no_seam = ph >= 2 && ((ph - 2) % 12 == 6 || (ph - 2) % 12 == 3);
        if (coop && ph + 1 < ph_hi && !no_seam) { if (ph == ph_lo) grid.sync(); else xcd_barrier(bar);
#if defined(PROBE_BAR)
            for (int rep = 0; rep < PROBE_BAR; ++rep) xcd_barrier(bar);
#endif
        }
    }
}

extern "C" void kernel_launch(void* const* d_in, const int* in_sizes, int n_in, void* d_out, int out_size, void* d_ws, size_t ws_size, hipStream_t stream) {
    static int grid_blocks = 0;
    if (!grid_blocks) {
        int dev = 0, cus = 0, per_cu = 0;
        (void)hipGetDevice(&dev);
        (void)hipDeviceGetAttribute(&cus, hipDeviceAttributeMultiprocessorCount, dev);
        (void)hipFuncSetAttribute((const void*)fwd_kernel, hipFuncAttributeMaxDynamicSharedMemorySize, LDS_BYTES);
        (void)hipOccupancyMaxActiveBlocksPerMultiprocessor(&per_cu, (const void*)fwd_kernel, 512, LDS_BYTES);
        if (per_cu < 1) { fprintf(stderr, "kernel_launch: occupancy query says %d blocks per CU\n", per_cu); per_cu = 1; }
        grid_blocks = cus * per_cu;
        fprintf(stderr, "kernel_launch: cus %d per_cu %d grid %d ws %zu need %zu\n", cus, per_cu, grid_blocks, ws_size, (size_t)WS_END);
    }
    if (n_in != 27 || ws_size < WS_END) { fprintf(stderr, "kernel_launch: bad inputs (n_in %d, ws %zu < %zu)\n", n_in, ws_size, (size_t)WS_END); return; }
    (void)hipMemsetAsync((char*)d_ws + OFF_BAR, 0, XCD_BAR_WORDS * 4, stream);
    Params p{};
    for (int i = 0; i < 27; ++i) p.in[i] = (const float*)d_in[i];
    p.out = (float*)d_out; p.ws = (unsigned char*)d_ws; p.ph_lo = 0; p.ph_hi = N_PHASES; p.coop = 1; p.pad = 0;
#if defined(MULTI_LAUNCH)
    p.coop = 0;
    for (int ph = 0; ph < N_PHASES; ++ph) { p.ph_lo = ph; p.ph_hi = ph + 1; hipLaunchKernelGGL(fwd_kernel, dim3(grid_blocks), dim3(512), LDS_BYTES, stream, p); }
#else
    void* args[] = {&p};
    hipError_t e = hipLaunchCooperativeKernel((void*)fwd_kernel, dim3(grid_blocks), dim3(512), args, LDS_BYTES, stream);
    if (e != hipSuccess) fprintf(stderr, "cooperative launch failed: %s (grid %d)\n", hipGetErrorString(e), grid_blocks);
#endif
}
```

```cpp
#define LAYOUT_SHIFT 28
#include <hip/hip_runtime.h>
#include <hip/hip_cooperative_groups.h>
#include <cstdio>
namespace cg = cooperative_groups;
namespace pg8 {
#define PG8_LAS __attribute__((address_space(3)))
typedef unsigned short bf16_t;
typedef short bf16x8 __attribute__((ext_vector_type(8)));
typedef float f32x4 __attribute__((ext_vector_type(4)));
typedef unsigned u32x4 __attribute__((ext_vector_type(4)));
constexpr int BM = 256, BK = 64, HALF = 128, HTB = HALF * BK * 2  , STAGE_BYTES = 8 * HTB, NXCD = 8, WGM = 8;

__host__ __device__ __forceinline__ int lds_byte(int r, int c) { const int st = (r >> 4) * 2 + (c >> 5), rr = r & 15, cc = c & 31, ob = rr * 64 + cc * 2; return st * 1024 + (ob ^ (((ob >> 9) & 1) << 5)); }
__host__ __device__ __forceinline__ void stage_rc(int b, int& R, int& C) { const int st = b / 1024, sb = b % 1024, swz = sb ^ (((sb >> 9) & 1) << 5); R = (st >> 1) * 16 + swz / 64; C = (st & 1) * 32 + (swz % 64) / 2; }
__host__ __device__ __forceinline__ int perm32(int rho) { const int n = rho >> 4, i = rho & 15; return 8 * (i >> 2) + 4 * n + (i & 3); }

struct Unit { int pm, pn; };
struct Gemm { const bf16_t* A; const bf16_t* Bt; int M, N, K; const bf16_t* A2; const bf16_t* Bt2; };

struct StaticOrder {
    int nM, nN, nwg, G, c;
    __host__ __device__ void init(int M, int N, int G_, int c_) { nM = M / BM; nN = N / BM; nwg = nM * nN; G = G_; c = c_; }
    __host__ __device__ bool next(int i, Unit& u) const {
        const long L = (long)i * G + c; if (L >= nwg) return false;
        int wgid = (int)L; { const int q = nwg / NXCD, r = nwg % NXCD, xcd = wgid % NXCD, off = wgid / NXCD; wgid = (xcd < r ? xcd * (q + 1) : r * (q + 1) + (xcd - r) * q) + off; }
        const int nig = WGM * nN, gid = wgid / nig, fm = gid * WGM, gsz = (nM - fm) < WGM ? (nM - fm) : WGM;
        u.pm = fm + ((wgid % nig) % gsz); u.pn = (wgid % nig) / gsz; return true;
    }
    __device__ __forceinline__ void a_ready(const Unit&) const {}
    __device__ __forceinline__ void done(const Unit&) const {}
};
__device__ __forceinline__ unsigned cvt_pk_bf16(float lo, float hi) { unsigned r; asm volatile("v_cvt_pk_bf16_f32 %0, %1, %2" : "=v"(r) : "v"(lo), "v"(hi)); return r; }
typedef float f32x2 __attribute__((ext_vector_type(2)));
typedef int i32x4 __attribute__((ext_vector_type(4)));
typedef int i32x8 __attribute__((ext_vector_type(8)));
constexpr int F8_SCALE_W = 0x79797979, F8_SCALE_A = 0x7c7c7c7c;
__device__ __forceinline__ i32x8 cat8(bf16x8 a, bf16x8 b) { const i32x4 x = __builtin_bit_cast(i32x4, a), y = __builtin_bit_cast(i32x4, b); return __builtin_shufflevector(x, y, 0, 1, 2, 3, 4, 5, 6, 7); }
template <class Epi, class Sched, bool STAMP = false, bool F8 = false>
__device__ __forceinline__ void gemm_phase(PG8_LAS unsigned char* lds, const Gemm g, const Sched& S, const Epi& E, unsigned long long* stamps) {
    int tid_l = threadIdx.x; asm volatile("" : "+v"(tid_l)); const int tid = tid_l, wid = __builtin_amdgcn_readfirstlane(tid >> 6), lane = tid & 63, wr = wid >> 2, wc = wid & 3, fr = lane & 15, fq = lane >> 4;
    const int K = g.K, nt = K / BK;
    int ts_lo = 0, ts_hi = 0, nts = 0; const unsigned long long rt_entry = STAMP ? (unsigned long long)wall_clock64() : 0ull;
#define PG8_STAMP() do { if (STAMP && wid == 0 && nts < 64) { const unsigned long long _c = (unsigned long long)clock64(); \
        ts_lo = (lane == nts) ? (int)(unsigned)_c : ts_lo; ts_hi = (lane == nts) ? (int)(unsigned)(_c >> 32) : ts_hi; ++nts; } } while (0)
    PG8_STAMP();
    unsigned voffA[2], voffB[2];
#pragma unroll
    for (int i = 0; i < 2; ++i) { int R, C; stage_rc(tid * 16 + i * 8192, R, C); const int Rb = Epi::PERM ? ((R & ~31) + perm32(R & 31)) : R;
        voffA[i] = (unsigned)(R * K + C) * 2u; voffB[i] = (unsigned)(Rb * K + C) * 2u; }
    const size_t kstep = (size_t)(BK * 2);
    const size_t hstep = (size_t)HALF * K * 2;
    const size_t tstep = 2 * hstep;
    const unsigned ldsw = (unsigned)wid * 1024u;
    const int aoff = lds_byte(wr * 64 + fr, fq * 8), boff = lds_byte(wc * 32 + fr, fq * 8);
#define PG8_SA(b, h) (((b) * 2 + (h)) * HTB)
#define PG8_SB(b, h) ((4 + (b) * 2 + (h)) * HTB)
#define PG8_STAGE(bufoff, gbase, voff) do { _Pragma("unroll") for (int _i = 0; _i < 2; ++_i) \
        __builtin_amdgcn_global_load_lds((const unsigned*)((const char*)(gbase) + (voff)[_i]), (PG8_LAS unsigned*)(lds + (bufoff) + ldsw + _i * 8192), 16, 0, 0); } while (0)
#define PG8_LDA(dst, b, h) do { _Pragma("unroll") for (int m = 0; m < 4; ++m) _Pragma("unroll") for (int k = 0; k < 2; ++k) dst[m][k] = *(const PG8_LAS bf16x8*)(lds + PG8_SA(b, h) + aoff + m * 2048 + k * 1024); } while (0)
#define PG8_LDB(dst, b, h) do { _Pragma("unroll") for (int n = 0; n < 2; ++n) _Pragma("unroll") for (int k = 0; k < 2; ++k) dst[n][k] = *(const PG8_LAS bf16x8*)(lds + PG8_SB(b, h) + boff + n * 2048 + k * 1024); } while (0)
#define PG8_MMA(ai, bj, At, Bt) do { __builtin_amdgcn_s_setprio(1); _Pragma("unroll") for (int m = 0; m < 4; ++m) _Pragma("unroll") for (int n = 0; n < 2; ++n) { \
        if constexpr (F8) asm volatile("v_mfma_scale_f32_16x16x128_f8f6f4 %0, %1, %2, %0, %3, %4 op_sel_hi:[0,0,0]" : "+v"(acc[ai][bj][m][n]) : "v"(cat8(Bt[n][0], Bt[n][1])), "v"(cat8(At[m][0], At[m][1])), "v"(f8sw), "v"(f8sa)); \
        else { _Pragma("unroll") for (int k = 0; k < 2; ++k) acc[ai][bj][m][n] = __builtin_amdgcn_mfma_f32_16x16x32_bf16(Bt[n][k], At[m][k], acc[ai][bj][m][n], 0, 0, 0); } } __builtin_amdgcn_s_setprio(0); } while (0)
#define PG8_WAIT_V(n) asm volatile("s_waitcnt vmcnt(" #n ")" ::: "memory")
#define PG8_WAIT_L(n) asm volatile("s_waitcnt lgkmcnt(" #n ")" ::: "memory")
#define PG8_BAR __builtin_amdgcn_s_barrier()
#define PG8_SCHED __builtin_amdgcn_sched_barrier(0)
    Unit cur, nxt; int ui = 0;
    int f8sw = F8_SCALE_W, f8sa = F8_SCALE_A; asm volatile("" : "+v"(f8sw), "+v"(f8sa));
    if (!S.next(0, cur)) return;
    f32x4 acc[2][2][4][2];
#pragma unroll
    for (int a = 0; a < 2; ++a)
#pragma unroll
        for (int b = 0; b < 2; ++b)
#pragma unroll
            for (int m = 0; m < 4; ++m)
#pragma unroll
                for (int n = 0; n < 2; ++n) acc[a][b][m][n] = (f32x4){0.f, 0.f, 0.f, 0.f};
    bf16x8 At[4][2], B0[2][2], B1[2][2];
    const char* cA = (const char*)g.A + (size_t)cur.pm * tstep; const char* cB = (const char*)g.Bt + (size_t)cur.pn * tstep;
    S.a_ready(cur);
    PG8_STAGE(PG8_SB(0, 0), cB, voffB); PG8_STAGE(PG8_SA(0, 0), cA, voffA); PG8_STAGE(PG8_SB(0, 1), cB + hstep, voffB); PG8_STAGE(PG8_SA(0, 1), cA + hstep, voffA);
    if (wr == 1) PG8_BAR;
    PG8_WAIT_V(4); PG8_BAR;
    PG8_STAGE(PG8_SB(1, 0), cB + kstep, voffB); PG8_STAGE(PG8_SA(1, 0), cA + kstep, voffA); PG8_STAGE(PG8_SB(1, 1), cB + hstep + kstep, voffB);
    PG8_WAIT_V(6); PG8_BAR;
    PG8_STAMP();
    for (;;) {
        const bool seg0 = (Epi::NSEG == 2) && !(ui & 1);
        bool has_next; if (seg0) { has_next = true; nxt = cur; } else has_next = S.next((ui + 1) / Epi::NSEG, nxt);
        const char* nA = has_next ? (const char*)(seg0 ? g.A2 : g.A) + (size_t)nxt.pm * tstep : cA; const char* nB = has_next ? (const char*)(seg0 ? g.Bt2 : g.Bt) + (size_t)nxt.pn * tstep : cB;
#pragma nounroll
        for (int t = 0; t < nt; t += 2) {
            const bool last = (t == nt - 2);
            const char* a1 = cA + (size_t)(t + 1) * kstep;
            const char* a2 = last ? nA : cA + (size_t)(t + 2) * kstep; const char* b2 = last ? nB : cB + (size_t)(t + 2) * kstep;
            const char* a3 = a2 + kstep; const char* b3 = b2 + kstep;
            if (last && has_next) S.a_ready(nxt);
            PG8_LDB(B0, 0, 0); PG8_SCHED; PG8_LDA(At, 0, 0); PG8_STAGE(PG8_SA(1, 1), a1 + hstep, voffA);
            PG8_WAIT_L(8); PG8_BAR; PG8_WAIT_L(0); PG8_MMA(0, 0, At, B0); PG8_BAR; PG8_SCHED;
            PG8_LDB(B1, 0, 1); PG8_STAGE(PG8_SB(0, 0), b2, voffB);
            PG8_BAR; PG8_WAIT_L(0); PG8_MMA(0, 1, At, B1); PG8_BAR;
            PG8_LDA(At, 0, 1); PG8_STAGE(PG8_SA(0, 0), a2, voffA);
            PG8_BAR; PG8_WAIT_L(0); PG8_MMA(1, 0, At, B0); PG8_BAR; PG8_SCHED;
            PG8_STAGE(PG8_SB(0, 1), b2 + hstep, voffB);
            PG8_WAIT_V(6); PG8_BAR; PG8_MMA(1, 1, At, B1); PG8_BAR;
            PG8_LDB(B0, 1, 0); PG8_SCHED; PG8_LDA(At, 1, 0); PG8_STAGE(PG8_SA(0, 1), a2 + hstep, voffA);
            PG8_WAIT_L(8); PG8_BAR; PG8_WAIT_L(0); PG8_MMA(0, 0, At, B0); PG8_BAR; PG8_SCHED;
            PG8_LDB(B1, 1, 1); PG8_STAGE(PG8_SB(1, 0), b3, voffB);
            PG8_BAR; PG8_WAIT_L(0); PG8_MMA(0, 1, At, B1); PG8_BAR;
            PG8_LDA(At, 1, 1); PG8_STAGE(PG8_SA(1, 0), a3, voffA);
            PG8_BAR; PG8_WAIT_L(0); PG8_MMA(1, 0, At, B0); PG8_BAR; PG8_SCHED;
            PG8_STAGE(PG8_SB(1, 1), b3 + hstep, voffB);
            PG8_WAIT_V(6); PG8_BAR; PG8_MMA(1, 1, At, B1); PG8_BAR;
        }
        if constexpr (F8) asm volatile("s_nop 15\n\ts_nop 15" ::: "memory");
        PG8_STAMP();
        if constexpr (Epi::NSEG == 2) { if (seg0) E.mid(acc, cur, wr, wc, fr, fq); else { E(acc, cur, wr, wc, fr, fq); S.done(cur); } }
        else if constexpr (!Epi::AFTER_DRAIN) { E(acc, cur, wr, wc, fr, fq); S.done(cur); }
        PG8_STAMP();
        if (!has_next) break;
        if (!seg0) {
#pragma unroll
        for (int a = 0; a < 2; ++a)
#pragma unroll
            for (int b = 0; b < 2; ++b)
#pragma unroll
                for (int m = 0; m < 4; ++m)
#pragma unroll
                    for (int n = 0; n < 2; ++n) acc[a][b][m][n] = (f32x4){0.f, 0.f, 0.f, 0.f};
        }
        cur = nxt; cA = nA; cB = nB; ++ui;
    }
    PG8_WAIT_V(0);
    if (wr == 0) PG8_BAR;
    PG8_BAR;
    if constexpr (Epi::AFTER_DRAIN) { E.fused(acc, cur, wr, wc, fr, fq, lds, wid, lane); S.done(cur); }
    PG8_STAMP();
    if (STAMP && wid == 0) { stamps[lane] = lane < nts ? (((unsigned long long)(unsigned)ts_hi << 32) | (unsigned)ts_lo) : 0ull;
        if (lane == 62) stamps[62] = rt_entry; if (lane == 63) stamps[63] = (unsigned long long)wall_clock64(); }
#undef PG8_STAMP
#undef PG8_SA
#undef PG8_SB
#undef PG8_STAGE
#undef PG8_LDA
#undef PG8_LDB
#undef PG8_MMA
#undef PG8_WAIT_V
#undef PG8_WAIT_L
#undef PG8_BAR
#undef PG8_SCHED
}
}

using pg8::bf16_t; using pg8::f32x4; using pg8::u32x4; using pg8::Unit;
#define LAS __attribute__((address_space(3)))
typedef unsigned u32x2 __attribute__((ext_vector_type(2)));
typedef float f32x2 __attribute__((ext_vector_type(2)));
typedef short bf16x8_t __attribute__((ext_vector_type(8)));
typedef float f32x16 __attribute__((ext_vector_type(16)));
typedef float f32x32 __attribute__((ext_vector_type(32)));
typedef unsigned u32x6 __attribute__((ext_vector_type(6)));
typedef _Float16 h2_t __attribute__((ext_vector_type(2)));
typedef _Float16 h32_t __attribute__((ext_vector_type(32)));

constexpr int NT = 36864, NL = 32768, NCX = 4096;
constexpr size_t MiB = 1u << 20;
constexpr size_t SLOT = 72 * MiB;
constexpr size_t FIX = 7 * SLOT;
constexpr size_t OFF_HC = FIX;
constexpr size_t OFF_WA = FIX + 16 * MiB;
constexpr size_t OFF_WB = OFF_WA + (size_t)3328 * 2048;
constexpr size_t OFF_WBL = OFF_WB + (size_t)4096 * 2048;
constexpr size_t OFF_WSC = OFF_WBL + 6 * MiB;
constexpr size_t OFF_MOD = OFF_WSC + 4 * MiB;
constexpr size_t OFF_BAR = OFF_MOD + 896 * 1024;
constexpr size_t WS_END = OFF_MOD + 1 * MiB;
constexpr size_t OFF_F = 6 * SLOT;
constexpr size_t OFF_WG = 6 * SLOT + 4 * MiB;
__device__ __forceinline__ size_t off_wa(int l) { return OFF_WA + (size_t)l * 3328 * 1024; }
__device__ __forceinline__ size_t off_wb(int l) { return OFF_WB + (size_t)l * 4 * MiB; }
__device__ __forceinline__ size_t off_wbl(int l, int mi) { return OFF_WBL + (size_t)mi * 2 * MiB + (size_t)l * MiB; }
__device__ __forceinline__ size_t off_wsc(int l) { return OFF_WSC - (size_t)l * (OFF_WSC - (OFF_HC + 10 * MiB)); }
__device__ __forceinline__ size_t off_wg(int l) { return OFF_WG + (size_t)l * MiB; }
constexpr size_t OFF_EU = 6 * SLOT + 8 * MiB;
constexpr size_t OFF_EV = 6 * SLOT + 40 * MiB;
constexpr int LDS_BYTES = 144 * 1024;
constexpr size_t HSLOT = 36 * MiB;
constexpr size_t OFF_HN8 = 0, OFF_YL8 = HSLOT, OFF_SGL8 = SLOT, OFF_SGG8 = SLOT + HSLOT, OFF_MM8 = 2 * SLOT, OFF_M1 = 3 * SLOT, OFF_HN2 = 3 * SLOT, OFF_YG8 = 5 * SLOT;
constexpr float ACT_S = 8.f, WGT_S = 64.f;
constexpr size_t OFF_HQ = 4 * SLOT, OFF_TS = 4 * SLOT + 40 * MiB;
constexpr float EV_S = 2.f;
constexpr float EU_S = 96.f;
typedef unsigned char u8_t;

struct Params { const float* in[27]; float* out; unsigned char* ws; int ph_lo, ph_hi, coop, pad; };
typedef const __attribute__((address_space(4))) Params* CPP;

__device__ __forceinline__ float bf_lo(unsigned w) { return __uint_as_float(w << 16); }
__device__ __forceinline__ float bf_hi(unsigned w) { return __uint_as_float(w & 0xffff0000u); }
__device__ __forceinline__ float bf2f(bf16_t b) { return __uint_as_float(((unsigned)b) << 16); }
typedef __bf16 bf16x2n __attribute__((ext_vector_type(2)));
__device__ __forceinline__ unsigned pk2(float lo, float hi) { const f32x2 v = {lo, hi}; return __builtin_bit_cast(unsigned, __builtin_convertvector(v, bf16x2n)); }
__device__ __forceinline__ bf16_t f2bf(float f) { return (bf16_t)(pk2(f, 0.f) & 0xffffu); }
__device__ __forceinline__ float sigmoidf_(float x) { return __builtin_amdgcn_rcpf(1.f + __expf(-x)); }
__device__ __forceinline__ float siluf_(float x) { return x * sigmoidf_(x); }
__device__ __forceinline__ float gelu_tanh(float x) { return x * sigmoidf_(1.5957691216f * (x + 0.044715f * x * x * x)); }
__device__ __forceinline__ unsigned pk4_f8(float a, float b, float c, float d) {
    const int w = __builtin_amdgcn_cvt_pk_fp8_f32(__builtin_amdgcn_fmed3f(a, -448.f, 448.f), __builtin_amdgcn_fmed3f(b, -448.f, 448.f), 0, false);
    return (unsigned)__builtin_amdgcn_cvt_pk_fp8_f32(__builtin_amdgcn_fmed3f(c, -448.f, 448.f), __builtin_amdgcn_fmed3f(d, -448.f, 448.f), w, true);
}
__device__ __forceinline__ unsigned pk4_u8(float a, float b, float c, float d) {
    unsigned w = __builtin_amdgcn_cvt_pk_u8_f32(a, 0u, 0u); w = __builtin_amdgcn_cvt_pk_u8_f32(b, 1u, w); w = __builtin_amdgcn_cvt_pk_u8_f32(c, 2u, w); return __builtin_amdgcn_cvt_pk_u8_f32(d, 3u, w);
}
__device__ __forceinline__ float ub0(unsigned w) { return (float)(w & 0xffu); }
__device__ __forceinline__ float ub1(unsigned w) { return (float)((w >> 8) & 0xffu); }
__device__ __forceinline__ float ub2(unsigned w) { return (float)((w >> 16) & 0xffu); }
__device__ __forceinline__ float ub3(unsigned w) { return (float)(w >> 24); }
__device__ __forceinline__ float wave_sum(float v) {
#pragma unroll
    for (int o = 32; o >= 1; o >>= 1) v += __shfl_xor(v, o);
    return v;
}
__device__ __forceinline__ float wave_max(float v) {
#pragma unroll
    for (int o = 32; o >= 1; o >>= 1) v = fmaxf(v, __shfl_xor(v, o));
    return v;
}
#define LDS_FENCE() asm volatile("s_waitcnt lgkmcnt(0)" ::: "memory")

__device__ __forceinline__ u32x4 wide_pack(u32x2 r0, u32x2 r1) {
    auto sx = __builtin_amdgcn_permlane16_swap(r0.x, r1.x, false, false); auto sy = __builtin_amdgcn_permlane16_swap(r0.y, r1.y, false, false);
    return (u32x4){sx[0], sy[0], sx[1], sy[1]};
}
__device__ __forceinline__ void wide_unpack(u32x4 w, u32x2& r0, u32x2& r1) {
    auto sx = __builtin_amdgcn_permlane16_swap(w.x, w.z, false, false); auto sy = __builtin_amdgcn_permlane16_swap(w.y, w.w, false, false);
    r0 = (u32x2){sx[0], sy[0]}; r1 = (u32x2){sx[1], sy[1]};
}
__device__ __forceinline__ int wide_col(int wc, int fq) { return wc * 32 + (fq & 1) * 128 + 16 * (fq >> 1); }

struct EpiA {
    static constexpr bool PERM = true, AFTER_DRAIN = false; static constexpr int NSEG = 1;
    bf16_t *X, *Q, *K, *V, *F; float qscale;
    __device__ __forceinline__ void operator()(const f32x4 (&acc)[2][2][4][2], const Unit& u, int wr, int wc, int fr, int fq) const {
        const int pn = u.pn, row0 = u.pm * 256 + wr * 64 + fr;
        if (pn == 12) {
            if (wc == 0) {
#pragma unroll
                for (int ai = 0; ai < 2; ++ai)
#pragma unroll
                    for (int m = 0; m < 4; ++m) { const f32x4 v0 = acc[ai][0][m][0], v1 = acc[ai][0][m][1]; u32x4 w; w.x = pk2(v0[0], v0[1]); w.y = pk2(v0[2], v0[3]); w.z = pk2(v1[0], v1[1]); w.w = pk2(v1[2], v1[3]);
                        *(u32x4*)(F + (size_t)(row0 + ai * 128 + m * 16) * 32 + 8 * fq) = w; }
            }
            return;
        }
        bf16_t* base; int ld, colt; float s = 1.f;
        if (pn < 4) { base = X; ld = 1024; colt = pn * 256; }
        else if (pn < 6) { base = Q; ld = 512; colt = (pn - 4) * 256; s = qscale; }
        else if (pn < 8) { base = K; ld = 512; colt = (pn - 6) * 256; }
        else { base = V; ld = 1024; colt = (pn - 8) * 256; }
        const int col0 = colt + wc * 32 + 8 * fq;
#pragma unroll
        for (int ai = 0; ai < 2; ++ai)
#pragma unroll
            for (int m = 0; m < 4; ++m) { bf16_t* rowp = base + (size_t)(row0 + ai * 128 + m * 16) * ld + col0;
#pragma unroll
                for (int bj = 0; bj < 2; ++bj) { const f32x4 v0 = acc[ai][bj][m][0] * s, v1 = acc[ai][bj][m][1] * s; u32x4 w; w.x = pk2(v0[0], v0[1]); w.y = pk2(v0[2], v0[3]); w.z = pk2(v1[0], v1[1]); w.w = pk2(v1[2], v1[3]);
                    *(u32x4*)(rowp + bj * 128) = w; } }
    }
};
struct EpiB {
    static constexpr bool PERM = true, AFTER_DRAIN = false; static constexpr int NSEG = 1;
    const bf16_t *HF, *HB, *ON; u8_t* ws;
    __device__ __forceinline__ void operator()(const f32x4 (&acc)[2][2][4][2], const Unit& u, int wr, int wc, int fr, int fq) const {
        const int pn = u.pn, row0 = u.pm * 256 + wr * 64 + fr, col0 = (pn & 3) * 256 + wc * 32 + 8 * fq, colw = (pn & 3) * 256 + wide_col(wc, fq);
        constexpr unsigned long long DST_MIB = (unsigned long long)(OFF_YL8 >> 20) | ((unsigned long long)(OFF_YG8 >> 20) << 16) | ((unsigned long long)(OFF_SGL8 >> 20) << 32) | ((unsigned long long)(OFF_SGG8 >> 20) << 48);
        u8_t* dst = ws + ((size_t)((DST_MIB >> (16 * (pn >> 2))) & 0xffffull) << 20);
#pragma unroll
        for (int ai = 0; ai < 2; ++ai) {
            u32x4 l0[4][2], l1[4][2];
            if (pn < 8) {
#pragma unroll
                for (int m = 0; m < 4; ++m)
#pragma unroll
                    for (int bj = 0; bj < 2; ++bj) { const size_t o = (size_t)(row0 + ai * 128 + m * 16) * 1024 + col0 + bj * 128;
                        if (pn < 4) { l0[m][bj] = *(const u32x4*)(HF + o); l1[m][bj] = *(const u32x4*)(HB + o); } else l0[m][bj] = *(const u32x4*)(ON + o); }
            }
#pragma unroll
            for (int m = 0; m < 4; ++m) { u32x2 res[2];
#pragma unroll
                for (int bj = 0; bj < 2; ++bj) { const f32x4 v0 = acc[ai][bj][m][0], v1 = acc[ai][bj][m][1]; float a[8] = {v0[0], v0[1], v0[2], v0[3], v1[0], v1[1], v1[2], v1[3]}; float y[8];
                    if (pn < 4) { const u32x4 hf = l0[m][bj], hb = l1[m][bj]; const unsigned hw[4] = {hf.x, hf.y, hf.z, hf.w}, gw[4] = {hb.x, hb.y, hb.z, hb.w};
#pragma unroll
                        for (int j = 0; j < 4; ++j) { y[2 * j] = (bf_lo(hw[j]) + bf_lo(gw[j])) * (ACT_S * gelu_tanh(a[2 * j])); y[2 * j + 1] = (bf_hi(hw[j]) + bf_hi(gw[j])) * (ACT_S * gelu_tanh(a[2 * j + 1])); }
                        res[bj] = (u32x2){pk4_f8(y[0], y[1], y[2], y[3]), pk4_f8(y[4], y[5], y[6], y[7])}; }
                    else if (pn < 8) { const u32x4 on = l0[m][bj]; const unsigned hw[4] = {on.x, on.y, on.z, on.w};
#pragma unroll
                        for (int j = 0; j < 4; ++j) { y[2 * j] = bf_lo(hw[j]) * (ACT_S * siluf_(a[2 * j])); y[2 * j + 1] = bf_hi(hw[j]) * (ACT_S * siluf_(a[2 * j + 1])); }
                        res[bj] = (u32x2){pk4_f8(y[0], y[1], y[2], y[3]), pk4_f8(y[4], y[5], y[6], y[7])}; }
                    else {
#pragma unroll
                        for (int j = 0; j < 8; ++j) y[j] = fmaxf(255.f * sigmoidf_(a[j]), 1.f);
                        res[bj] = (u32x2){pk4_u8(y[0], y[1], y[2], y[3]), pk4_u8(y[4], y[5], y[6], y[7])}; }
                }
                const u32x4 w = wide_pack(res[0], res[1]); const size_t ow = (size_t)(row0 + ai * 128 + m * 16) * 1024 + colw;
                *(u32x4*)(dst + ow) = w; }
            asm volatile("" ::: "memory"); }
    }
};
template <int SECOND> struct EpiM {
    static constexpr bool PERM = true, AFTER_DRAIN = false; static constexpr int NSEG = 1;
    const u8_t* G; bf16_t* M1; u8_t* MM;
    __device__ __forceinline__ void operator()(const f32x4 (&acc)[2][2][4][2], const Unit& u, int wr, int wc, int fr, int fq) const {
        const int row0 = u.pm * 256 + wr * 64 + fr, col0 = u.pn * 256 + wc * 32 + 8 * fq;
#pragma unroll
        for (int ai = 0; ai < 2; ++ai) {
            u32x2 gl[4][2]; u32x4 pl[4][2];
#pragma unroll
            for (int m = 0; m < 4; ++m)
#pragma unroll
                for (int bj = 0; bj < 2; ++bj) { const size_t o = (size_t)(row0 + ai * 128 + m * 16) * 1024 + col0 + bj * 128; gl[m][bj] = *(const u32x2*)(G + o); if (SECOND) pl[m][bj] = *(const u32x4*)(M1 + o); }
#pragma unroll
            for (int m = 0; m < 4; ++m) { const size_t off = (size_t)(row0 + ai * 128 + m * 16) * 1024 + col0;
#pragma unroll
                for (int bj = 0; bj < 2; ++bj) { const f32x4 v0 = acc[ai][bj][m][0], v1 = acc[ai][bj][m][1]; const float a[8] = {v0[0], v0[1], v0[2], v0[3], v1[0], v1[1], v1[2], v1[3]}; float y[8];
                    const size_t o = off + bj * 128; const u32x2 g = gl[m][bj];
                    const float gf[8] = {ub0(g.x), ub1(g.x), ub2(g.x), ub3(g.x), ub0(g.y), ub1(g.y), ub2(g.y), ub3(g.y)};
                    if (SECOND) { const u32x4 p1 = pl[m][bj]; const unsigned pw[4] = {p1.x, p1.y, p1.z, p1.w};
#pragma unroll
                        for (int j = 0; j < 4; ++j) { y[2 * j] = ACT_S * bf_lo(pw[j]) + (ACT_S / 255.f) * gf[2 * j] * a[2 * j]; y[2 * j + 1] = ACT_S * bf_hi(pw[j]) + (ACT_S / 255.f) * gf[2 * j + 1] * a[2 * j + 1]; }
                        *(u32x2*)(MM + o) = (u32x2){pk4_f8(y[0], y[1], y[2], y[3]), pk4_f8(y[4], y[5], y[6], y[7])}; }
                    else {
#pragma unroll
                        for (int j = 0; j < 8; ++j) y[j] = (1.f / 255.f) * gf[j] * a[j];
                        u32x4 w; w.x = pk2(y[0], y[1]); w.y = pk2(y[2], y[3]); w.z = pk2(y[4], y[5]); w.w = pk2(y[6], y[7]); *(u32x4*)(M1 + o) = w; } } }
            asm volatile("" ::: "memory"); }
    }
};
struct EpiMM {
    static constexpr bool PERM = true, AFTER_DRAIN = false; static constexpr int NSEG = 2;
    const u8_t *GL, *GG; u8_t* MM;
    __device__ __forceinline__ void mid(f32x4 (&acc)[2][2][4][2], const Unit& u, int wr, int wc, int fr, int fq) const {
        const int row0 = u.pm * 256 + wr * 64 + fr, colw = u.pn * 256 + wide_col(wc, fq);
#pragma unroll
        for (int ai = 0; ai < 2; ++ai)
#pragma unroll
            for (int mh = 0; mh < 2; ++mh) {
                u32x4 gl[2], gg[2];
#pragma unroll
                for (int mm = 0; mm < 2; ++mm) { const size_t o = (size_t)(row0 + ai * 128 + (2 * mh + mm) * 16) * 1024 + colw; gl[mm] = *(const u32x4*)(GL + o); gg[mm] = *(const u32x4*)(GG + o); }
#pragma unroll
                for (int mm = 0; mm < 2; ++mm) { const int m = 2 * mh + mm; u32x2 a2[2], g2[2]; wide_unpack(gl[mm], a2[0], a2[1]); wide_unpack(gg[mm], g2[0], g2[1]);
#pragma unroll
                    for (int bj = 0; bj < 2; ++bj) { const u32x2 a = a2[bj], g = g2[bj];
                        acc[ai][bj][m][0] *= (f32x4){ub0(a.x) * __builtin_amdgcn_rcpf(ub0(g.x)), ub1(a.x) * __builtin_amdgcn_rcpf(ub1(g.x)), ub2(a.x) * __builtin_amdgcn_rcpf(ub2(g.x)), ub3(a.x) * __builtin_amdgcn_rcpf(ub3(g.x))};
                        acc[ai][bj][m][1] *= (f32x4){ub0(a.y) * __builtin_amdgcn_rcpf(ub0(g.y)), ub1(a.y) * __builtin_amdgcn_rcpf(ub1(g.y)), ub2(a.y) * __builtin_amdgcn_rcpf(ub2(g.y)), ub3(a.y) * __builtin_amdgcn_rcpf(ub3(g.y))}; } }
                asm volatile("" ::: "memory"); }
    }
    __device__ __forceinline__ void operator()(const f32x4 (&acc)[2][2][4][2], const Unit& u, int wr, int wc, int fr, int fq) const {
        const int row0 = u.pm * 256 + wr * 64 + fr, colw = u.pn * 256 + wide_col(wc, fq);
#pragma unroll
        for (int ai = 0; ai < 2; ++ai) {
            u32x4 gg[4];
#pragma unroll
            for (int m = 0; m < 4; ++m) gg[m] = *(const u32x4*)(GG + (size_t)(row0 + ai * 128 + m * 16) * 1024 + colw);
#pragma unroll
            for (int m = 0; m < 4; ++m) { u32x2 g2[2], res[2]; wide_unpack(gg[m], g2[0], g2[1]); const float s = ACT_S / 255.f;
#pragma unroll
                for (int bj = 0; bj < 2; ++bj) { const u32x2 g = g2[bj]; const f32x4 v0 = acc[ai][bj][m][0], v1 = acc[ai][bj][m][1];
                    res[bj] = (u32x2){pk4_f8(s * ub0(g.x) * v0[0], s * ub1(g.x) * v0[1], s * ub2(g.x) * v0[2], s * ub3(g.x) * v0[3]), pk4_f8(s * ub0(g.y) * v1[0], s * ub1(g.y) * v1[1], s * ub2(g.y) * v1[2], s * ub3(g.y) * v1[3])}; }
                *(u32x4*)(MM + (size_t)(row0 + ai * 128 + m * 16) * 1024 + colw) = wide_pack(res[0], res[1]); }
            asm volatile("" ::: "memory"); }
    }
};
__device__ __forceinline__ bf16_t* h_row(float* out, unsigned char* ws, int r) { return r < NL ? (bf16_t*)((unsigned char*)out + (size_t)r * 4096 + 2048) : (bf16_t*)(ws + OFF_HC) + (size_t)(r - NL) * 1024; }
struct EpiOut {
    static constexpr bool PERM = true, AFTER_DRAIN = false; static constexpr int NSEG = 1;
    const float *inL, *inC; float* out; unsigned char* ws; const float* mod; int layer;
    template <int LAYER> __device__ __forceinline__ void body(const f32x4 (&acc)[2][2][4][2], const Unit& u, int wr, int wc, int fr, int fq) const {
        const bool lat = u.pm < 128; const int row0 = u.pm * 256 + wr * 64 + fr, col0 = u.pn * 256 + wc * 32 + 8 * fq;
        const float* g1 = mod + (size_t)(lat ? (u.pm >> 3) : 16) * 6144 + 2048 + col0;
        f32x4 gv[2][2];
#pragma unroll
        for (int bj = 0; bj < 2; ++bj) { gv[bj][0] = *(const f32x4*)(g1 + bj * 128); gv[bj][1] = *(const f32x4*)(g1 + bj * 128 + 4); }
        if constexpr (LAYER == 0) {
#pragma unroll
            for (int ai = 0; ai < 2; ++ai)
#pragma unroll
                for (int mh = 0; mh < 2; ++mh) {
                    f32x4 h0[2][2], h1[2][2];
#pragma unroll
                    for (int mm = 0; mm < 2; ++mm)
#pragma unroll
                        for (int bj = 0; bj < 2; ++bj) { const int r = row0 + ai * 128 + (2 * mh + mm) * 16; const float* src = (lat ? inL + (size_t)r * 1024 : inC + (size_t)(r - NL) * 1024) + col0 + bj * 128; h0[mm][bj] = *(const f32x4*)src; h1[mm][bj] = *(const f32x4*)(src + 4); }
#pragma unroll
                    for (int mm = 0; mm < 2; ++mm) { const int m = 2 * mh + mm, r = row0 + ai * 128 + m * 16; bf16_t* hr = h_row(out, ws, r) + col0;
#pragma unroll
                        for (int bj = 0; bj < 2; ++bj) { const f32x4 y0 = h0[mm][bj] + gv[bj][0] * acc[ai][bj][m][0], y1 = h1[mm][bj] + gv[bj][1] * acc[ai][bj][m][1];
                            u32x4 o; o.x = pk2(y0[0], y0[1]); o.y = pk2(y0[2], y0[3]); o.z = pk2(y1[0], y1[1]); o.w = pk2(y1[2], y1[3]); *(u32x4*)(hr + bj * 128) = o; } }
                    asm volatile("" ::: "memory"); }
        } else {
#pragma unroll
            for (int ai = 0; ai < 2; ++ai) {
                u32x4 hw[4][2];
#pragma unroll
                for (int m = 0; m < 4; ++m)
#pragma unroll
                    for (int bj = 0; bj < 2; ++bj) hw[m][bj] = *(const u32x4*)(h_row(out, ws, row0 + ai * 128 + m * 16) + col0 + bj * 128);
#pragma unroll
                for (int m = 0; m < 4; ++m) { bf16_t* hr = h_row(out, ws, row0 + ai * 128 + m * 16) + col0;
#pragma unroll
                    for (int bj = 0; bj < 2; ++bj) { const u32x4 w = hw[m][bj];
                        const f32x4 y0 = (f32x4){bf_lo(w.x), bf_hi(w.x), bf_lo(w.y), bf_hi(w.y)} + gv[bj][0] * acc[ai][bj][m][0], y1 = (f32x4){bf_lo(w.z), bf_hi(w.z), bf_lo(w.w), bf_hi(w.w)} + gv[bj][1] * acc[ai][bj][m][1];
                        u32x4 o; o.x = pk2(y0[0], y0[1]); o.y = pk2(y0[2], y0[3]); o.z = pk2(y1[0], y1[1]); o.w = pk2(y1[2], y1[3]); *(u32x4*)(hr + bj * 128) = o; } }
                asm volatile("" ::: "memory"); }
        }
    }
    __device__ __forceinline__ void operator()(const f32x4 (&acc)[2][2][4][2], const Unit& u, int wr, int wc, int fr, int fq) const {
        if (layer == 0) body<0>(acc, u, wr, wc, fr, fq); else body<1>(acc, u, wr, wc, fr, fq);
    }
};
struct EpiSc {
    static constexpr bool PERM = true, AFTER_DRAIN = false; static constexpr int NSEG = 1;
    bf16_t* SC;
    __device__ __forceinline__ void operator()(const f32x4 (&acc)[2][2][4][2], const Unit& u, int wr, int wc, int fr, int fq) const {
        const int row0 = u.pm * 256 + wr * 64 + fr, col0 = u.pn * 256 + wc * 32 + 8 * fq;
#pragma unroll
        for (int ai = 0; ai < 2; ++ai)
#pragma unroll
            for (int m = 0; m < 4; ++m) { bf16_t* rowp = SC + (size_t)(row0 + ai * 128 + m * 16) * 2048 + col0;
#pragma unroll
                for (int bj = 0; bj < 2; ++bj) { const f32x4 v0 = acc[ai][bj][m][0], v1 = acc[ai][bj][m][1]; u32x4 w; w.x = pk2(v0[0], v0[1]); w.y = pk2(v0[2], v0[3]); w.z = pk2(v1[0], v1[1]); w.w = pk2(v1[2], v1[3]);
                    *(u32x4*)(rowp + bj * 128) = w; } }
    }
};
#define XB_TMO      128
#define XB_XCNT(j)  (256  + 64 * (j))
#define XB_XSUB(j)  (1280 + 64 * (j))
#define XB_XGEN(j)  (2304 + 64 * (j))
#define XB_TOP      3328
#define XB_TOPGEN   3392
#define XCD_BAR_WORDS 3456
#define XB_SPIN_CAP (1u << 18)

__device__ __forceinline__ unsigned xb_ld(unsigned* p)              { return __hip_atomic_load(p, __ATOMIC_RELAXED, __HIP_MEMORY_SCOPE_AGENT); }
__device__ __forceinline__ unsigned xb_add(unsigned* p, unsigned v) { return __hip_atomic_fetch_add(p, v, __ATOMIC_RELAXED, __HIP_MEMORY_SCOPE_AGENT); }
__device__ __forceinline__ unsigned xb_xcc_id() { return (unsigned)__builtin_amdgcn_s_getreg((3 << 11) | 20) & 0xFu; }
#define XB_SPIN(cond, bar) do { unsigned _sp = 0; while (cond) { __builtin_amdgcn_s_sleep(1); \
    if ((++_sp & 255u) == 0u) { if (xb_ld(&(bar)[XB_TMO])) break; if (_sp > XB_SPIN_CAP) { atomicAdd(&(bar)[XB_TMO], 1u); break; } } } } while (0)

struct XcdBarrier {
    unsigned* bar; unsigned x;
    volatile LAS unsigned* st;
};

__device__ __forceinline__ XcdBarrier xcd_barrier_post(unsigned* bar, volatile LAS unsigned* st) {
    XcdBarrier b; b.bar = bar; b.x = xb_xcc_id(); b.st = st;
    if (threadIdx.x == 0) (void)xb_add(&bar[XB_XCNT(b.x)], 1u);
    return b;
}
__device__ __forceinline__ void xcd_barrier_complete(unsigned* bar, unsigned x, unsigned& nloc, unsigned& nx) {
    const unsigned G = gridDim.x * gridDim.y * gridDim.z;
    unsigned sum, cnt, mine, sp = 0u;
    for (;;) {
        sum = 0u; cnt = 0u; mine = 0u;
#pragma unroll
        for (unsigned j = 0; j < 16; ++j) { const unsigned c = xb_ld(&bar[XB_XCNT(j)]); sum += c; cnt += (c > 0u) ? 1u : 0u; mine = (j == x) ? c : mine; }
        if (sum == G) break;
        __builtin_amdgcn_s_sleep(1);
        if ((++sp & 255u) == 0u) { if (xb_ld(&bar[XB_TMO])) break; if (sp > XB_SPIN_CAP) { atomicAdd(&bar[XB_TMO], 1u); break; } }
    }
    nloc = mine > 0u ? mine : 1u; nx = cnt > 0u ? cnt : 1u;
}

__device__ __forceinline__ void xcd_barrier(const XcdBarrier& b) {
    asm volatile("s_waitcnt vmcnt(0)" ::: "memory");
    __syncthreads();
    if (threadIdx.x == 0) {
        unsigned* bar = b.bar;
        __builtin_amdgcn_s_waitcnt(0);
        unsigned nloc = b.st[0], nx = b.st[1];
        if (nloc == 0u) { xcd_barrier_complete(bar, b.x, nloc, nx); b.st[0] = nloc; b.st[1] = nx; }
        const unsigned old = xb_add(&bar[XB_XSUB(b.x)], 1u);
        const unsigned gen = old / nloc;
        if (old + 1u == (gen + 1u) * nloc) {
            __builtin_amdgcn_fence(__ATOMIC_RELEASE, "agent");
            asm volatile("s_waitcnt vmcnt(0)" ::: "memory");
            const unsigned og = xb_add(&bar[XB_TOP], 1u);
            const unsigned tg = og / nx;
            if (og + 1u == (tg + 1u) * nx) xb_add(&bar[XB_TOPGEN], 1u);
            else XB_SPIN(xb_ld(&bar[XB_TOPGEN]) == tg, bar);
            __builtin_amdgcn_fence(__ATOMIC_ACQUIRE, "agent");
            xb_add(&bar[XB_XGEN(b.x)], 1u);
            asm volatile("s_waitcnt vmcnt(0)" ::: "memory");
        } else {
            XB_SPIN(xb_ld(&bar[XB_XGEN(b.x)]) == gen, bar);
            __builtin_amdgcn_fence(__ATOMIC_ACQUIRE, "agent");
            asm volatile("s_waitcnt vmcnt(0)" ::: "memory");
        }
    }
    __syncthreads();
}
__device__ __forceinline__ void transpose_item(const float* W, int N, u8_t* WT, int drow, int k0, int n0, LAS float* scr, int lane) {
    float tv[32];
    const float* Wl = W + (size_t)(k0 + (lane >> 5)) * N + n0 + (lane & 31);
#pragma unroll
    for (int i = 0; i < 32; ++i) tv[i] = Wl[(size_t)(2 * i) * N];
    __builtin_amdgcn_sched_barrier(0);
#pragma unroll
    for (int i = 0; i < 32; ++i) scr[(2 * i + (lane >> 5)) * 33 + (lane & 31)] = tv[i];
    LDS_FENCE();
    const int c = lane & 7;
#pragma unroll
    for (int j = 0; j < 4; ++j) { const int n = (lane >> 3) + 8 * j; const LAS float* s = scr + (8 * c) * 33 + n;
        u32x2 o; o.x = pk4_f8(WGT_S * s[0 * 33], WGT_S * s[1 * 33], WGT_S * s[2 * 33], WGT_S * s[3 * 33]); o.y = pk4_f8(WGT_S * s[4 * 33], WGT_S * s[5 * 33], WGT_S * s[6 * 33], WGT_S * s[7 * 33]);
        *(u32x2*)(WT + (size_t)(drow + n) * 1024 + k0 + 8 * c) = o; }
    LDS_FENCE();
}
__device__ __forceinline__ void prep_phase(CPP p, LAS unsigned char* lds, int tid, int lane, int wave) {
    unsigned char* ws = p->ws;
    const int gw = blockIdx.x * 8 + wave, NGW = gridDim.x * 8;
    {
        LAS float* sc = (LAS float*)(lds + 69632);
        LAS float* red = (LAS float*)lds;
        for (int e = tid; e < 17 * 1024; e += 512) { const int r = e >> 10, k = e & 1023; const float c = r < 16 ? p->in[1][r * 1024 + k] : p->in[3][k]; sc[e] = siluf_(c); }
        __syncthreads();
        float* MOD = (float*)(ws + OFF_MOD);
        for (int it = blockIdx.x; it < 192; it += gridDim.x) {
            const int l = it / 96, n0 = (it % 96) * 64, kr = lane >> 4, c4 = (lane & 15) * 4;
            f32x4 acc[17];
#pragma unroll
            for (int r = 0; r < 17; ++r) acc[r] = (f32x4){0.f, 0.f, 0.f, 0.f};
            const float* wm = p->in[4] + ((size_t)l * 1024 + wave * 128 + kr) * 6144 + n0 + c4;
            const LAS float* scw = sc + wave * 128 + kr;
#pragma nounroll
            for (int j0 = 0; j0 < 32; j0 += 16) {
                f32x4 wv[16];
#pragma unroll
                for (int j = 0; j < 16; ++j) wv[j] = *(const f32x4*)(wm + (size_t)(j0 + j) * 4 * 6144);
                __builtin_amdgcn_sched_barrier(0);
#pragma unroll
                for (int j = 0; j < 16; ++j) { const f32x4 w = wv[j];
#pragma unroll
                    for (int r = 0; r < 17; ++r) { const float s = scw[r * 1024 + (j0 + j) * 4]; acc[r][0] += s * w[0]; acc[r][1] += s * w[1]; acc[r][2] += s * w[2]; acc[r][3] += s * w[3]; } }
            }
#pragma unroll
            for (int r = 0; r < 17; ++r) {
#pragma unroll
                for (int c = 0; c < 4; ++c) { float v = acc[r][c]; v += __shfl_xor(v, 16); v += __shfl_xor(v, 32); acc[r][c] = v; } }
            if (kr == 0) {
#pragma unroll
                for (int r = 0; r < 17; ++r) *(LAS f32x4*)(red + (wave * 17 + r) * 64 + c4) = acc[r]; }
            __syncthreads();
            for (int e = tid; e < 17 * 64; e += 512) { const int r = e >> 6, nn = e & 63; float s = p->in[5][l * 6144 + n0 + nn];
#pragma unroll
                for (int w = 0; w < 8; ++w) s += red[(w * 17 + r) * 64 + nn];
                MOD[((size_t)l * 17 + r) * 6144 + n0 + nn] = s; }
            __syncthreads();
        }
    }
    LAS float* scr = (LAS float*)(lds + wave * 8448);
    for (int it2 = gw; it2 < 2 * 5136; it2 += NGW) {
        const int layer = it2 >= 5136, it = it2 - layer * 5136;
        u8_t* WA = ws + off_wa(layer); u8_t* WB = ws + off_wb(layer);
        const float* W; int N, kb, nb, drow; u8_t* WT;
        if (it < 3600) { kb = it / 225; nb = it % 225; W = p->in[8] + (size_t)layer * 1024 * 7200; N = 7200; const int n0 = nb * 32;
            if (n0 < 1024) { WT = WA; drow = n0; }
            else if (n0 < 2048) { WT = WB; drow = n0 - 1024; }
            else if (n0 < 2560) { WT = WA; drow = 1024 + (n0 - 2048); }
            else if (n0 < 3072) { WT = WA; drow = 1536 + (n0 - 2560); }
            else if (n0 < 4096) { WT = WA; drow = 2048 + (n0 - 3072); }
            else if (n0 < 5120) { WT = WB; drow = 1024 + (n0 - 4096); }
            else if (n0 < 5152) { WT = WA; drow = 3072; }
            else if (n0 < 6176) { WT = WB; drow = 2048 + (n0 - 5152); }
            else { WT = WB; drow = 3072 + (n0 - 6176); }
        } else { int r = it - 3600; const int mi = r / 512; r %= 512; kb = r / 32; nb = r % 32; N = 1024; W = p->in[19 + mi] + (size_t)layer * 1024 * 1024; WT = ws + off_wbl(layer, mi); drow = nb * 32; }
        transpose_item(W, N, WT, drow, kb * 64, nb * 32, scr, lane);
    }
    for (int i = blockIdx.x * 512 + tid; i < 2 * 224 * 1024 / 16; i += gridDim.x * 512) { const int l = i >= 224 * 1024 / 16; ((u32x4*)(ws + off_wa(l) + (size_t)3104 * 1024))[i - l * (224 * 1024 / 16)] = (u32x4){0u, 0u, 0u, 0u}; }
    for (int e2 = blockIdx.x * 512 + tid; e2 < 2 * 32768; e2 += gridDim.x * 512) {
        const int layer = e2 >> 15, e = e2 & 32767;
        const int i8 = e & 7, j = (e >> 3) & 63, hb = (e >> 9) & 15, gate = (e >> 13) & 1, dir = e >> 14;
        const float* src = p->in[gate ? 13 : 11] + ((size_t)((layer * 2 + dir) * 16 + hb) * 64 + i8 * 8) * 64 + j;
        float gv[8];
#pragma unroll
        for (int q = 0; q < 8; ++q) gv[q] = src[64 * q];
        __builtin_amdgcn_sched_barrier(0);
        u32x4 o; o.x = pk2(gv[0], gv[1]); o.y = pk2(gv[2], gv[3]); o.z = pk2(gv[4], gv[5]); o.w = pk2(gv[6], gv[7]);
        *(u32x4*)((bf16_t*)(ws + off_wg(layer)) + (size_t)e * 8) = o;
    }
    __syncthreads();
    LAS float* kl = (LAS float*)lds;
    LAS float* ql = (LAS float*)(lds + 67584);
    for (int w = blockIdx.x; w < 512; w += gridDim.x) {
        const int layer = w >> 8, hz = (w >> 4) & 15, ib = (w & 15) * 64, z = hz & 1;
        const float* wq = p->in[22] + (size_t)layer * 1024 * 2048 + (size_t)ib * 2048 + hz * 128; const float* keys = p->in[23] + (size_t)layer * 2 * 128 * 128 + (size_t)z * 128 * 128;
        f32x4 kv[8], qv[4];
#pragma unroll
        for (int e = 0; e < 8; ++e) { const int idx = tid + 512 * e; kv[e] = *(const f32x4*)(keys + (size_t)(idx >> 5) * 128 + (idx & 31) * 4); }
#pragma unroll
        for (int e = 0; e < 4; ++e) { const int idx = tid + 512 * e; qv[e] = *(const f32x4*)(wq + (size_t)(idx >> 5) * 2048 + (idx & 31) * 4); }
#pragma unroll
        for (int e = 0; e < 8; ++e) { const int idx = tid + 512 * e; *(LAS f32x4*)(kl + (idx >> 5) * 132 + (idx & 31) * 4) = kv[e]; }
#pragma unroll
        for (int e = 0; e < 4; ++e) { const int idx = tid + 512 * e; *(LAS f32x4*)(ql + (idx >> 5) * 128 + (idx & 31) * 4) = qv[e]; }
        __syncthreads();
        float a0[8], a1[8];
#pragma unroll
        for (int ii = 0; ii < 8; ++ii) { a0[ii] = 0.f; a1[ii] = 0.f; }
        const LAS float* kr0 = kl + lane * 132; const LAS float* kr1 = kr0 + 64 * 132; const LAS float* qr = ql + wave * 8 * 128;
#pragma unroll 4
        for (int d4 = 0; d4 < 32; ++d4) { const f32x4 k0 = *(const LAS f32x4*)(kr0 + 4 * d4), k1 = *(const LAS f32x4*)(kr1 + 4 * d4);
#pragma unroll
            for (int ii = 0; ii < 8; ++ii) { const f32x4 q = *(const LAS f32x4*)(qr + ii * 128 + 4 * d4);
                a0[ii] += q[0] * k0[0] + q[1] * k0[1] + q[2] * k0[2] + q[3] * k0[3]; a1[ii] += q[0] * k1[0] + q[1] * k1[1] + q[2] * k1[2] + q[3] * k1[3]; } }
        bf16_t* WSC = (bf16_t*)(ws + off_wsc(layer)); const int i0 = ib + wave * 8;
        u32x4 o; o.x = pk2(a0[0], a0[1]); o.y = pk2(a0[2], a0[3]); o.z = pk2(a0[4], a0[5]); o.w = pk2(a0[6], a0[7]); *(u32x4*)(WSC + (size_t)(hz * 128 + lane) * 1024 + i0) = o;
        o.x = pk2(a1[0], a1[1]); o.y = pk2(a1[2], a1[3]); o.z = pk2(a1[4], a1[5]); o.w = pk2(a1[6], a1[7]); *(u32x4*)(WSC + (size_t)(hz * 128 + 64 + lane) * 1024 + i0) = o;
        __syncthreads();
    }
}
__device__ __forceinline__ void norm_phase(CPP p, int layer, int which, int nrows, const float* HL, const float* HCp, int lane, int wave) {
    const int gw = blockIdx.x * 8 + wave, NGW = gridDim.x * 8;
    bf16_t* HN2 = (bf16_t*)(p->ws + OFF_HN2); u8_t* HN8 = p->ws + OFF_HN8; const float* MOD = (const float*)(p->ws + OFF_MOD) + (size_t)layer * 17 * 6144 + which * 3072; const float* gn = p->in[6 + which] + layer * 1024;
    if (which == 0) {
        for (int r0 = gw; r0 < nrows; r0 += 2 * NGW) {
            const bool two = r0 + NGW < nrows; const int rr[2] = {r0, two ? r0 + NGW : r0};
            f32x4 v[2][4]; float ss[2] = {0.f, 0.f};
#pragma unroll
            for (int q = 0; q < 2; ++q) { const int r = rr[q]; const float* src = r < NL ? HL + (size_t)r * 1024 : HCp + (size_t)(r - NL) * 1024;
#pragma unroll
                for (int j = 0; j < 4; ++j) v[q][j] = ((const f32x4*)src)[lane + 64 * j]; }
#pragma unroll
            for (int q = 0; q < 2; ++q)
#pragma unroll
                for (int j = 0; j < 4; ++j) ss[q] += v[q][j][0] * v[q][j][0] + v[q][j][1] * v[q][j][1] + v[q][j][2] * v[q][j][2] + v[q][j][3] * v[q][j][3];
            const float rstd[2] = {rsqrtf(wave_sum(ss[0]) * (1.f / 1024.f) + 1e-6f), rsqrtf(wave_sum(ss[1]) * (1.f / 1024.f) + 1e-6f)};
            unsigned o[2][4];
#pragma unroll
            for (int q = 0; q < 2; ++q) { const int r = rr[q]; const float* md = MOD + (size_t)(r < NL ? (r >> 11) : 16) * 6144;
#pragma unroll
                for (int j = 0; j < 4; ++j) { const f32x4 g = ((const f32x4*)gn)[lane + 64 * j], sh = ((const f32x4*)md)[lane + 64 * j], sc = ((const f32x4*)(md + 1024))[lane + 64 * j];
                    const f32x4 y = v[q][j] * rstd[q] * g * (sc + 1.f) + sh; o[q][j] = pk4_f8(ACT_S * y[0], ACT_S * y[1], ACT_S * y[2], ACT_S * y[3]); } }
#pragma unroll
            for (int j = 0; j < 4; ++j) ((unsigned*)(HN8 + (size_t)rr[0] * 1024))[lane + 64 * j] = o[0][j];
            if (two) {
#pragma unroll
                for (int j = 0; j < 4; ++j) ((unsigned*)(HN8 + (size_t)rr[1] * 1024))[lane + 64 * j] = o[1][j]; }
        }
    } else {
        for (int r0 = gw; r0 < nrows; r0 += 2 * NGW) {
            const bool two = r0 + NGW < nrows; const int rr[2] = {r0, two ? r0 + NGW : r0};
            u32x4 w[2][2]; float v[2][16], ss[2] = {0.f, 0.f};
#pragma unroll
            for (int q = 0; q < 2; ++q) { const u32x4* src = (const u32x4*)(h_row(p->out, p->ws, rr[q]) + 16 * lane); w[q][0] = src[0]; w[q][1] = src[1]; }
#pragma unroll
            for (int q = 0; q < 2; ++q) { const unsigned ww[8] = {w[q][0].x, w[q][0].y, w[q][0].z, w[q][0].w, w[q][1].x, w[q][1].y, w[q][1].z, w[q][1].w};
#pragma unroll
                for (int j = 0; j < 8; ++j) { v[q][2 * j] = bf_lo(ww[j]); v[q][2 * j + 1] = bf_hi(ww[j]); ss[q] += v[q][2 * j] * v[q][2 * j] + v[q][2 * j + 1] * v[q][2 * j + 1]; } }
            const float rstd[2] = {rsqrtf(wave_sum(ss[0]) * (1.f / 1024.f) + 1e-6f), rsqrtf(wave_sum(ss[1]) * (1.f / 1024.f) + 1e-6f)};
            u32x4 o[2][2]; unsigned hqd[2][4]; float tsv[2];
#pragma unroll
            for (int q = 0; q < 2; ++q) { const int r = rr[q]; const float* md = MOD + (size_t)(r < NL ? (r >> 11) : 16) * 6144 + 16 * lane; float y[16];
#pragma unroll
                for (int j = 0; j < 4; ++j) { const f32x4 g = ((const f32x4*)(gn + 16 * lane))[j], sh = ((const f32x4*)md)[j], sc = ((const f32x4*)(md + 1024))[j];
#pragma unroll
                    for (int i = 0; i < 4; ++i) y[4 * j + i] = v[q][4 * j + i] * rstd[q] * g[i] * (sc[i] + 1.f) + sh[i]; }
                o[q][0].x = pk2(y[0], y[1]); o[q][0].y = pk2(y[2], y[3]); o[q][0].z = pk2(y[4], y[5]); o[q][0].w = pk2(y[6], y[7]); o[q][1].x = pk2(y[8], y[9]); o[q][1].y = pk2(y[10], y[11]); o[q][1].z = pk2(y[12], y[13]); o[q][1].w = pk2(y[14], y[15]);
                float am = 0.f;
#pragma unroll
                for (int i = 0; i < 16; ++i) am = fmaxf(am, fabsf(y[i]));
                am = fmaxf(wave_max(am), 1e-20f); const float qs = 119.f * __builtin_amdgcn_rcpf(am);
#pragma unroll
                for (int t = 0; t < 2; ++t) { unsigned c0 = 0u, c1 = 0u;
#pragma unroll
                    for (int i = 0; i < 4; ++i) { c0 = __builtin_amdgcn_cvt_pk_u8_f32(__builtin_rintf(y[8 * t + i] * qs) + 136.f, (unsigned)i, c0); c1 = __builtin_amdgcn_cvt_pk_u8_f32(__builtin_rintf(y[8 * t + 4 + i] * qs) + 136.f, (unsigned)i, c1); }
                    hqd[q][t] = (((c0 >> 4) & 0x0f0f0f0fu) | (c1 & 0xf0f0f0f0u)) ^ 0x88888888u; hqd[q][2 + t] = ((c0 & 0x0f0f0f0fu) | ((c1 << 4) & 0xf0f0f0f0u)) ^ 0x88888888u; }
                tsv[q] = am * (1.f / (119.f * EU_S)); }
            { u32x4* d = (u32x4*)(HN2 + (size_t)rr[0] * 1024 + 16 * lane); d[0] = o[0][0]; d[1] = o[0][1]; }
            if (two) { u32x4* d = (u32x4*)(HN2 + (size_t)rr[1] * 1024 + 16 * lane); d[0] = o[1][0]; d[1] = o[1][1]; }
#pragma unroll
            for (int q = 0; q < 2; ++q) if (q == 0 || two) {
                unsigned char* hq = p->ws + OFF_HQ + (size_t)rr[q] * 1024 + (lane >> 2) * 64 + (lane & 3) * 8;
                *(u32x2*)hq = (u32x2){hqd[q][0], hqd[q][1]}; *(u32x2*)(hq + 32) = (u32x2){hqd[q][2], hqd[q][3]};
                if (lane == 0) ((float*)(p->ws + OFF_TS))[rr[q]] = tsv[q]; }
        }
    }
}
__device__ __forceinline__ int gla_row(int b, int dir, int s) {
    if (s < 256) return NL + b * 256 + (dir ? 255 - s : s);
    const int j = dir ? 2047 - (s - 256) : (s - 256);
    return b * 2048 + (j & 31) * 64 + (j >> 5);
}
__device__ __forceinline__ void gla_naive_phase(CPP p, int layer, LAS unsigned char* lds, int tid) {
    const bf16_t* Q = (const bf16_t*)(p->ws + 3 * SLOT); const bf16_t* K = Q + (size_t)NT * 512; const bf16_t* V = (const bf16_t*)(p->ws + 2 * SLOT); const bf16_t* F = (const bf16_t*)(p->ws + OFF_F);
    LAS float* sA = (LAS float*)lds; LAS float* sK = sA + 512; LAS float* sQ = sK + 512; LAS float* sO = sQ + 512;
    const int tt = tid >> 7, dkk = tid & 127, dv = tid & 255, half = tid >> 8;
    for (int item = blockIdx.x; item < 128; item += gridDim.x) {
        const int b = item >> 3, h = (item >> 1) & 3, dir = item & 1;
        bf16_t* O = (bf16_t*)(p->ws + (size_t)(4 + dir) * SLOT);
        const float* wf = p->in[16] + ((size_t)(layer * 2 + dir) * 16) * 512 + h * 128 + dkk; const float bfv = p->in[17][(layer * 2 + dir) * 512 + h * 128 + dkk];
        float wfr[16];
#pragma unroll
        for (int j = 0; j < 16; ++j) wfr[j] = wf[j * 512];
        float S[64];
#pragma unroll
        for (int i = 0; i < 64; ++i) S[i] = 0.f;
        for (int s4 = 0; s4 < 576; ++s4) {
            { const int r = gla_row(b, dir, s4 * 4 + tt);
              const u32x4* fp = (const u32x4*)(F + (size_t)r * 32 + dir * 16); const u32x4 f0 = fp[0], f1 = fp[1]; const unsigned fw[8] = {f0.x, f0.y, f0.z, f0.w, f1.x, f1.y, f1.z, f1.w};
              float z = bfv;
#pragma unroll
              for (int j = 0; j < 8; ++j) z += bf_lo(fw[j]) * wfr[2 * j] + bf_hi(fw[j]) * wfr[2 * j + 1];
              const float lg = (fminf(z, 0.f) - log1pf(__expf(-fabsf(z)))) * (1.f / 16.f);
              sA[tid] = __expf(lg); sK[tid] = bf2f(K[(size_t)r * 512 + h * 128 + dkk]); sQ[tid] = bf2f(Q[(size_t)r * 512 + h * 128 + dkk]); }
            __syncthreads();
#pragma unroll
            for (int t4 = 0; t4 < 4; ++t4) { const int r = gla_row(b, dir, s4 * 4 + t4); const float v = bf2f(V[(size_t)r * 1024 + h * 256 + dv]); float op = 0.f;
#pragma unroll
                for (int i = 0; i < 64; ++i) { const int dk = t4 * 128 + half * 64 + i; S[i] = sA[dk] * S[i] + sK[dk] * v; op += sQ[dk] * S[i]; }
                sO[(t4 * 2 + half) * 256 + dv] = op; }
            __syncthreads();
            for (int e = tid; e < 1024; e += 512) { const int t4 = e >> 8, d = e & 255; const int r = gla_row(b, dir, s4 * 4 + t4); O[(size_t)r * 1024 + h * 256 + d] = f2bf(sO[(t4 * 2) * 256 + d] + sO[(t4 * 2 + 1) * 256 + d]); }
        }
        __syncthreads();
    }
}
typedef short s16x4 __attribute__((ext_vector_type(4)));
__device__ __forceinline__ bf16x8_t bits8(u32x4 v) { return __builtin_bit_cast(bf16x8_t, v); }
__device__ __forceinline__ bf16x8_t tr8(const LAS unsigned char* p0, const LAS unsigned char* p1) {
    const s16x4 a = __builtin_amdgcn_ds_read_tr16_b64_v4i16((LAS s16x4*)p0), b = __builtin_amdgcn_ds_read_tr16_b64_v4i16((LAS s16x4*)p1);
    return __builtin_shufflevector(a, b, 0, 1, 2, 3, 4, 5, 6, 7);
}
template <int CTRL> __device__ __forceinline__ float dppz(float v) { return __int_as_float(__builtin_amdgcn_update_dpp(0, __float_as_int(v), CTRL, 0xf, 0xf, true)); }
__device__ __forceinline__ float wave_incl_scan(float v) {
    v += dppz<0x111>(v); v += dppz<0x112>(v); v += dppz<0x114>(v); v += dppz<0x118>(v);
    v += __int_as_float(__builtin_amdgcn_update_dpp(0, __float_as_int(v), 0x142, 0xa, 0xf, false));
    v += __int_as_float(__builtin_amdgcn_update_dpp(0, __float_as_int(v), 0x143, 0xc, 0xf, false));
    return v;
}
__device__ __forceinline__ void gla_phase(CPP p, int layer, LAS unsigned char* lds, int tid, int lane, int wave, int mode = 0) {
    const bf16_t* Q = (const bf16_t*)(p->ws + 3 * SLOT); const bf16_t* K = Q + (size_t)NT * 512; const bf16_t* V = (const bf16_t*)(p->ws + 2 * SLOT); const bf16_t* F = (const bf16_t*)(p->ws + OFF_F);
    LAS unsigned char* ATT = lds + 108544;
    LAS unsigned char* OST = lds + 117760;
    LAS float* GL = (LAS float*)(lds + 135168);
    LAS float* WFL = (LAS float*)(lds + 136192);
    LAS float* BFL = (LAS float*)(lds + 144384);
    const int l15 = lane & 15, g4 = lane >> 4;
    for (int item = blockIdx.x; item < 256; item += gridDim.x) {
        const int b = (item & 63) >> 2, h = item & 3, dir = item >> 7, dvh = (item >> 6) & 1;
        bf16_t* O = (bf16_t*)(p->ws + (size_t)(4 + dir) * SLOT);
        bf16x8_t afr; f32x4 bias4;
        { u32x4 t4 = (u32x4){0u, 0u, 0u, 0u};
          if (g4 < 2) { const float* wp = p->in[16] + ((size_t)(layer * 2 + dir) * 16 + 8 * g4) * 512 + h * 128 + 16 * wave + l15;
              t4.x = pk2(wp[0], wp[512]); t4.y = pk2(wp[1024], wp[1536]); t4.z = pk2(wp[2048], wp[2560]); t4.w = pk2(wp[3072], wp[3584]); }
          afr = bits8(t4); bias4 = *(const f32x4*)(p->in[17] + (layer * 2 + dir) * 512 + h * 128 + 16 * wave + 4 * g4); }
        f32x4 Sacc[8];
#pragma unroll
        for (int i = 0; i < 8; ++i) Sacc[i] = (f32x4){0.f, 0.f, 0.f, 0.f};
        u32x4 pq[2], pk[2], pv[2], pf;
        const int sgn = dir ? -1 : 1; int rC[2], rL[2], chq = tid & 15; int rCf, rLf;
#pragma unroll
        for (int k = 0; k < 2; ++k) { const int j_ = (tid >> 4) + 32 * k; rC[k] = NL + b * 256 + (dir ? 255 - j_ : j_); rL[k] = b * 2048 + (dir ? (31 - (j_ & 31)) * 64 + 63 - (j_ >> 5) : (j_ & 31) * 64 + (j_ >> 5)); }
        { const int j_ = (tid >> 1) & 63; rCf = NL + b * 256 + (dir ? 255 - j_ : j_); rLf = b * 2048 + (dir ? (31 - (j_ & 31)) * 64 + 63 - (j_ >> 5) : (j_ & 31) * 64 + (j_ >> 5)); }
        const unsigned char* wsb = p->ws;
        const unsigned cQ = (unsigned)(3 * SLOT) + h * 256 + chq * 16, cK = cQ + (unsigned)NT * 1024u, cV = (unsigned)(2 * SLOT) + h * 512 + dvh * 256 + chq * 16, cO = (unsigned)((4 + dir) * SLOT) + h * 512 + dvh * 256 + chq * 16, cF = (unsigned)OFF_F + dir * 32 + (tid & 1) * 16;
#define GLA_ROW(c_, rc_, rl_) ((c_) < 4 ? (rc_) + sgn * 64 * (c_) : (rl_) + sgn * 2 * ((c_) - 4))
#define GLA_PREFETCH(c_) do { _Pragma("unroll") for (int k = 0; k < 2; ++k) { const unsigned r_ = (unsigned)GLA_ROW(c_, rC[k], rL[k]); \
            pq[k] = *(const u32x4*)(wsb + (size_t)(cQ + r_ * 1024u)); pk[k] = *(const u32x4*)(wsb + (size_t)(cK + r_ * 1024u)); pv[k] = *(const u32x4*)(wsb + (size_t)(cV + r_ * 2048u)); } \
        if (tid < 128) { const unsigned r_ = (unsigned)GLA_ROW(c_, rCf, rLf); pf = *(const u32x4*)(wsb + (size_t)(cF + r_ * 64u)); } } while (0)
#define GLA_STAGE(bufp) do { _Pragma("unroll") for (int k = 0; k < 2; ++k) { const int id_ = tid + 512 * k, j_ = id_ >> 4, ch_ = id_ & 15; *(LAS u32x4*)((bufp) + j_ * 272 + ch_ * 16) = pq[k]; *(LAS u32x4*)((bufp) + 17408 + j_ * 272 + ch_ * 16) = pk[k]; *(LAS u32x4*)((bufp) + 34816 + j_ * 272 + ch_ * 16) = pv[k]; } \
        if (tid < 128) *(LAS u32x4*)((bufp) + 52224 + tid * 16) = pf; } while (0)
#define GLA_GATES(bufp, glp) do { f32x4 zt_[4]; \
        _Pragma("unroll") for (int nt = 0; nt < 4; ++nt) { const bf16x8_t fb_ = *(const LAS bf16x8_t*)((bufp) + 52224 + (16 * nt + l15) * 32 + 16 * (g4 & 1)); zt_[nt] = __builtin_amdgcn_mfma_f32_16x16x32_bf16(afr, fb_, bias4, 0, 0, 0); } \
        float off_[4] = {0.f, 0.f, 0.f, 0.f}; float e_[4][4]; \
        _Pragma("unroll") for (int nt = 0; nt < 4; ++nt) { _Pragma("unroll") for (int r = 0; r < 4; ++r) { const float z_ = zt_[nt][r]; float lg_ = (fminf(z_, 0.f) * 1.4426950409f - __builtin_amdgcn_logf(1.f + __builtin_amdgcn_exp2f(fabsf(z_) * -1.4426950409f))) * 0.0625f;     \
                lg_ += dppz<0x111>(lg_); lg_ += dppz<0x112>(lg_); lg_ += dppz<0x114>(lg_); lg_ += dppz<0x118>(lg_); lg_ += off_[r]; \
                if (nt < 3) off_[r] = __int_as_float(__builtin_amdgcn_ds_bpermute((lane | 15) << 2, __float_as_int(lg_))); \
                e_[nt][r] = __builtin_amdgcn_exp2f(lg_); } } \
        if (l15 == 15) *(LAS f32x4*)((glp) + 16 * wave + 4 * g4) = (f32x4){e_[3][0], e_[3][1], e_[3][2], e_[3][3]}; \
        _Pragma("unroll") for (int nt = 0; nt < 4; ++nt) { LAS u32x2* qp_ = (LAS u32x2*)((bufp) + (16 * nt + l15) * 272 + (16 * wave + 4 * g4) * 2); LAS u32x2* kp_ = (LAS u32x2*)((bufp) + 17408 + (16 * nt + l15) * 272 + (16 * wave + 4 * g4) * 2); \
            const u32x2 qv_ = *qp_, kv_ = *kp_; u32x2 qo_, ko_; \
            qo_.x = pk2(bf_lo(qv_.x) * e_[nt][0], bf_hi(qv_.x) * e_[nt][1]); qo_.y = pk2(bf_lo(qv_.y) * e_[nt][2], bf_hi(qv_.y) * e_[nt][3]); \
            ko_.x = pk2(bf_lo(kv_.x) * __builtin_amdgcn_rcpf(e_[nt][0]), bf_hi(kv_.x) * __builtin_amdgcn_rcpf(e_[nt][1])); ko_.y = pk2(bf_lo(kv_.y) * __builtin_amdgcn_rcpf(e_[nt][2]), bf_hi(kv_.y) * __builtin_amdgcn_rcpf(e_[nt][3])); \
            *qp_ = qo_; *kp_ = ko_; } } while (0)
#define GLA_ATT(bufp) do { const int mt_ = wave >> 1; \
        _Pragma("unroll") for (int n2 = 0; n2 < 2; ++n2) { const int nt_ = 2 * (wave & 1) + n2; f32x4 a4_ = (f32x4){0.f, 0.f, 0.f, 0.f}; \
            if (nt_ <= mt_) { _Pragma("unroll") for (int ks = 0; ks < 4; ++ks) { const bf16x8_t a_ = *(const LAS bf16x8_t*)((bufp) + (16 * mt_ + l15) * 272 + ks * 64 + g4 * 16), bb_ = *(const LAS bf16x8_t*)((bufp) + 17408 + (16 * nt_ + l15) * 272 + ks * 64 + g4 * 16); \
                    a4_ = __builtin_amdgcn_mfma_f32_16x16x32_bf16(a_, bb_, a4_, 0, 0, 0); } } \
            _Pragma("unroll") for (int r = 0; r < 4; ++r) { const int t_ = 16 * mt_ + 4 * g4 + r, sx_ = 16 * nt_ + l15; *(LAS bf16_t*)(ATT + t_ * 144 + sx_ * 2) = f2bf(t_ >= sx_ ? a4_[r] : 0.f); } } } while (0)
        GLA_PREFETCH(0);
        __syncthreads();
        GLA_STAGE(lds);
        GLA_PREFETCH(1);
        __syncthreads();
        GLA_GATES(lds, GL);
        __syncthreads();
        GLA_ATT(lds);
        GLA_STAGE(lds + 54272);
        GLA_PREFETCH(2);
        __syncthreads();
        for (int c = 0; c < 36; ++c) {
            if (mode) { LAS unsigned char* cb2 = lds + (c & 1) * 54272; __syncthreads(); if (c + 2 < 36) GLA_STAGE(cb2); if (c + 3 < 36) GLA_PREFETCH(c + 3); __syncthreads(); continue; }
            LAS unsigned char* cb = lds + (c & 1) * 54272; LAS unsigned char* nb = lds + ((c + 1) & 1) * 54272;
            const LAS float* glc = GL + (c & 1) * 128;
            if (wave >= 4 && c + 1 < 36) GLA_GATES(nb, GL + ((c + 1) & 1) * 128);
            f32x4 oacc[4];
#pragma unroll
            for (int m = 0; m < 4; ++m) oacc[m] = (f32x4){0.f, 0.f, 0.f, 0.f};
#pragma unroll
            for (int ks = 0; ks < 4; ++ks) { u32x4 sb; sb.x = pk2(Sacc[2 * ks][0], Sacc[2 * ks][1]); sb.y = pk2(Sacc[2 * ks][2], Sacc[2 * ks][3]); sb.z = pk2(Sacc[2 * ks + 1][0], Sacc[2 * ks + 1][1]); sb.w = pk2(Sacc[2 * ks + 1][2], Sacc[2 * ks + 1][3]);
                const bf16x8_t bS = bits8(sb);
#pragma unroll
                for (int m = 0; m < 4; ++m) { const LAS unsigned char* ap = cb + (16 * m + l15) * 272 + (32 * ks + 4 * g4) * 2; const u32x2 lo = *(const LAS u32x2*)ap, hi = *(const LAS u32x2*)(ap + 32);
                    oacc[m] = __builtin_amdgcn_mfma_f32_16x16x32_bf16(bits8((u32x4){lo.x, lo.y, hi.x, hi.y}), bS, oacc[m], 0, 0, 0); } }
            bf16x8_t bV[2];
            { const int q_ = l15 >> 2, p_ = l15 & 3;
#pragma unroll
              for (int ks = 0; ks < 2; ++ks) { const LAS unsigned char* vp = cb + 34816 + (32 * ks + 8 * g4 + q_) * 272 + (16 * wave + 4 * p_) * 2; bV[ks] = tr8(vp, vp + 4 * 272); } }
#pragma unroll
            for (int ks = 0; ks < 2; ++ks)
#pragma unroll
                for (int m = 0; m < 4; ++m) if (2 * ks <= m) { const bf16x8_t a = *(const LAS bf16x8_t*)(ATT + (16 * m + l15) * 144 + ks * 64 + g4 * 16); oacc[m] = __builtin_amdgcn_mfma_f32_16x16x32_bf16(a, bV[ks], oacc[m], 0, 0, 0); }
#pragma unroll
            for (int m = 0; m < 4; ++m)
#pragma unroll
                for (int r = 0; r < 4; ++r) *(LAS bf16_t*)(OST + (16 * m + 4 * g4 + r) * 272 + (16 * wave + l15) * 2) = f2bf(oacc[m][r]);
            { const int q_ = l15 >> 2, p_ = l15 & 3;
#pragma unroll
              for (int ks = 0; ks < 2; ++ks)
#pragma unroll
                  for (int i = 0; i < 8; ++i) { const LAS unsigned char* kp = cb + 17408 + (32 * ks + 8 * g4 + q_) * 272 + (16 * i + 4 * p_) * 2; Sacc[i] = __builtin_amdgcn_mfma_f32_16x16x32_bf16(tr8(kp, kp + 4 * 272), bV[ks], Sacc[i], 0, 0, 0); } }
#pragma unroll
            for (int i = 0; i < 8; ++i) { const f32x4 gl = *(const LAS f32x4*)(glc + 16 * i + 4 * g4); Sacc[i] = Sacc[i] * gl; }
            if (wave < 4 && c + 1 < 36) GLA_GATES(nb, GL + ((c + 1) & 1) * 128);
            __syncthreads();
#pragma unroll
            for (int k = 0; k < 2; ++k) { const unsigned r_ = (unsigned)GLA_ROW(c, rC[k], rL[k]); *(u32x4*)(p->ws + (size_t)(cO + r_ * 2048u)) = *(const LAS u32x4*)(OST + ((tid >> 4) + 32 * k) * 272 + chq * 16); }
            if (c + 1 < 36) GLA_ATT(nb);
            if (c + 2 < 36) GLA_STAGE(cb);
            if (c + 3 < 36) GLA_PREFETCH(c + 3);
            __syncthreads();
        }
#undef GLA_PREFETCH
#undef GLA_ROW
#undef GLA_STAGE
#undef GLA_GATES
#undef GLA_ATT
    }
}
template <int DIR> __device__ __forceinline__ void lru_naive_item(CPP p, int layer, int b, int hb, int lane) {
    const int c = hb * 64 + lane;
    const bf16_t* X = (const bf16_t*)(p->ws + 1 * SLOT); bf16_t* Hd = (bf16_t*)(p->ws + (size_t)(DIR ? 2 : 3) * SLOT);
    const float* wa = p->in[11] + ((size_t)((layer * 2 + DIR) * 16 + hb) * 64) * 64 + lane; const float* wx = p->in[13] + ((size_t)((layer * 2 + DIR) * 16 + hb) * 64) * 64 + lane;
    float war[64], wxr[64];
#pragma unroll
    for (int i = 0; i < 64; ++i) { war[i] = wa[i * 64]; wxr[i] = wx[i * 64]; }
    const float ba = p->in[12][(layer * 2 + DIR) * 1024 + c], bx = p->in[14][(layer * 2 + DIR) * 1024 + c], lam = p->in[15][(layer * 2 + DIR) * 1024 + c];
    const float cl = -8.f * (fmaxf(-lam, 0.f) + log1pf(__expf(-fabsf(lam))));
    const float cw0 = p->in[9][(layer * 4 + 0) * 1024 + c], cw1 = p->in[9][(layer * 4 + 1) * 1024 + c], cw2 = p->in[9][(layer * 4 + 2) * 1024 + c], cw3 = p->in[9][(layer * 4 + 3) * 1024 + c], cb = p->in[10][layer * 1024 + c];
    float h = 0.f;
    for (int seg = 0; seg < 2; ++seg) {
        const int L = seg ? 2048 : 256; const size_t base = seg ? (size_t)b * 2048 : (size_t)NL + (size_t)b * 256;
        for (int ch = 0; ch < L / 16; ++ch) {
            const int tb = DIR ? L - 16 - ch * 16 : ch * 16;
            float xv[19];
#pragma unroll
            for (int j = 0; j < 19; ++j) { const int t = tb - 2 + j; xv[j] = (t >= 0 && t < L) ? bf2f(X[(base + t) * 1024 + c]) : 0.f; }
#pragma unroll
            for (int i = 0; i < 16; ++i) { const int q = DIR ? 15 - i : i;
                const float xr = cb + cw0 * xv[q] + cw1 * xv[q + 1] + cw2 * xv[q + 2] + cw3 * xv[q + 3];
                float ra = ba, ri = bx;
#pragma unroll
                for (int k = 0; k < 64; ++k) { const float xk = __int_as_float(__builtin_amdgcn_readlane(__float_as_int(xr), k)); ra += xk * war[k]; ri += xk * wxr[k]; }
                const float rg = sigmoidf_(ra), ig = sigmoidf_(ri), la = cl * rg, a = __expf(la), uu = sqrtf(fmaxf(-expm1f(2.f * la), 0.f)) * ig * xr;
                h = a * h + uu;
                Hd[(base + tb + q) * 1024 + c] = f2bf(h); }
        }
    }
}
__device__ __forceinline__ void lru_naive_phase(CPP p, int layer, int lane, int wave) {
    const int gw = wave * gridDim.x + blockIdx.x, NGW = gridDim.x * 8;
    for (int item = gw; item < 512; item += NGW) { const int b = item >> 5, hb = (item >> 1) & 15;
        if (item & 1) lru_naive_item<1>(p, layer, b, hb, lane); else lru_naive_item<0>(p, layer, b, hb, lane); }
}
__device__ __forceinline__ void lru_tile_geom(int s, int dirb, int b, int& t0, int& L, size_t& gb) {
    if (s < 4) { t0 = 64 * (dirb ? 3 - s : s); L = 256; gb = (size_t)NL + (size_t)b * 256; }
    else { t0 = 64 * (dirb ? 35 - s : s - 4); L = 2048; gb = (size_t)b * 2048; }
}
__device__ __forceinline__ u32x4 conv_ev_(const f32x4* v) {
    unsigned o[4];
#pragma unroll
    for (int n = 0; n < 4; ++n) { const f32x4 a = v[2 * n] * EV_S, b = v[2 * n + 1] * EV_S; unsigned w = 0u;
        w = __builtin_amdgcn_cvt_scalef32_pk_fp4_f32(w, __builtin_amdgcn_fmed3f(a[0], -6.f, 6.f), __builtin_amdgcn_fmed3f(a[1], -6.f, 6.f), 1.0f, 0);
        w = __builtin_amdgcn_cvt_scalef32_pk_fp4_f32(w, __builtin_amdgcn_fmed3f(a[2], -6.f, 6.f), __builtin_amdgcn_fmed3f(a[3], -6.f, 6.f), 1.0f, 1);
        w = __builtin_amdgcn_cvt_scalef32_pk_fp4_f32(w, __builtin_amdgcn_fmed3f(b[0], -6.f, 6.f), __builtin_amdgcn_fmed3f(b[1], -6.f, 6.f), 1.0f, 2);
        w = __builtin_amdgcn_cvt_scalef32_pk_fp4_f32(w, __builtin_amdgcn_fmed3f(b[2], -6.f, 6.f), __builtin_amdgcn_fmed3f(b[3], -6.f, 6.f), 1.0f, 3); o[n] = w; }
    return (u32x4){o[0], o[1], o[2], o[3]};
}
__device__ __forceinline__ u32x4 conv_eu_(const f32x4* v) {
    unsigned o[4];
#pragma unroll
    for (int n = 0; n < 4; ++n) { const f32x4 a = v[2 * n] * EU_S, b = v[2 * n + 1] * EU_S; unsigned w = 0u;
#pragma unroll
        for (int k = 0; k < 4; ++k) { const int qa = (int)__builtin_rintf(__builtin_amdgcn_fmed3f(a[k], -8.f, 7.f)), qb = (int)__builtin_rintf(__builtin_amdgcn_fmed3f(b[k], -8.f, 7.f));
            w |= ((unsigned)qa & 15u) << (8 * k); w |= ((unsigned)qb & 15u) << (8 * k + 4); }
        o[n] = w; }
    return (u32x4){o[0], o[1], o[2], o[3]};
}
__device__ __forceinline__ void lru_phase(CPP p, int layer, LAS unsigned char* lds, int tid, int lane, int wave) {
    const bf16_t* X = (const bf16_t*)(p->ws + 1 * SLOT); const bf16_t* WG = (const bf16_t*)(p->ws + off_wg(layer));
    LAS unsigned char* RAW = lds;
    LAS unsigned char* XRB = lds + 17152;
    LAS float* XRF = (LAS float*)(lds + 35584);
    LAS float* AA = (LAS float*)(lds + 68352);
    LAS float* UU = (LAS float*)(lds + 103168);
    const int td = wave >> 2, idx = tid & 255;
    const int dirw = wave >> 2, mt = (wave >> 1) & 1, nh = wave & 1, l31 = lane & 31, l5 = lane >> 5;
    bf16_t* OF = (bf16_t*)(p->ws + 4 * SLOT); const bf16_t* OB = (const bf16_t*)(p->ws + 5 * SLOT);
    const int rpi = (layer == 1 ? NL : NT) / 256, ow = ((wave >> 2) << 1) | (wave & 1); const bool oact = wave >= 2 && wave < 6;
    LAS float* OGL = (LAS float*)(lds + 137984);
    for (int e = tid; e < 1024; e += 512) OGL[e] = p->in[18][layer * 1024 + e];
    const bool cact = wave >= 6;
    for (int item = blockIdx.x; item < 256; item += gridDim.x) {
        const int b = item >> 4, hb = item & 15;
        bf16x8_t bfr[2][4];
#pragma unroll
        for (int g = 0; g < 2; ++g)
#pragma unroll
            for (int ks = 0; ks < 4; ++ks) bfr[g][ks] = *(const bf16x8_t*)(WG + ((size_t)(((dirw * 2 + g) * 16 + hb) * 64 + nh * 32 + l31)) * 64 + ks * 16 + 8 * l5);
        const int ce = hb * 64 + nh * 32 + l31;
        const float e_ba = p->in[12][(layer * 2 + dirw) * 1024 + ce], e_bx = p->in[14][(layer * 2 + dirw) * 1024 + ce]; const float lam = p->in[15][(layer * 2 + dirw) * 1024 + ce];
        const float e_cl = -8.f * (fmaxf(-lam, 0.f) + log1pf(__expf(-fabsf(lam))));
        const float k_ba = -1.4426950409f * e_ba, k_bx = -1.4426950409f * e_bx, k_cl = 1.4426950409f * e_cl;
        const int chp = idx & 31, tg = idx >> 5, cc = hb * 64 + 2 * chp;
        float cw[4][2], cbv[2];
#pragma unroll
        for (int k = 0; k < 4; ++k) { cw[k][0] = p->in[9][(layer * 4 + k) * 1024 + cc]; cw[k][1] = p->in[9][(layer * 4 + k) * 1024 + cc + 1]; }
        cbv[0] = p->in[10][layer * 1024 + cc]; cbv[1] = p->in[10][layer * 1024 + cc + 1];
        float hstate = 0.f;
        u32x4 pre[3]; int poff[3]; bool pok[3], pfirst[3], plast[3];
#pragma unroll
        for (int k = 0; k < 3; ++k) { const int id_ = idx + 256 * k, rr_ = id_ >> 3; pok[k] = id_ < 536; pfirst[k] = rr_ < 2; plast[k] = rr_ == 66; poff[k] = ((rr_ - 2) * 1024 + hb * 64 + (id_ & 7) * 8) * 2; }
#define LRU_PREFETCH(s_) do { int t0_, L_; size_t gb_; lru_tile_geom((s_), td, b, t0_, L_, gb_); const char* base_ = (const char*)X + (gb_ + t0_) * 2048; const bool fst_ = t0_ == 0, lst_ = t0_ == L_ - 64; \
        _Pragma("unroll") for (int k = 0; k < 3; ++k) { pre[k] = (u32x4){0u, 0u, 0u, 0u}; if (pok[k] && !(fst_ && pfirst[k]) && !(lst_ && plast[k])) pre[k] = *(const u32x4*)(base_ + poff[k]); } } while (0)
        LRU_PREFETCH(0);
        for (int s = 0; s < 36; ++s) {
#pragma unroll
            for (int k = 0; k < 3; ++k) { const int id_ = idx + 256 * k; if (id_ < 536) *(LAS u32x4*)(RAW + td * 8576 + id_ * 16) = pre[k]; }
            __syncthreads();
            if (s + 1 < 36) LRU_PREFETCH(s + 1);
            const int oj = s * 4 + ow; const size_t orow = ((size_t)item * rpi + (oj < rpi ? oj : rpi - 1)) * 1024 + 16 * lane;
            const u32x4 oa0 = ((const u32x4*)(OF + orow))[0], oa1 = ((const u32x4*)(OF + orow))[1], ob0 = ((const u32x4*)(OB + orow))[0], ob1 = ((const u32x4*)(OB + orow))[1];
            const int cwi = s * 2 + (wave - 6), ci = (item * 32 + (cwi & 31)) * 64 + lane; const bool cdo = cact && s < 32;
            f32x4 cvv[8];
            if (cdo) { const f32x4* tb = (const f32x4*)(p->in[24 + (cwi >> 5)] + (size_t)layer * 16384 * 1024) + (size_t)ci * 8;
#pragma unroll
                for (int n = 0; n < 8; ++n) cvv[n] = tb[n]; }
            { float r0[11], r1[11];
#pragma unroll
              for (int j = 0; j < 11; ++j) { const unsigned w = *(const LAS unsigned*)(RAW + td * 8576 + (8 * tg + j) * 128 + chp * 4); r0[j] = bf_lo(w); r1[j] = bf_hi(w); }
#pragma unroll
              for (int t = 0; t < 8; ++t) { const float y0 = cbv[0] + cw[0][0] * r0[t] + cw[1][0] * r0[t + 1] + cw[2][0] * r0[t + 2] + cw[3][0] * r0[t + 3];
                  const float y1 = cbv[1] + cw[0][1] * r1[t] + cw[1][1] * r1[t + 1] + cw[2][1] * r1[t + 2] + cw[3][1] * r1[t + 3];
                  *(LAS f32x2*)(XRF + td * 4096 + (8 * tg + t) * 64 + 2 * chp) = (f32x2){y0, y1};
                  *(LAS unsigned*)(XRB + td * 9216 + (8 * tg + t) * 144 + chp * 4) = pk2(y0, y1); } }
            __syncthreads();
            { f32x16 ca, cx;
#pragma unroll
              for (int i = 0; i < 16; ++i) { ca[i] = 0.f; cx[i] = 0.f; }
#pragma unroll
              for (int ks = 0; ks < 4; ++ks) { const bf16x8_t a = *(const LAS bf16x8_t*)(XRB + dirw * 9216 + (mt * 32 + l31) * 144 + ks * 32 + 16 * l5);
                  ca = __builtin_amdgcn_mfma_f32_32x32x16_bf16(a, bfr[0][ks], ca, 0, 0, 0); cx = __builtin_amdgcn_mfma_f32_32x32x16_bf16(a, bfr[1][ks], cx, 0, 0, 0); }
#pragma unroll
              for (int rq = 0; rq < 4; ++rq) { const int tok0 = mt * 32 + 8 * rq + 4 * l5; f32x4 a4, u4;
#pragma unroll
                  for (int r4 = 0; r4 < 4; ++r4) { const int rg = 4 * rq + r4; const float xr = XRF[dirw * 4096 + (tok0 + r4) * 64 + nh * 32 + l31];
                      const float rgt = __builtin_amdgcn_rcpf(1.f + __builtin_amdgcn_exp2f(ca[rg] * -1.4426950409f + k_ba)), igt = __builtin_amdgcn_rcpf(1.f + __builtin_amdgcn_exp2f(cx[rg] * -1.4426950409f + k_bx));
                      const float a = __builtin_amdgcn_exp2f(k_cl * rgt); a4[r4] = a; u4[r4] = __builtin_amdgcn_sqrtf(fmaxf(__builtin_fmaf(-a, a, 1.f), 0.f)) * (igt * xr); }
                  const int o_ = (dirw * 64 + nh * 32 + l31) * 68 + tok0; *(LAS f32x4*)(AA + o_) = a4; *(LAS f32x4*)(UU + o_) = u4; } }
            __syncthreads();
            if (oact && oj < rpi) {
                const unsigned aw[8] = {oa0.x, oa0.y, oa0.z, oa0.w, oa1.x, oa1.y, oa1.z, oa1.w}, bw[8] = {ob0.x, ob0.y, ob0.z, ob0.w, ob1.x, ob1.y, ob1.z, ob1.w};
                float o[16], ss = 0.f;
#pragma unroll
                for (int j = 0; j < 8; ++j) { o[2 * j] = bf_lo(aw[j]) + bf_lo(bw[j]); o[2 * j + 1] = bf_hi(aw[j]) + bf_hi(bw[j]); ss += o[2 * j] * o[2 * j] + o[2 * j + 1] * o[2 * j + 1]; }
#pragma unroll
                for (int of = 1; of < 16; of <<= 1) ss += __shfl_xor(ss, of);
                const float rs = rsqrtf(ss * (1.f / 256.f) + 1e-6f);
                f32x4 og[4];
#pragma unroll
                for (int j = 0; j < 4; ++j) og[j] = ((const LAS f32x4*)(OGL + 16 * lane))[j];
                u32x4 w0, w1;
                w0.x = pk2(o[0] * rs * og[0][0], o[1] * rs * og[0][1]); w0.y = pk2(o[2] * rs * og[0][2], o[3] * rs * og[0][3]); w0.z = pk2(o[4] * rs * og[1][0], o[5] * rs * og[1][1]); w0.w = pk2(o[6] * rs * og[1][2], o[7] * rs * og[1][3]);
                w1.x = pk2(o[8] * rs * og[2][0], o[9] * rs * og[2][1]); w1.y = pk2(o[10] * rs * og[2][2], o[11] * rs * og[2][3]); w1.z = pk2(o[12] * rs * og[3][0], o[13] * rs * og[3][1]); w1.w = pk2(o[14] * rs * og[3][2], o[15] * rs * og[3][3]);
                u32x4* d = (u32x4*)(OF + orow); d[0] = w0; d[1] = w1; }
            if (cdo) { unsigned char* dst = p->ws + OFF_EU + (size_t)(cwi >> 5) * (OFF_EV - OFF_EU) + (size_t)(ci >> 5) * 512 + (ci & 1) * 256 + ((ci & 31) >> 1) * 16;
                if (cwi >> 5) *(u32x4*)dst = conv_ev_(cvv); else *(u32x4*)dst = conv_eu_(cvv); }
            if (tid < 128) { LAS f32x4* ap = (LAS f32x4*)(AA + tid * 68); LAS f32x4* up = (LAS f32x4*)(UU + tid * 68);
                if (tid < 64) {
#pragma unroll
                    for (int hf = 0; hf < 2; ++hf) { f32x4 a[8], u[8];
#pragma unroll
                        for (int k = 0; k < 8; ++k) { a[k] = ap[8 * hf + k]; u[k] = up[8 * hf + k]; }
#pragma unroll
                        for (int k = 0; k < 8; ++k) {
#pragma unroll
                            for (int j = 0; j < 4; ++j) { hstate = a[k][j] * hstate + u[k][j]; u[k][j] = hstate; } }
#pragma unroll
                        for (int k = 0; k < 8; ++k) up[8 * hf + k] = u[k]; } }
                else {
#pragma unroll
                    for (int hf = 1; hf >= 0; --hf) { f32x4 a[8], u[8];
#pragma unroll
                        for (int k = 0; k < 8; ++k) { a[k] = ap[8 * hf + k]; u[k] = up[8 * hf + k]; }
#pragma unroll
                        for (int k = 7; k >= 0; --k) {
#pragma unroll
                            for (int j = 3; j >= 0; --j) { hstate = a[k][j] * hstate + u[k][j]; u[k][j] = hstate; } }
#pragma unroll
                        for (int k = 0; k < 8; ++k) up[8 * hf + k] = u[k]; } } }
            __syncthreads();
#pragma unroll
            for (int k = 0; k < 2; ++k) { const int tok = tid & 63, cp = wave; int t0, L; size_t gb; lru_tile_geom(s, k, b, t0, L, gb); char* Hd = (char*)(p->ws + (size_t)(k ? 2 : 3) * SLOT) + (gb + t0) * 2048;
                const LAS float* src = UU + (k * 64 + 8 * cp) * 68 + tok; u32x4 w; w.x = pk2(src[0], src[68]); w.y = pk2(src[136], src[204]); w.z = pk2(src[272], src[340]); w.w = pk2(src[408], src[476]);
                *(u32x4*)(Hd + (tok * 1024 + hb * 64 + 8 * cp) * 2) = w; }
        }
        __syncthreads();
#undef LRU_PREFETCH
    }
}
template <int CTRL> __device__ __forceinline__ float dppf(float v) { return __int_as_float(__builtin_amdgcn_update_dpp(0, __float_as_int(v), CTRL, 0xf, 0xf, true)); }
__device__ __forceinline__ float row_max16(float v) { v = fmaxf(v, dppf<0xB1>(v)); v = fmaxf(v, dppf<0x4E>(v)); v = fmaxf(v, dppf<0x141>(v)); v = fmaxf(v, dppf<0x140>(v)); return v; }
template <int CTRL> __device__ __forceinline__ int dppi(int v) { return __builtin_amdgcn_update_dpp(0, v, CTRL, 0xf, 0xf, true); }
__device__ __forceinline__ int row_max16i(int v) { v = max(v, dppi<0xB1>(v)); v = max(v, dppi<0x4E>(v)); v = max(v, dppi<0x141>(v)); v = max(v, dppi<0x140>(v)); return v; }
__device__ __forceinline__ float row_sum16(float v) { v += dppf<0xB1>(v); v += dppf<0x4E>(v); v += dppf<0x141>(v); v += dppf<0x140>(v); return v; }
__device__ __forceinline__ float xrow_sum(float t) {
    auto r = __builtin_amdgcn_permlane32_swap(__float_as_uint(t), __float_as_uint(t), false, false); t = __uint_as_float(r[0]) + __uint_as_float(r[1]);
    auto q = __builtin_amdgcn_permlane16_swap(__float_as_uint(t), __float_as_uint(t), false, false); return __uint_as_float(q[0]) + __uint_as_float(q[1]);
}
__device__ __forceinline__ float wave_sum_d(float v) { return xrow_sum(row_sum16(v)); }
__device__ __forceinline__ void peer_phase(CPP p, int layer, LAS unsigned char* lds, int lane, int wave) {
    const int gw = blockIdx.x * 8 + wave, NGW = gridDim.x * 8;
    const int nrows = layer == 1 ? NL : NT;
    const bf16_t* SC = (const bf16_t*)(p->ws + 1 * SLOT); const bf16_t* HN = (const bf16_t*)(p->ws + OFF_HN2); u8_t* HN8 = p->ws + OFF_HN8;
    const unsigned char* EU = p->ws + OFF_EU; const unsigned char* EV = p->ws + OFF_EV;
    const float* MODL = (const float*)(p->ws + OFF_MOD) + (size_t)layer * 17 * 6144;
    LAS int* topv = (LAS int*)(lds + wave * 4096);
    LAS float* selw = (LAS float*)(topv + 256);
    LAS int* sele = (LAS int*)(selw + 128);
    LAS float* sels = (LAS float*)(sele + 128);
    LAS int* se2 = (LAS int*)(sels + 128); LAS float* sw2 = (LAS float*)(se2 + 128);
    const int IMIN = (int)0x80000000;
    LAS unsigned char* ptab = (LAS unsigned char*)(sw2 + 128);
    int pi4[4], pj4[4];
#pragma unroll
    for (int m = 0; m < 4; ++m) { const int slot = (lane & 15) + 16 * m; int base = 0; bool found = false; pi4[m] = 0; pj4[m] = 0;
        for (int i = 0; i < 16; ++i) { const int cnt = 16 / (i + 1); if (!found && slot < base + cnt) { pi4[m] = i; pj4[m] = slot - base; found = true; } base += cnt; } }
    const int R = lane >> 4, c16 = lane & 15, half = lane >> 5, l31 = lane & 31;
    if (R == 0) {
#pragma unroll
        for (int m = 0; m < 4; ++m) ptab[c16 + 16 * m] = (unsigned char)((pi4[m] << 4) | pj4[m]);
    }
    LDS_FENCE();
    u32x4 scn[4];
#pragma unroll
    for (int B = 0; B < 4; ++B) scn[B] = *(const u32x4*)(SC + (size_t)(gw < nrows ? gw : 0) * 2048 + (4 * B + R) * 128 + 8 * c16);
    asm volatile("" :: "v"(scn[0]), "v"(scn[1]), "v"(scn[2]), "v"(scn[3]));
    for (int r = gw; r < nrows; r += NGW) {
        int hqh[8], hql[8]; float tscale; h2_t acch[32];
        { const u32x4* hp = (const u32x4*)(p->ws + OFF_HQ + (size_t)r * 1024 + 64 * c16); const u32x4 h0 = hp[0], h1 = hp[1], l0 = hp[2], l1 = hp[3];
          hqh[0] = h0.x; hqh[1] = h0.y; hqh[2] = h0.z; hqh[3] = h0.w; hqh[4] = h1.x; hqh[5] = h1.y; hqh[6] = h1.z; hqh[7] = h1.w; hql[0] = l0.x; hql[1] = l0.y; hql[2] = l0.z; hql[3] = l0.w; hql[4] = l1.x; hql[5] = l1.y; hql[6] = l1.z; hql[7] = l1.w;
          tscale = ((const float*)(p->ws + OFF_TS))[r]; }
#if defined(PROBE_PEER)
        for (int rep = 0; rep < PROBE_PEER; ++rep) {
#endif
#if defined(PROBE_PK)
        const unsigned long long pk0 = __builtin_amdgcn_s_memrealtime();
#endif
        __builtin_amdgcn_s_setprio(1);
#define PEER_KEY(b) ((b) ^ (((b) >> 31) & 0x7fffffff))
#pragma unroll
        for (int B = 0; B < 4; ++B) {
            const int g = 4 * B + R; int v[8];
            { const u32x4 w = scn[B]; const unsigned ww[4] = {w.x, w.y, w.z, w.w};
#pragma unroll
              for (int i = 0; i < 4; ++i) { const int k = 8 * c16 + 2 * i; const int b0 = (int)((ww[i] << 16) | (unsigned)k), b1 = (int)((ww[i] & 0xffff0000u) | (unsigned)(k + 1)); v[2 * i] = PEER_KEY(b0); v[2 * i + 1] = PEER_KEY(b1); } }
#define PEER_CE(x, y) do { const int hi_ = max(v[x], v[y]), lo_ = min(v[x], v[y]); v[x] = hi_; v[y] = lo_; } while (0)
            PEER_CE(0, 1); PEER_CE(2, 3); PEER_CE(4, 5); PEER_CE(6, 7); PEER_CE(0, 2); PEER_CE(1, 3); PEER_CE(4, 6); PEER_CE(5, 7); PEER_CE(1, 2); PEER_CE(5, 6);
            PEER_CE(0, 4); PEER_CE(1, 5); PEER_CE(2, 6); PEER_CE(3, 7); PEER_CE(2, 4); PEER_CE(3, 5); PEER_CE(1, 2); PEER_CE(3, 4); PEER_CE(5, 6);
#undef PEER_CE
            int res = IMIN;
#pragma unroll
            for (int it = 0; it < 16; ++it) {
                const int m = row_max16i(v[0]); const bool own = v[0] == m;
                res = (c16 == it) ? m : res;
#pragma unroll
                for (int i = 0; i < 7; ++i) v[i] = own ? v[i + 1] : v[i];
                v[7] = own ? IMIN : v[7];
            }
            topv[g * 16 + c16] = PEER_KEY(res);
        }
        LDS_FENCE();
        for (int P = 0; P < 2; ++P) { const int h = 4 * P + R; int cs[4];
#pragma unroll
            for (int m = 0; m < 4; ++m) { const float a = __int_as_float(topv[(2 * h) * 16 + pi4[m]]), bq = __int_as_float(topv[(2 * h + 1) * 16 + pj4[m]]);
                const int b = (int)((__float_as_uint(a + bq) & ~63u) | (unsigned)(c16 + 16 * m)); cs[m] = (c16 + 16 * m < 50) ? PEER_KEY(b) : IMIN; }
#define PEER_CE(x, y) do { const int hi_ = max(cs[x], cs[y]), lo_ = min(cs[x], cs[y]); cs[x] = hi_; cs[y] = lo_; } while (0)
            PEER_CE(0, 1); PEER_CE(2, 3); PEER_CE(0, 2); PEER_CE(1, 3); PEER_CE(1, 2);
#undef PEER_CE
            int res = IMIN;
#pragma unroll
            for (int it = 0; it < 16; ++it) {
                const int m = row_max16i(cs[0]); const bool own = cs[0] == m;
                res = (c16 == it) ? m : res;
                cs[0] = own ? cs[1] : cs[0]; cs[1] = own ? cs[2] : cs[1]; cs[2] = own ? cs[3] : cs[2]; cs[3] = own ? IMIN : cs[3];
            }
            const int bits = PEER_KEY(res), ij = ptab[bits & 63];
            sels[h * 16 + c16] = __int_as_float(bits);
            sele[h * 16 + c16] = (topv[(2 * h) * 16 + (ij >> 4)] & 127) * 128 + (topv[(2 * h + 1) * 16 + (ij & 15)] & 127);
        }
#undef PEER_KEY
        LDS_FENCE();
        { const int h = lane >> 3;
          const float s0 = sels[2 * lane], s1 = sels[2 * lane + 1];
          float mx = fmaxf(s0, s1); mx = fmaxf(mx, dppf<0xB1>(mx)); mx = fmaxf(mx, dppf<0x4E>(mx)); mx = fmaxf(mx, dppf<0x141>(mx));
          const float e0 = __expf(s0 - mx), e1 = __expf(s1 - mx); float sm = e0 + e1; sm += dppf<0xB1>(sm); sm += dppf<0x4E>(sm); sm += dppf<0x141>(sm);
          const float inv = __builtin_amdgcn_rcpf(sm); const float w0 = e0 * inv, w1 = e1 * inv; (void)h;
          const int x0 = sele[2 * lane], x1 = sele[2 * lane + 1]; const int p0 = x0 >> 10, p1 = x1 >> 10; int pos0 = 0, pos1 = 0, base = 0;
#pragma unroll
          for (int x = 0; x < 16; ++x) { const unsigned long long m0 = __ballot(p0 == x), m1 = __ballot(p1 == x); const int c0 = __popcll(m0), c1 = __popcll(m1);
              const int b0 = (int)__builtin_amdgcn_mbcnt_hi((unsigned)(m0 >> 32), __builtin_amdgcn_mbcnt_lo((unsigned)m0, 0u)), b1 = (int)__builtin_amdgcn_mbcnt_hi((unsigned)(m1 >> 32), __builtin_amdgcn_mbcnt_lo((unsigned)m1, 0u));
              pos0 = (p0 == x) ? base + b0 : pos0; pos1 = (p1 == x) ? base + c0 + b1 : pos1; base += c0 + c1; }
          se2[pos0] = x0; sw2[pos0] = w0; se2[pos1] = x1; sw2[pos1] = w1; }
        LDS_FENCE();
#if defined(PROBE_PK)
        const unsigned long long pk1 = __builtin_amdgcn_s_memrealtime();
        if (PROBE_PK == 1) { while (__builtin_amdgcn_s_memrealtime() - pk1 < pk1 - pk0) __builtin_amdgcn_s_sleep(4); }
#endif
        {
#pragma unroll
            for (int j = 0; j < 32; ++j) acch[j] = (h2_t){(_Float16)0.f, (_Float16)0.f}; }
        u32x4 A4[2][2], B4[2][2];
#define PEER_LDV(b) _Pragma("unroll") for (int i = 0; i < 2; ++i) { const int e_ = se2[(b) * 8 + 2 * R + i]; const unsigned char* rp_ = EV + (size_t)e_ * 512 + c16 * 16; B4[i][0] = *(const u32x4*)rp_; B4[i][1] = *(const u32x4*)(rp_ + 256); }
#define PEER_LDU(b) _Pragma("unroll") for (int i = 0; i < 2; ++i) { const int e_ = se2[(b) * 8 + 2 * R + i]; const unsigned char* rp_ = EU + (size_t)e_ * 512 + c16 * 16; A4[i][0] = *(const u32x4*)rp_; A4[i][1] = *(const u32x4*)(rp_ + 256); }
#define PEER_UCOMP(b) do { float d[2]; \
        _Pragma("unroll") for (int i = 0; i < 2; ++i) { int h0_ = 0, h1_ = 0, l0_ = 0, l1_ = 0; const int uw_[8] = {(int)A4[i][0].x, (int)A4[i][0].y, (int)A4[i][0].z, (int)A4[i][0].w, (int)A4[i][1].x, (int)A4[i][1].y, (int)A4[i][1].z, (int)A4[i][1].w}; \
            _Pragma("unroll") for (int n = 0; n < 8; n += 2) { h0_ = __builtin_amdgcn_sdot8(uw_[n], hqh[n], h0_, false); l0_ = __builtin_amdgcn_sdot8(uw_[n], hql[n], l0_, false); \
                h1_ = __builtin_amdgcn_sdot8(uw_[n + 1], hqh[n + 1], h1_, false); l1_ = __builtin_amdgcn_sdot8(uw_[n + 1], hql[n + 1], l1_, false); } \
            d[i] = (float)(16 * (h0_ + h1_) + l0_ + l1_); } \
        const bool b0_ = lane & 1; float t_ = (b0_ ? d[1] : d[0]) + dppf<0xB1>(b0_ ? d[0] : d[1]);        \
        t_ += dppf<0x4E>(t_); t_ += dppf<0x124>(t_); t_ += dppf<0x128>(t_); \
        if (c16 < 2) { const int k_ = (b) * 8 + 2 * R + c16; sw2[k_] = sw2[k_] * gelu_tanh(t_ * tscale); } } while (0)
#define PEER_VCOMP(b) do { _Pragma("unroll") for (int i = 0; i < 2; ++i) { const _Float16 wq_ = (_Float16)(sw2[(b) * 8 + 2 * R + i] * (1.f / EV_S)); const h2_t w2_ = (h2_t){wq_, wq_}; \
            const unsigned vw_[8] = {B4[i][0].x, B4[i][0].y, B4[i][0].z, B4[i][0].w, B4[i][1].x, B4[i][1].y, B4[i][1].z, B4[i][1].w}; \
            _Pragma("unroll") for (int n = 0; n < 8; ++n) { \
                acch[4 * n] += w2_ * __builtin_amdgcn_cvt_scalef32_pk_f16_fp4(vw_[n], 1.0f, 0); acch[4 * n + 1] += w2_ * __builtin_amdgcn_cvt_scalef32_pk_f16_fp4(vw_[n], 1.0f, 1); \
                acch[4 * n + 2] += w2_ * __builtin_amdgcn_cvt_scalef32_pk_f16_fp4(vw_[n], 1.0f, 2); acch[4 * n + 3] += w2_ * __builtin_amdgcn_cvt_scalef32_pk_f16_fp4(vw_[n], 1.0f, 3); } } } while (0)
        __builtin_amdgcn_s_setprio(2);
        PEER_LDU(0); PEER_LDV(0);
        { const int rn = (r + NGW < nrows) ? r + NGW : r;
#pragma unroll
          for (int B = 0; B < 4; ++B) scn[B] = *(const u32x4*)(SC + (size_t)rn * 2048 + (4 * B + R) * 128 + 8 * c16); }
        const int cb = 64 * c16 + 16 * R; const int mrow = r < NL ? (r >> 11) : 16;
        bf16_t* hp = h_row(p->out, p->ws, r) + cb; const float* g2 = MODL + (size_t)mrow * 6144 + 5120 + cb;
        const u32x4 hr0 = ((const u32x4*)hp)[0], hr1 = ((const u32x4*)hp)[1];
        for (int b = 0; b < 16; ++b) {
            PEER_UCOMP(b);
            if (b + 1 < 16) { PEER_LDU(b + 1); }
            LDS_FENCE();
            PEER_VCOMP(b);
            if (b + 1 < 16) { PEER_LDV(b + 1); }
        }
        __builtin_amdgcn_s_setprio(0);
#if defined(PROBE_PEER)

        }
#endif
#if defined(PROBE_PK)
        if (PROBE_PK == 2) { const unsigned long long pk2 = __builtin_amdgcn_s_memrealtime(); while (__builtin_amdgcn_s_memrealtime() - pk2 < pk2 - pk1) __builtin_amdgcn_s_sleep(4); }
#endif
        float a16[16];
        { h2_t f1[16];
#pragma unroll
          for (int j = 0; j < 16; ++j) { auto sx = __builtin_amdgcn_permlane32_swap(__builtin_bit_cast(unsigned, acch[j]), __builtin_bit_cast(unsigned, acch[16 + j]), false, false);
              f1[j] = __builtin_bit_cast(h2_t, (unsigned)sx[0]) + __builtin_bit_cast(h2_t, (unsigned)sx[1]); }
#pragma unroll
          for (int j = 0; j < 8; ++j) { auto sx = __builtin_amdgcn_permlane16_swap(__builtin_bit_cast(unsigned, f1[j]), __builtin_bit_cast(unsigned, f1[8 + j]), false, false);
              const h2_t x = __builtin_bit_cast(h2_t, (unsigned)sx[0]), y = __builtin_bit_cast(h2_t, (unsigned)sx[1]); a16[2 * j] = (float)x.x + (float)y.x; a16[2 * j + 1] = (float)x.y + (float)y.y; } }
        float hv[16], ss = 0.f;
        { const unsigned hw[8] = {hr0.x, hr0.y, hr0.z, hr0.w, hr1.x, hr1.y, hr1.z, hr1.w};
#pragma unroll
          for (int j = 0; j < 4; ++j) { const f32x4 g4 = ((const f32x4*)g2)[j];
#pragma unroll
            for (int i = 0; i < 4; ++i) { const unsigned w = hw[2 * j + (i >> 1)]; const float y = ((i & 1) ? bf_hi(w) : bf_lo(w)) + g4[i] * a16[4 * j + i]; hv[4 * j + i] = y; ss += y * y; } } }
        const float rstd = rsqrtf(wave_sum_d(ss) * (1.f / 1024.f) + 1e-6f);
        asm volatile("" :: "v"(scn[0]), "v"(scn[1]), "v"(scn[2]), "v"(scn[3]));
        if (layer == 0) {
            { u32x4 o0, o1; o0.x = pk2(hv[0], hv[1]); o0.y = pk2(hv[2], hv[3]); o0.z = pk2(hv[4], hv[5]); o0.w = pk2(hv[6], hv[7]); o1.x = pk2(hv[8], hv[9]); o1.y = pk2(hv[10], hv[11]); o1.z = pk2(hv[12], hv[13]); o1.w = pk2(hv[14], hv[15]);
              ((u32x4*)hp)[0] = o0; ((u32x4*)hp)[1] = o1; }
            const float* md = MODL + 17 * 6144 + (size_t)mrow * 6144 + cb; const float* gn = p->in[6] + 1024 + cb; float y[16];
#pragma unroll
            for (int j = 0; j < 16; ++j) y[j] = hv[j] * rstd * gn[j] * (1.f + md[1024 + j]) + md[j];
#pragma unroll
            for (int j = 0; j < 16; ++j) y[j] *= ACT_S;
            *(u32x4*)(HN8 + (size_t)r * 1024 + cb) = (u32x4){pk4_f8(y[0], y[1], y[2], y[3]), pk4_f8(y[4], y[5], y[6], y[7]), pk4_f8(y[8], y[9], y[10], y[11]), pk4_f8(y[12], y[13], y[14], y[15])};
        } else {
            const float* gn = p->in[26] + cb; float* op = p->out + (size_t)r * 1024 + cb;
            f32x4 gnv[4];
#pragma unroll
            for (int j = 0; j < 4; ++j) gnv[j] = ((const f32x4*)gn)[j];
#pragma unroll
            for (int j = 0; j < 4; ++j) ((f32x4*)op)[j] = (f32x4){hv[4 * j] * rstd * gnv[j][0], hv[4 * j + 1] * rstd * gnv[j][1], hv[4 * j + 2] * rstd * gnv[j][2], hv[4 * j + 3] * rstd * gnv[j][3]};
        }
    }
    __builtin_amdgcn_s_setprio(0);
#undef PEER_LDU
#undef PEER_LDV
#undef PEER_UCOMP
#undef PEER_VCOMP
}
#define LAYOUT_STR2(x) #x
#define LAYOUT_STR(x) LAYOUT_STR2(x)

constexpr int N_PHASES = 24;
#ifndef ONLY
#define ONLY -1
#endif
#define EN(k) (ONLY < 0 || ONLY == (k))
template <bool F8, class Epi> __device__ __forceinline__ void run_gemm(LAS unsigned char* lds, const void* A, const void* Bt, int M, int N, const Epi& E, const void* A2 = nullptr, const void* Bt2 = nullptr) {
    pg8::Gemm g{(const bf16_t*)A, (const bf16_t*)Bt, M, N, F8 ? 512 : 1024, (const bf16_t*)A2, (const bf16_t*)Bt2}; pg8::StaticOrder S; S.init(M, N, (int)gridDim.x, (int)blockIdx.x);
    pg8::gemm_phase<Epi, pg8::StaticOrder, false, F8>(lds, g, S, E, nullptr);
}
__global__ void __launch_bounds__(512, 2) fwd_kernel(Params p_unused) {
    extern __shared__ __attribute__((aligned(16))) unsigned char lds_raw[];
#if defined(LAYOUT_SHIFT)
    asm volatile(".fill " LAYOUT_STR(LAYOUT_SHIFT) ", 4, 0xBF800000" :::);
#endif
    LAS unsigned char* lds = (LAS unsigned char*)lds_raw;
    cg::grid_group grid = cg::this_grid();
    CPP p0 = (CPP)__builtin_amdgcn_kernarg_segment_ptr();
    const int ph_lo = p0->ph_lo, ph_hi = p0->ph_hi, coop = p0->coop;
    volatile LAS unsigned* bst = (volatile LAS unsigned*)(lds + LDS_BYTES - 16);
    if (threadIdx.x < 4) bst[threadIdx.x] = 0u;
    __syncthreads();
    XcdBarrier bar = xcd_barrier_post((unsigned*)(p0->ws + OFF_BAR), bst);
    for (int ph = ph_lo; ph < ph_hi; ++ph) {
        CPP p = p0; asm volatile("" : "+s"(p));
        unsigned char* ws = p->ws; float* HC = (float*)(ws + OFF_HC);
        int tid_l = threadIdx.x; asm volatile("" : "+v"(tid_l));
        const int tid = tid_l, lane = tid & 63, wave = __builtin_amdgcn_readfirstlane(tid >> 6);
#if defined(PROBE_STRETCH)
        const unsigned long long pst0 = __builtin_amdgcn_s_memrealtime();
#endif
        if (ph == 0 && EN(20)) prep_phase(p, lds, tid, lane, wave);
        else if (ph == 1 && EN(21)) norm_phase(p, 0, 0, NT, p->in[0], p->in[2], lane, wave);
        else {
            const int layer = (ph - 2) / 11, sub = (ph - 2) % 11, M = layer ? NL : NT;
            if (sub == 0 && EN(0)) { EpiA E{(bf16_t*)(ws + 1 * SLOT), (bf16_t*)(ws + 3 * SLOT), (bf16_t*)(ws + 3 * SLOT) + (size_t)NT * 512, (bf16_t*)(ws + 2 * SLOT), (bf16_t*)(ws + OFF_F), 0.08838834764831845f};
                run_gemm<true>(lds, ws + OFF_HN8, ws + off_wa(layer), NT, 3328, E); }
            else if (sub == 1 && EN(1)) gla_phase(p, layer, lds, tid, lane, wave);
            else if (sub == 2 && EN(2)) { lru_phase(p, layer, lds, tid, lane, wave); }
            else if (sub == 3) { }
            else if (sub == 4 && EN(4)) { EpiB E{(const bf16_t*)(ws + 3 * SLOT), (const bf16_t*)(ws + 2 * SLOT), (const bf16_t*)(ws + 4 * SLOT), ws};
                run_gemm<true>(lds, ws + OFF_HN8, ws + off_wb(layer), M, 4096, E); }
            else if (sub == 5 && EN(5)) { EpiMM E{ws + OFF_SGL8, ws + OFF_SGG8, ws + OFF_MM8}; run_gemm<true>(lds, ws + OFF_YL8, ws + off_wbl(layer, 0), M, 1024, E, ws + OFF_YG8, ws + off_wbl(layer, 1)); }
            else if (sub == 6) { }
            else if (sub == 7 && EN(7)) { EpiOut E{p->in[0], p->in[2], p->out, ws, (const float*)(ws + OFF_MOD) + (size_t)layer * 17 * 6144, layer};
                run_gemm<true>(lds, ws + OFF_MM8, ws + off_wbl(layer, 2), M, 1024, E); }
            else if (sub == 8 && EN(8)) norm_phase(p, layer, 1, M, p->out, HC, lane, wave);
            else if (sub == 9 && EN(9)) { EpiSc E{(bf16_t*)(ws + 1 * SLOT)}; run_gemm<false>(lds, ws + OFF_HN2, ws + off_wsc(layer), M, 2048, E); }
            else if (sub == 10 && EN(10)) peer_phase(p, layer, lds, lane, wave);
        }
#if defined(PROBE_STRETCH)
        { const int code = ph == 0 ? 12 : ph == 1 ? 13 : (ph - 2) % 11;
          if ((PROBE_STRETCH >> code) & 1) { const unsigned long long pst1 = __builtin_amdgcn_s_memrealtime(); while (__builtin_amdgcn_s_memrealtime() - pst1 < pst1 - pst0) __builtin_amdgcn_s_sleep(8); } }
#endif
        const bool no_seam = ph >= 2 && ((ph - 2) % 11 == 6 || (ph - 2) % 11 == 3);
        if (coop && ph + 1 < ph_hi && !no_seam) { if (ph == ph_lo) grid.sync(); else xcd_barrier(bar);
#if defined(PROBE_BAR)
            for (int rep = 0; rep < PROBE_BAR; ++rep) xcd_barrier(bar);
#endif
        }
    }
}

extern "C" void kernel_launch(void* const* d_in, const int* in_sizes, int n_in, void* d_out, int out_size, void* d_ws, size_t ws_size, hipStream_t stream) {
    static int grid_blocks = 0;
    if (!grid_blocks) {
        int dev = 0, cus = 0, per_cu = 0;
        (void)hipGetDevice(&dev);
        (void)hipDeviceGetAttribute(&cus, hipDeviceAttributeMultiprocessorCount, dev);
        (void)hipFuncSetAttribute((const void*)fwd_kernel, hipFuncAttributeMaxDynamicSharedMemorySize, LDS_BYTES);
        (void)hipOccupancyMaxActiveBlocksPerMultiprocessor(&per_cu, (const void*)fwd_kernel, 512, LDS_BYTES);
        if (per_cu < 1) { fprintf(stderr, "kernel_launch: occupancy query says %d blocks per CU\n", per_cu); per_cu = 1; }
        grid_blocks = cus * per_cu;
        fprintf(stderr, "kernel_launch: cus %d per_cu %d grid %d ws %zu need %zu\n", cus, per_cu, grid_blocks, ws_size, (size_t)WS_END);
    }
    if (n_in != 27 || ws_size < WS_END) { fprintf(stderr, "kernel_launch: bad inputs (n_in %d, ws %zu < %zu)\n", n_in, ws_size, (size_t)WS_END); return; }
    (void)hipMemsetAsync((char*)d_ws + OFF_BAR, 0, XCD_BAR_WORDS * 4, stream);
    Params p{};
    for (int i = 0; i < 27; ++i) p.in[i] = (const float*)d_in[i];
    p.out = (float*)d_out; p.ws = (unsigned char*)d_ws; p.ph_lo = 0; p.ph_hi = N_PHASES; p.coop = 1; p.pad = 0;
#if defined(MULTI_LAUNCH)
    p.coop = 0;
    for (int ph = 0; ph < N_PHASES; ++ph) { p.ph_lo = ph; p.ph_hi = ph + 1; hipLaunchKernelGGL(fwd_kernel, dim3(grid_blocks), dim3(512), LDS_BYTES, stream, p); }
#else
    void* args[] = {&p};
    hipError_t e = hipLaunchCooperativeKernel((void*)fwd_kernel, dim3(grid_blocks), dim3(512), args, LDS_BYTES, stream);
    if (e != hipSuccess) fprintf(stderr, "cooperative launch failed: %s (grid %d)\n", hipGetErrorString(e), grid_blocks);
#endif
}
```
